# Optimizing an MI355X kernel written in HIP

```python
import math
import jax, jax.numpy as jnp
from jax import lax
import numpy as np

D_MODEL = 1024
BATCH = 8
SEQ = 2048
DEPTH = 1

D_MIX = D_MODEL
ATT_WIDTH = D_MIX // 2
POOL_WIDTH = D_MIX - ATT_WIDTH
HEAD_DIM = 64
N_HEADS = ATT_WIDTH // HEAD_DIM
IDX_HEADS = 4
IDX_DIM = 64
IDX_ROPE_DIM = 32
INDEX_TOPK = 256
POOL_WINDOWS = (2, 4, 8, 16)
N_POOL_GROUPS = len(POOL_WINDOWS)
POOL_CH = POOL_WIDTH // N_POOL_GROUPS
D_FF = 2816
ROPE_THETA = 10000.0
NORM_EPS = 1e-6
Q_BLOCK = 128
IN_SPLITS = (ATT_WIDTH, ATT_WIDTH, ATT_WIDTH, IDX_HEADS * IDX_DIM, IDX_DIM, IDX_HEADS, POOL_WIDTH)
IN_COLS = sum(IN_SPLITS)

kernel_name = "hybrid_dsa_multiscale_pool_macaron"


def rms_norm(x, g):
    xf = x.astype(jnp.float32)
    y = xf * lax.rsqrt(jnp.mean(xf * xf, axis=-1, keepdims=True) + NORM_EPS)
    return (y * g.astype(jnp.float32)).astype(x.dtype)


def rope(x, pos, rot_dim):
    half = rot_dim // 2
    inv = ROPE_THETA ** (-jnp.arange(half, dtype=jnp.float32) / half)
    ang = pos.astype(jnp.float32)[:, None] * inv[None, :]
    cos = jnp.cos(ang)[:, None, :]
    sin = jnp.sin(ang)[:, None, :]
    xr = x[..., :rot_dim].astype(jnp.float32)
    x1, x2 = xr[..., :half], xr[..., half:]
    rot = jnp.concatenate([x1 * cos - x2 * sin, x2 * cos + x1 * sin], axis=-1).astype(x.dtype)
    return jnp.concatenate([rot, x[..., rot_dim:]], axis=-1)


def swiglu(x, w_gate, w_up, w_down):
    return (jax.nn.silu(x @ w_gate) * (x @ w_up)) @ w_down


def dsa_attention(q, k, v, q_idx, k_idx, w_idx, top_k):
    B, S, H, Dh = q.shape
    nb = S // Q_BLOCK
    key_pos = jnp.arange(S)
    scale = Dh ** -0.5

    def to_blocks(a):
        return a.reshape((B, nb, Q_BLOCK) + a.shape[2:]).swapaxes(0, 1)

    def block(args):
        qb, qib, wb, posb = args
        rel = jax.nn.relu(jnp.einsum('bthd,bsd->bths', qib, k_idx).astype(jnp.float32))
        score = jnp.einsum('bth,bths->bts', wb.astype(jnp.float32), rel)
        causal = key_pos[None, :] <= posb[:, None]
        score = jnp.where(causal[None], score, -jnp.inf)
        _, idx = lax.top_k(score, top_k)
        valid = idx <= posb[None, :, None]
        k_sel = jax.vmap(lambda kk, ii: kk[ii])(k, idx)
        v_sel = jax.vmap(lambda vv, ii: vv[ii])(v, idx)
        logits = jnp.einsum('bthd,btkhd->bhtk', qb, k_sel).astype(jnp.float32) * scale
        logits = jnp.where(valid[:, None], logits, -jnp.inf)
        p = jax.nn.softmax(logits, axis=-1).astype(v.dtype)
        return jnp.einsum('bhtk,btkhd->bthd', p, v_sel)

    pos_blocks = jnp.arange(S).reshape(nb, Q_BLOCK)
    out = lax.map(block, (to_blocks(q), to_blocks(q_idx), to_blocks(w_idx), pos_blocks))
    return out.swapaxes(0, 1).reshape(B, S, H * Dh)


def multiscale_pool(u):
    B, S, _ = u.shape
    uf = u.astype(jnp.float32).reshape(B, S, N_POOL_GROUPS, POOL_CH)
    c = jnp.concatenate([jnp.zeros((B, 1, N_POOL_GROUPS, POOL_CH), jnp.float32),
                         jnp.cumsum(uf, axis=1)], axis=1)
    t = jnp.arange(S)
    outs = []
    for g, w in enumerate(POOL_WINDOWS):
        cg = c[:, :, g]
        c_lo = jnp.concatenate([jnp.zeros((B, w - 1, POOL_CH), jnp.float32), cg[:, :S + 1 - w]], axis=1)
        count = jnp.minimum(t + 1, w).astype(jnp.float32)[None, :, None]
        outs.append((cg[:, 1:] - c_lo) / count - uf[:, :, g])
    return jnp.stack(outs, axis=2).astype(u.dtype)


def setup_inputs(seed: int = 0) -> dict:
    key = jax.random.key(seed)
    ks = jax.random.split(key, 20)
    f32 = jnp.float32

    def nrm(k, shape, fan_in):
        return jax.random.normal(k, shape, f32) * fan_in ** -0.5

    def gain(k, shape):
        return 1.0 + 0.02 * jax.random.normal(k, shape, f32)

    L = DEPTH
    return {
        "x": jax.random.normal(ks[0], (BATCH, SEQ, D_MODEL), f32),
        "ffn1_norm": gain(ks[1], (L, D_MODEL)),
        "ffn1_w_gate": nrm(ks[2], (L, D_MODEL, D_FF), D_MODEL),
        "ffn1_w_up": nrm(ks[3], (L, D_MODEL, D_FF), D_MODEL),
        "ffn1_w_down": nrm(ks[4], (L, D_FF, D_MODEL), D_FF),
        "mix_norm": gain(ks[5], (L, D_MODEL)),
        "w_in": nrm(ks[6], (L, D_MODEL, IN_COLS), D_MODEL),
        "q_norm": gain(ks[7], (L, HEAD_DIM)),
        "k_norm": gain(ks[8], (L, HEAD_DIM)),
        "pool_w": nrm(ks[9], (L, N_POOL_GROUPS, POOL_CH, POOL_CH), POOL_CH),
        "pool_scale": 0.5 + 0.05 * jax.random.normal(ks[10], (L, POOL_WIDTH), f32),
        "w_out": nrm(ks[11], (L, D_MIX, D_MODEL), D_MIX),
        "ffn2_norm": gain(ks[12], (L, D_MODEL)),
        "ffn2_w_gate": nrm(ks[13], (L, D_MODEL, D_FF), D_MODEL),
        "ffn2_w_up": nrm(ks[14], (L, D_MODEL, D_FF), D_MODEL),
        "ffn2_w_down": nrm(ks[15], (L, D_FF, D_MODEL), D_FF),
    }


def reference(x, ffn1_norm, ffn1_w_gate, ffn1_w_up, ffn1_w_down, mix_norm, w_in,
              q_norm, k_norm, pool_w, pool_scale, w_out,
              ffn2_norm, ffn2_w_gate, ffn2_w_up, ffn2_w_down):
    B, S, _ = x.shape
    top_k = min(INDEX_TOPK, S // 4)
    pos = jnp.arange(S)
    split_points = list(np.cumsum(IN_SPLITS)[:-1])
    idx_scale = (IDX_HEADS ** -0.5) * (IDX_DIM ** -0.5)

    for l in range(DEPTH):
        x = x + 0.5 * swiglu(rms_norm(x, ffn1_norm[l]), ffn1_w_gate[l], ffn1_w_up[l], ffn1_w_down[l])

        h = rms_norm(x, mix_norm[l])
        proj = h @ w_in[l]
        q, k, v, qi, ki, wi, u = jnp.split(proj, split_points, axis=-1)
        q = rope(rms_norm(q.reshape(B, S, N_HEADS, HEAD_DIM), q_norm[l]), pos, HEAD_DIM)
        k = rope(rms_norm(k.reshape(B, S, N_HEADS, HEAD_DIM), k_norm[l]), pos, HEAD_DIM)
        v = v.reshape(B, S, N_HEADS, HEAD_DIM)
        qi = rope(qi.reshape(B, S, IDX_HEADS, IDX_DIM), pos, IDX_ROPE_DIM)
        ki = rope(ki.reshape(B, S, 1, IDX_DIM), pos, IDX_ROPE_DIM)[:, :, 0]
        wi = wi * idx_scale

        attn = dsa_attention(q, k, v, qi, ki, wi, top_k)

        pooled = jnp.einsum('bsgc,gcd->bsgd', multiscale_pool(u), pool_w[l])
        pooled = pooled.reshape(B, S, POOL_WIDTH) * pool_scale[l]

        x = x + jnp.concatenate([attn, pooled], axis=-1) @ w_out[l]

        x = x + 0.5 * swiglu(rms_norm(x, ffn2_norm[l]), ffn2_w_gate[l], ffn2_w_up[l], ffn2_w_down[l])
    return x
```

```cpp
#include <hip/hip_runtime.h>
#include <cstdio>
#include <cstdint>
#include <math.h>
namespace pg8 {
#define PG8_LAS __attribute__((address_space(3)))
typedef unsigned short bf16_t;
typedef short bf16x8 __attribute__((ext_vector_type(8)));
typedef float f32x4 __attribute__((ext_vector_type(4)));
typedef unsigned u32x4 __attribute__((ext_vector_type(4)));
constexpr int BM = 256, BK = 64, HALF = 128, HTB = HALF * BK * 2  , STAGE_BYTES = 8 * HTB, NXCD = 8, WGM = 8;

__host__ __device__ __forceinline__ int lds_byte(int r, int c) { const int st = (r >> 4) * 2 + (c >> 5), rr = r & 15, cc = c & 31, ob = rr * 64 + cc * 2; return st * 1024 + (ob ^ (((ob >> 9) & 1) << 5)); }
__host__ __device__ __forceinline__ void stage_rc(int b, int& R, int& C) { const int st = b / 1024, sb = b % 1024, swz = sb ^ (((sb >> 9) & 1) << 5); R = (st >> 1) * 16 + swz / 64; C = (st & 1) * 32 + (swz % 64) / 2; }
__host__ __device__ __forceinline__ int perm32(int rho) { const int n = rho >> 4, i = rho & 15; return 8 * (i >> 2) + 4 * n + (i & 3); }

struct Unit { int pm, pn; };
struct Gemm { const bf16_t* A; const bf16_t* Bt; int M, N, K; };

struct StaticOrder {
    int nM, nN, nwg, G, c;
    __host__ __device__ void init(int M, int N, int G_, int c_) { nM = M / BM; nN = N / BM; nwg = nM * nN; G = G_; c = c_; }
    __host__ __device__ bool next(int i, Unit& u) const {
        const long L = (long)i * G + c; if (L >= nwg) return false;
        int wgid = (int)L; { const int q = nwg / NXCD, r = nwg % NXCD, xcd = wgid % NXCD, off = wgid / NXCD; wgid = (xcd < r ? xcd * (q + 1) : r * (q + 1) + (xcd - r) * q) + off; }
        const int nig = WGM * nN, gid = wgid / nig, fm = gid * WGM, gsz = (nM - fm) < WGM ? (nM - fm) : WGM;
        u.pm = fm + ((wgid % nig) % gsz); u.pn = (wgid % nig) / gsz; return true;
    }
    __device__ __forceinline__ void a_ready(const Unit&) const {}
    __device__ __forceinline__ void done(const Unit&) const {}
};


__device__ __forceinline__ unsigned cvt_pk_bf16(float lo, float hi) { unsigned r; asm volatile("v_cvt_pk_bf16_f32 %0, %1, %2" : "=v"(r) : "v"(lo), "v"(hi)); return r; }
typedef float f32x2 __attribute__((ext_vector_type(2)));

typedef float f32x2 __attribute__((ext_vector_type(2)));
__device__ __forceinline__ float rrow(const float* ssp, int row, int fq) {
    const f32x4 p = *(const f32x4*)(ssp + (size_t)row * 16 + 4 * fq);
    float s = (p[0] + p[1]) + (p[2] + p[3]);
    s += __shfl_xor(s, 16); s += __shfl_xor(s, 32);
    return __builtin_amdgcn_rsqf(s * (1.0f / 1024.0f) + 1e-6f);
}
__device__ __forceinline__ f32x4 silu_mul(f32x4 g, f32x4 u) {
    f32x4 o;
#pragma unroll
    for (int e = 0; e < 4; ++e) { const float t = __builtin_amdgcn_exp2f(g[e] * -1.4426950408889634f); o[e] = g[e] * __builtin_amdgcn_rcpf(1.0f + t) * u[e]; }
    return o;
}
__device__ __forceinline__ u32x4 pack8(f32x4 a, f32x4 b) { u32x4 w; w.x = cvt_pk_bf16(a[0], a[1]); w.y = cvt_pk_bf16(a[2], a[3]); w.z = cvt_pk_bf16(b[0], b[1]); w.w = cvt_pk_bf16(b[2], b[3]); return w; }
__device__ __forceinline__ float dot4(f32x4 a) { return (a[0] * a[0] + a[1] * a[1]) + (a[2] * a[2] + a[3] * a[3]); }

struct EpiSwiGLU {
    static constexpr bool PERM = true, AFTER_DRAIN = false;
    bf16_t* H; const float* ssp;
    __device__ __forceinline__ void operator()(const f32x4 (&acc)[2][2][4][2], const Unit& u, int wr, int wc, int fr, int fq) const {
        const int row0 = u.pm * BM + wr * 64 + fr, hc0 = u.pn * 128 + wc * 32 + 8 * fq;
#pragma unroll
        for (int ai = 0; ai < 2; ++ai)
#pragma unroll
            for (int m = 0; m < 4; ++m) {
                const int row = row0 + ai * HALF + m * 16; const float r = rrow(ssp, row, fq);
                const f32x4 h0 = silu_mul(acc[ai][0][m][0] * r, acc[ai][1][m][0] * r), h1 = silu_mul(acc[ai][0][m][1] * r, acc[ai][1][m][1] * r);
                *(u32x4*)(H + (size_t)row * 2816 + hc0) = pack8(h0, h1);
            }
    }
};
struct EpiResid {
    static constexpr bool PERM = true, AFTER_DRAIN = false;
    const float* R; float* OUT; bf16_t* XB; float* ssp; float alpha; int wb;
    __device__ __forceinline__ void operator()(const f32x4 (&acc)[2][2][4][2], const Unit& u, int wr, int wc, int fr, int fq) const {
        const int row0 = u.pm * BM + wr * 64 + fr, c0 = u.pn * BM + wc * 32 + 8 * fq;
#pragma unroll
        for (int ai = 0; ai < 2; ++ai)
#pragma unroll
            for (int m = 0; m < 4; ++m) {
                const int row = row0 + ai * HALF + m * 16; float ss = 0.f;
#pragma unroll
                for (int bj = 0; bj < 2; ++bj) {
                    const size_t off = (size_t)row * 1024 + c0 + bj * HALF;
                    const f32x4 b0 = *(const f32x4*)(R + off), b1 = *(const f32x4*)(R + off + 4);
                    const f32x4 o0 = b0 + acc[ai][bj][m][0] * alpha, o1 = b1 + acc[ai][bj][m][1] * alpha;
                    *(f32x4*)(OUT + off) = o0; *(f32x4*)(OUT + off + 4) = o1;
                    if (wb) { *(u32x4*)(XB + off) = pack8(o0, o1); ss += dot4(o0) + dot4(o1); }
                }
                if (wb) { ss += __shfl_xor(ss, 16); ss += __shfl_xor(ss, 32); if (fq == 0) ssp[(size_t)row * 16 + u.pn * 4 + wc] = ss; }
            }
    }
};
struct EpiInProj {
    static constexpr bool PERM = true, AFTER_DRAIN = false;
    const float* ssp; bf16_t *Q, *K, *V, *U, *QI, *KI; float* WI; const float *qn, *kn, *cosH, *sinH, *cosI, *sinI; float qscale;
    __device__ __forceinline__ void operator()(const f32x4 (&acc)[2][2][4][2], const Unit& u, int wr, int wc, int fr, int fq) const {
        const int row0 = u.pm * BM + wr * 64 + fr, pn = u.pn;
#pragma unroll
        for (int ai = 0; ai < 2; ++ai)
#pragma unroll
            for (int m = 0; m < 4; ++m) {
                const int row = row0 + ai * HALF + m * 16, pos = row & 2047; const float r = rrow(ssp, row, fq);
                const f32x4 a00 = acc[ai][0][m][0] * r, a01 = acc[ai][0][m][1] * r, a10 = acc[ai][1][m][0] * r, a11 = acc[ai][1][m][1] * r;
                if (pn < 4) {
                    float ss = (dot4(a00) + dot4(a01)) + (dot4(a10) + dot4(a11));
                    ss += __shfl_xor(ss, 16); ss += __shfl_xor(ss, 32);
                    const float rh = __builtin_amdgcn_rsqf(ss * (1.0f / 64.0f) + 1e-6f);
                    const float* gp = (pn < 2) ? qn : kn;
                    const f32x4 g00 = *(const f32x4*)(gp + 8 * fq), g01 = *(const f32x4*)(gp + 8 * fq + 4), g10 = *(const f32x4*)(gp + 32 + 8 * fq), g11 = *(const f32x4*)(gp + 36 + 8 * fq);
                    const f32x4 x1a = a00 * rh * g00, x1b = a01 * rh * g01, x2a = a10 * rh * g10, x2b = a11 * rh * g11;
                    const f32x4 ca = *(const f32x4*)(cosH + pos * 32 + 8 * fq), cb = *(const f32x4*)(cosH + pos * 32 + 8 * fq + 4);
                    const f32x4 sa = *(const f32x4*)(sinH + pos * 32 + 8 * fq), sb = *(const f32x4*)(sinH + pos * 32 + 8 * fq + 4);
                    const float sc = (pn < 2) ? qscale : 1.0f;
                    const f32x4 o1a = (x1a * ca - x2a * sa) * sc, o1b = (x1b * cb - x2b * sb) * sc, o2a = (x2a * ca + x1a * sa) * sc, o2b = (x2b * cb + x1b * sb) * sc;
                    bf16_t* dst = ((pn < 2) ? Q : K) + (size_t)row * 512 + ((pn & 1) * 4 + wc) * 64 + 8 * fq;
                    *(u32x4*)dst = pack8(o1a, o1b); *(u32x4*)(dst + 32) = pack8(o2a, o2b);
                } else if (pn < 8) {
                    bf16_t* dst = ((pn < 6) ? V : U) + (size_t)row * 512 + (pn & 1) * 256 + wc * 32 + 8 * fq;
                    *(u32x4*)dst = pack8(a00, a01); *(u32x4*)(dst + 128) = pack8(a10, a11);
                } else if (pn == 8 || wc == 0) {
                    const int tq = (fq & 1) * 8;
                    f32x4 ca = *(const f32x4*)(cosI + pos * 16 + tq), cb = *(const f32x4*)(cosI + pos * 16 + tq + 4);
                    f32x4 sa = *(const f32x4*)(sinI + pos * 16 + tq), sb = *(const f32x4*)(sinI + pos * 16 + tq + 4);
                    if (fq >= 2) { ca = (f32x4){1.f, 1.f, 1.f, 1.f}; cb = ca; sa = (f32x4){0.f, 0.f, 0.f, 0.f}; sb = sa; }
                    const f32x4 o1a = a00 * ca - a10 * sa, o1b = a01 * cb - a11 * sb, o2a = a10 * ca + a00 * sa, o2b = a11 * cb + a01 * sb;
                    const int d1 = 8 * fq + ((fq >= 2) ? 16 : 0);
                    bf16_t* dst = (pn == 8) ? (QI + (size_t)row * 256 + wc * 64 + d1) : (KI + (size_t)row * 64 + d1);
                    *(u32x4*)dst = pack8(o1a, o1b); *(u32x4*)(dst + 16) = pack8(o2a, o2b);
                } else if (wc == 1) {
                    if (fq == 0) *(f32x4*)(WI + (size_t)row * 4) = a00 * 0.0625f;
                }
            }
    }
};
template <class Epi, class Sched, bool ALIGN_EPI = false, bool SP2 = false>
__device__ __forceinline__ void gemm_phase(PG8_LAS unsigned char* lds, const Gemm g, const Sched& S, const Epi& E) {
    const int tid = threadIdx.x, wid = __builtin_amdgcn_readfirstlane(tid >> 6), lane = tid & 63, wr = wid >> 2, wc = wid & 3, fr = lane & 15, fq = lane >> 4;
    const int K = g.K, nt = K / BK;
    unsigned voffA[2], voffB[2];
#pragma unroll
    for (int i = 0; i < 2; ++i) { int R, C; stage_rc(tid * 16 + i * 8192, R, C); const int Rb = Epi::PERM ? ((R & ~31) + perm32(R & 31)) : R;
        voffA[i] = (unsigned)(R * K + C) * 2u; voffB[i] = (unsigned)(Rb * K + C) * 2u; }
    const size_t kstep = (size_t)(BK * 2);
    const size_t hstep = (size_t)HALF * K * 2;
    const size_t tstep = 2 * hstep;
    const unsigned ldsw = (unsigned)wid * 1024u;
    const int aoff = lds_byte(wr * 64 + fr, fq * 8), boff = lds_byte(wc * 32 + fr, fq * 8);
#define PG8_SA(b, h) (((b) * 2 + (h)) * HTB)
#define PG8_SB(b, h) ((4 + (b) * 2 + (h)) * HTB)
#define PG8_STAGE(bufoff, gbase, voff) do { _Pragma("unroll") for (int _i = 0; _i < 2; ++_i) \
        __builtin_amdgcn_global_load_lds((const unsigned*)((const char*)(gbase) + (voff)[_i]), (PG8_LAS unsigned*)(lds + (bufoff) + ldsw + _i * 8192), 16, 0, 0); } while (0)
#define PG8_LDA(dst, b, h) do { _Pragma("unroll") for (int m = 0; m < 4; ++m) _Pragma("unroll") for (int k = 0; k < 2; ++k) dst[m][k] = *(const PG8_LAS bf16x8*)(lds + PG8_SA(b, h) + aoff + m * 2048 + k * 1024); } while (0)
#define PG8_LDB(dst, b, h) do { _Pragma("unroll") for (int n = 0; n < 2; ++n) _Pragma("unroll") for (int k = 0; k < 2; ++k) dst[n][k] = *(const PG8_LAS bf16x8*)(lds + PG8_SB(b, h) + boff + n * 2048 + k * 1024); } while (0)
#define PG8_MMA(ai, bj, At, Bt) do { __builtin_amdgcn_s_setprio(1); _Pragma("unroll") for (int m = 0; m < 4; ++m) _Pragma("unroll") for (int n = 0; n < 2; ++n) _Pragma("unroll") for (int k = 0; k < 2; ++k) \
        acc[ai][bj][m][n] = __builtin_amdgcn_mfma_f32_16x16x32_bf16(Bt[n][k], At[m][k], acc[ai][bj][m][n], 0, 0, 0); __builtin_amdgcn_s_setprio(0); } while (0)
#define PG8_WAIT_V(n) asm volatile("s_waitcnt vmcnt(" #n ")" ::: "memory")
#define PG8_WAIT_L(n) asm volatile("s_waitcnt lgkmcnt(" #n ")" ::: "memory")
#define PG8_BAR __builtin_amdgcn_s_barrier()
#define PG8_SCHED __builtin_amdgcn_sched_barrier(0)
    Unit cur, nxt; int ui = 0;
    if (!S.next(0, cur)) return;
    f32x4 acc[2][2][4][2];
#pragma unroll
    for (int a = 0; a < 2; ++a)
#pragma unroll
        for (int b = 0; b < 2; ++b)
#pragma unroll
            for (int m = 0; m < 4; ++m)
#pragma unroll
                for (int n = 0; n < 2; ++n) acc[a][b][m][n] = (f32x4){0.f, 0.f, 0.f, 0.f};
    bf16x8 At[4][2], B0[2][2], B1[2][2];
    const char* cA = (const char*)g.A + (size_t)cur.pm * tstep; const char* cB = (const char*)g.Bt + (size_t)cur.pn * tstep;
    S.a_ready(cur);
    if constexpr (SP2) {
        PG8_STAGE(PG8_SB(0, 0), cB, voffB); PG8_STAGE(PG8_SB(0, 1), cB + hstep, voffB); PG8_STAGE(PG8_SA(0, 0), cA, voffA); PG8_STAGE(PG8_SA(0, 1), cA + hstep, voffA);
        if (wr == 1) PG8_BAR;
        PG8_WAIT_V(2); PG8_BAR;
        PG8_STAGE(PG8_SB(1, 0), cB + kstep, voffB); PG8_STAGE(PG8_SA(1, 0), cA + kstep, voffA); PG8_STAGE(PG8_SB(1, 1), cB + hstep + kstep, voffB);
        PG8_WAIT_V(6); PG8_BAR;
    } else {
        PG8_STAGE(PG8_SB(0, 0), cB, voffB); PG8_STAGE(PG8_SA(0, 0), cA, voffA); PG8_STAGE(PG8_SB(0, 1), cB + hstep, voffB); PG8_STAGE(PG8_SA(0, 1), cA + hstep, voffA);
        if (wr == 1) PG8_BAR;
        PG8_WAIT_V(4); PG8_BAR;
        PG8_STAGE(PG8_SB(1, 0), cB + kstep, voffB); PG8_STAGE(PG8_SA(1, 0), cA + kstep, voffA); PG8_STAGE(PG8_SB(1, 1), cB + hstep + kstep, voffB);
        PG8_WAIT_V(6); PG8_BAR;
    }
    for (;;) {
        const bool has_next = S.next(ui + 1, nxt);
        const char* nA = has_next ? (const char*)g.A + (size_t)nxt.pm * tstep : cA; const char* nB = has_next ? (const char*)g.Bt + (size_t)nxt.pn * tstep : cB;
        for (int t = 0; t < nt; t += 2) {
            const bool last = (t == nt - 2);
            const char* a1 = cA + (size_t)(t + 1) * kstep;
            const char* a2 = last ? nA : cA + (size_t)(t + 2) * kstep; const char* b2 = last ? nB : cB + (size_t)(t + 2) * kstep;
            const char* a3 = a2 + kstep; const char* b3 = b2 + kstep;
            if (last && has_next) S.a_ready(nxt);
            if constexpr (SP2) {
            PG8_LDB(B0, 0, 0); PG8_LDB(B1, 0, 1); PG8_SCHED; PG8_LDA(At, 0, 0); PG8_STAGE(PG8_SA(1, 1), a1 + hstep, voffA);
            PG8_WAIT_V(8); PG8_WAIT_L(0); PG8_BAR; PG8_MMA(0, 0, At, B0); PG8_MMA(0, 1, At, B1); PG8_BAR; PG8_SCHED;
            PG8_LDA(At, 0, 1); PG8_STAGE(PG8_SB(0, 0), b2, voffB); PG8_STAGE(PG8_SB(0, 1), b2 + hstep, voffB); PG8_STAGE(PG8_SA(0, 0), a2, voffA);
            PG8_WAIT_V(8); PG8_WAIT_L(0); PG8_BAR; PG8_MMA(1, 0, At, B0); PG8_MMA(1, 1, At, B1); PG8_BAR; PG8_SCHED;
            PG8_LDB(B0, 1, 0); PG8_LDB(B1, 1, 1); PG8_SCHED; PG8_LDA(At, 1, 0); PG8_STAGE(PG8_SA(0, 1), a2 + hstep, voffA);
            PG8_WAIT_V(8); PG8_WAIT_L(0); PG8_BAR; PG8_MMA(0, 0, At, B0); PG8_MMA(0, 1, At, B1); PG8_BAR; PG8_SCHED;
            PG8_LDA(At, 1, 1); PG8_STAGE(PG8_SB(1, 0), b3, voffB); PG8_STAGE(PG8_SB(1, 1), b3 + hstep, voffB); PG8_STAGE(PG8_SA(1, 0), a3, voffA);
            PG8_WAIT_V(8); PG8_WAIT_L(0); PG8_BAR; PG8_MMA(1, 0, At, B0); PG8_MMA(1, 1, At, B1); PG8_BAR; PG8_SCHED;
            } else {
            PG8_LDB(B0, 0, 0); PG8_SCHED; PG8_LDA(At, 0, 0); PG8_STAGE(PG8_SA(1, 1), a1 + hstep, voffA);
            PG8_WAIT_L(8); PG8_BAR; PG8_WAIT_L(0); PG8_MMA(0, 0, At, B0); PG8_BAR; PG8_SCHED;
            PG8_LDB(B1, 0, 1); PG8_STAGE(PG8_SB(0, 0), b2, voffB);
            PG8_BAR; PG8_WAIT_L(0); PG8_MMA(0, 1, At, B1); PG8_BAR;
            PG8_LDA(At, 0, 1); PG8_STAGE(PG8_SA(0, 0), a2, voffA);
            PG8_BAR; PG8_WAIT_L(0); PG8_MMA(1, 0, At, B0); PG8_BAR; PG8_SCHED;
            PG8_STAGE(PG8_SB(0, 1), b2 + hstep, voffB);
            PG8_WAIT_V(6); PG8_BAR; PG8_MMA(1, 1, At, B1); PG8_BAR;
            PG8_LDB(B0, 1, 0); PG8_SCHED; PG8_LDA(At, 1, 0); PG8_STAGE(PG8_SA(0, 1), a2 + hstep, voffA);
            PG8_WAIT_L(8); PG8_BAR; PG8_WAIT_L(0); PG8_MMA(0, 0, At, B0); PG8_BAR; PG8_SCHED;
            PG8_LDB(B1, 1, 1); PG8_STAGE(PG8_SB(1, 0), b3, voffB);
            PG8_BAR; PG8_WAIT_L(0); PG8_MMA(0, 1, At, B1); PG8_BAR;
            PG8_LDA(At, 1, 1); PG8_STAGE(PG8_SA(1, 0), a3, voffA);
            PG8_BAR; PG8_WAIT_L(0); PG8_MMA(1, 0, At, B0); PG8_BAR; PG8_SCHED;
            PG8_STAGE(PG8_SB(1, 1), b3 + hstep, voffB);
            PG8_WAIT_V(6); PG8_BAR; PG8_MMA(1, 1, At, B1); PG8_BAR;
            }
        }
        if constexpr (ALIGN_EPI) { if (wr == 0) PG8_BAR; }
        if constexpr (!Epi::AFTER_DRAIN) { E(acc, cur, wr, wc, fr, fq); S.done(cur); }
        if (!has_next) break;
#pragma unroll
        for (int a = 0; a < 2; ++a)
#pragma unroll
            for (int b = 0; b < 2; ++b)
#pragma unroll
                for (int m = 0; m < 4; ++m)
#pragma unroll
                    for (int n = 0; n < 2; ++n) acc[a][b][m][n] = (f32x4){0.f, 0.f, 0.f, 0.f};
        cur = nxt; cA = nA; cB = nB; ++ui;
        if constexpr (ALIGN_EPI) { if (wr == 1) PG8_BAR; }
    }
    PG8_WAIT_V(0);
    if constexpr (!ALIGN_EPI) { if (wr == 0) PG8_BAR; }
    PG8_BAR;
    if constexpr (Epi::AFTER_DRAIN) { E.fused(acc, cur, wr, wc, fr, fq, lds, wid, lane); S.done(cur); }
#undef PG8_SA
#undef PG8_SB
#undef PG8_STAGE
#undef PG8_LDA
#undef PG8_LDB
#undef PG8_MMA
#undef PG8_WAIT_V
#undef PG8_WAIT_L
#undef PG8_BAR
#undef PG8_SCHED
}
}


#ifndef PG8_SP2
#define PG8_SP2 true
#endif
#ifndef PG8_ALIGN
#define PG8_ALIGN true
#endif

constexpr int NWAVES = 8;
constexpr int BATCH = 8, SEQ = 2048, D = 1024, M = BATCH * SEQ, DFF = 2816, NGU = 2 * DFF, NIN = 2560, INC = 2372;
constexpr size_t MiB = 1u << 20;
constexpr size_t WS_CTL = 0, CTL_ZERO_BYTES = 1 * MiB;
constexpr size_t WS_SSPA = 2 * MiB, WS_SSPB = 3 * MiB;
constexpr size_t WS_TAB = 4 * MiB;
constexpr size_t WS_WI = 5 * MiB;
constexpr size_t WS_MASK = 6 * MiB;
constexpr size_t WS_WGU1 = 10 * MiB, WS_WD1 = 21 * MiB, WS_WIN = 27 * MiB, WS_WOUT = 32 * MiB, WS_WGU2 = 34 * MiB, WS_WD2 = 45 * MiB;
constexpr size_t WS_XB = 52 * MiB;
constexpr size_t WS_MIX = 84 * MiB;
constexpr size_t WS_H = 116 * MiB;
constexpr size_t WS_Q = 116 * MiB, WS_K = 132 * MiB, WS_V = 148 * MiB, WS_U = 164 * MiB, WS_QI = 180 * MiB, WS_KI = 188 * MiB;
constexpr size_t WS_END = 204 * MiB;
constexpr int CW_BAR = 4096;
constexpr int RING_OFF = 0, RING_BYTES = 131072;
constexpr int LDS_BYTES = 163840;
constexpr int LDSCTL_OFF = LDS_BYTES - 1024, MISC_OFF = LDSCTL_OFF + 320;
constexpr float C2 = 0.125f * 1.4426950408889634f;

#define GAS __attribute__((address_space(1)))
#define LAS __attribute__((address_space(3)))
typedef unsigned short bf16;
typedef unsigned v4u __attribute__((ext_vector_type(4)));
typedef float f32x4 __attribute__((ext_vector_type(4)));
typedef short bf16x8 __attribute__((ext_vector_type(8)));
typedef GAS unsigned gu32;
typedef GAS unsigned long long gu64;
#define RLX_AGENT __ATOMIC_RELAXED, __HIP_MEMORY_SCOPE_AGENT
#define LDS_WAIT() asm volatile("s_waitcnt lgkmcnt(0)" ::: "memory")
#define VM_WAIT() asm volatile("s_waitcnt vmcnt(0)" ::: "memory")
__device__ __forceinline__ unsigned long long rt() { return __builtin_amdgcn_s_memrealtime(); }
__device__ __forceinline__ unsigned f2bf(float f) { unsigned u = __builtin_bit_cast(unsigned, f); return (u + 0x7fffu + ((u >> 16) & 1u)) >> 16; }
__device__ __forceinline__ unsigned pk2(float lo, float hi) { return f2bf(lo) | (f2bf(hi) << 16); }

#define XB_TMO      128
#define XB_XCNT(j)  (256  + 64 * (j))
#define XB_XSUB(j)  (1280 + 64 * (j))
#define XB_XGEN(j)  (2304 + 64 * (j))
#define XB_TOP      3328
#define XB_TOPGEN   3392
#define XCD_BAR_WORDS 3456
#define XB_SPIN_CAP (1u << 18)

__device__ __forceinline__ unsigned xb_ld(unsigned* p)              { return __hip_atomic_load(p, __ATOMIC_RELAXED, __HIP_MEMORY_SCOPE_AGENT); }
__device__ __forceinline__ unsigned xb_add(unsigned* p, unsigned v) { return __hip_atomic_fetch_add(p, v, __ATOMIC_RELAXED, __HIP_MEMORY_SCOPE_AGENT); }
__device__ __forceinline__ unsigned xb_xcc_id() { return (unsigned)__builtin_amdgcn_s_getreg((3 << 11) | 20) & 0xFu; }
#define XB_SPIN(cond, bar) do { unsigned _sp = 0; while (cond) { __builtin_amdgcn_s_sleep(1); \
    if ((++_sp & 255u) == 0u) { if (xb_ld(&(bar)[XB_TMO])) break; if (_sp > XB_SPIN_CAP) { atomicAdd(&(bar)[XB_TMO], 1u); break; } } } } while (0)

struct XcdBarrier {
    unsigned* bar; unsigned x;
    volatile LAS unsigned* st;
};

__device__ __forceinline__ XcdBarrier xcd_barrier_post(unsigned* bar, volatile LAS unsigned* st) {
    XcdBarrier b; b.bar = bar; b.x = xb_xcc_id(); b.st = st;
    if (threadIdx.x == 0) (void)xb_add(&bar[XB_XCNT(b.x)], 1u);
    return b;
}
__device__ __forceinline__ void xcd_barrier_complete(unsigned* bar, unsigned x, unsigned& nloc, unsigned& nx) {
    const unsigned G = gridDim.x * gridDim.y * gridDim.z;
    unsigned sum, cnt, mine, sp = 0u;
    for (;;) {
        sum = 0u; cnt = 0u; mine = 0u;
#pragma unroll
        for (unsigned j = 0; j < 16; ++j) { const unsigned c = xb_ld(&bar[XB_XCNT(j)]); sum += c; cnt += (c > 0u) ? 1u : 0u; mine = (j == x) ? c : mine; }
        if (sum == G) break;
        __builtin_amdgcn_s_sleep(1);
        if ((++sp & 255u) == 0u) { if (xb_ld(&bar[XB_TMO])) break; if (sp > XB_SPIN_CAP) { atomicAdd(&bar[XB_TMO], 1u); break; } }
    }
    nloc = mine > 0u ? mine : 1u; nx = cnt > 0u ? cnt : 1u;
}

__device__ __forceinline__ void xcd_barrier(const XcdBarrier& b) {
    asm volatile("s_waitcnt vmcnt(0)" ::: "memory");
    __syncthreads();
    if (threadIdx.x == 0) {
        unsigned* bar = b.bar;
        __builtin_amdgcn_s_waitcnt(0);
        unsigned nloc = b.st[0], nx = b.st[1];
        if (nloc == 0u) { xcd_barrier_complete(bar, b.x, nloc, nx); b.st[0] = nloc; b.st[1] = nx; }
        const unsigned old = xb_add(&bar[XB_XSUB(b.x)], 1u);
        const unsigned gen = old / nloc;
        if (old + 1u == (gen + 1u) * nloc) {
            __builtin_amdgcn_fence(__ATOMIC_RELEASE, "agent");
            asm volatile("s_waitcnt vmcnt(0)" ::: "memory");
            const unsigned og = xb_add(&bar[XB_TOP], 1u);
            const unsigned tg = og / nx;
            if (og + 1u == (tg + 1u) * nx) xb_add(&bar[XB_TOPGEN], 1u);
            else XB_SPIN(xb_ld(&bar[XB_TOPGEN]) == tg, bar);
            __builtin_amdgcn_fence(__ATOMIC_ACQUIRE, "agent");
            xb_add(&bar[XB_XGEN(b.x)], 1u);
            asm volatile("s_waitcnt vmcnt(0)" ::: "memory");
        } else {
            XB_SPIN(xb_ld(&bar[XB_XGEN(b.x)]) == gen, bar);
            __builtin_amdgcn_fence(__ATOMIC_ACQUIRE, "agent");
            asm volatile("s_waitcnt vmcnt(0)" ::: "memory");
        }
    }
    __syncthreads();
}


struct Frame {
    LAS unsigned char* lds;
    volatile LAS unsigned* MISC;
    gu32* ctl;
    int tid, lane, wave;
    int vcu, G;
};
__device__ __forceinline__ float wave_sum(float v) {
#pragma unroll
    for (int o = 1; o < 64; o <<= 1) v += __shfl_xor(v, o);
    return v;
}
template <class Map>
__device__ __forceinline__ void transpose_item(const float* W, int K, int N, const float* gk, bf16* WT, int ldk, Map map, LAS float* scr, int item, int lane) {
    const int nblk = (N + 31) / 32, kb = item / nblk, nb = item % nblk, k0 = 64 * kb, n0 = 32 * nb;
    (void)K;
#pragma unroll 8
    for (int i = 0; i < 32; ++i) { const int kk = 2 * i + (lane >> 5), n = n0 + (lane & 31);
        float v = 0.f; if (n < N) { v = W[(size_t)(k0 + kk) * N + n]; if (gk) v *= gk[k0 + kk]; }
        scr[kk * 33 + (lane & 31)] = v; }
    LDS_WAIT(); asm volatile("" ::: "memory");
    const int c = lane & 7;
#pragma unroll
    for (int j = 0; j < 4; ++j) { const int nn = (lane >> 3) + 8 * j, n = n0 + nn; const LAS float* s = scr + (8 * c) * 33 + nn;
        if (n < N) { const int dst = map(n);
            v4u o; o.x = pk2(s[0 * 33], s[1 * 33]); o.y = pk2(s[2 * 33], s[3 * 33]); o.z = pk2(s[4 * 33], s[5 * 33]); o.w = pk2(s[6 * 33], s[7 * 33]);
            *(GAS v4u*)(WT + (size_t)dst * ldk + k0 + 8 * c) = o; } }
    LDS_WAIT(); asm volatile("" ::: "memory");
}
struct MapPlain { __device__ __forceinline__ int operator()(int n) const { return n; } };
struct MapGate { int add; __device__ __forceinline__ int operator()(int n) const { return 256 * (n >> 7) + (n & 127) + add; } };
__device__ __forceinline__ int idx_slot(int d) { return (d < 16) ? d : (d < 32) ? 128 + (d - 16) : (d < 48) ? 16 + (d - 32) : 128 + 16 + (d - 48); }
struct MapIn {
    __device__ __forceinline__ int operator()(int n) const {
        if (n < 1024) { const int kq = n >> 9, nn = n & 511, head = nn >> 6, d = nn & 63; return kq * 512 + 256 * (head >> 2) + 128 * (d >> 5) + 32 * (head & 3) + (d & 31); }
        if (n < 1536) return n;
        if (n < 1792) { const int nn = n - 1536, h = nn >> 6, d = nn & 63; return 2048 + 32 * h + idx_slot(d); }
        if (n < 1856) return 2304 + idx_slot(n - 1792);
        if (n < 1860) return 2304 + 32 + (n - 1856);
        return 1536 + (n - 1860);
    }
};

struct Args { const float* in[16]; float* out; unsigned char* ws; int ph_lo, ph_hi, li, pad; };

__device__ __forceinline__ void p0_prologue(Frame& F, const Args& a) {
    unsigned char* ws = a.ws;
    LAS float* scr = (LAS float*)(F.lds + RING_OFF + F.wave * 16384);
    const int gw = F.vcu * NWAVES + F.wave, NGW = F.G * NWAVES, lane = F.lane;
    const float *x = a.in[0], *f1n = a.in[1], *f1g = a.in[2], *f1u = a.in[3], *f1d = a.in[4], *mixn = a.in[5], *win = a.in[6], *poolw = a.in[9], *pools = a.in[10], *wout = a.in[11],
                *f2n = a.in[12], *f2g = a.in[13], *f2u = a.in[14], *f2d = a.in[15];
    bf16* WGU1 = (bf16*)(ws + WS_WGU1); bf16* WD1 = (bf16*)(ws + WS_WD1); bf16* WIN = (bf16*)(ws + WS_WIN); bf16* WOUT = (bf16*)(ws + WS_WOUT); bf16* WGU2 = (bf16*)(ws + WS_WGU2); bf16* WD2 = (bf16*)(ws + WS_WD2);
    constexpr int I_G = (D / 64) * (DFF / 32), I_D = (DFF / 64) * (D / 32), I_IN = (D / 64) * ((INC + 31) / 32), I_O = (512 / 64) * (D / 32);
    constexpr int NITEMS = 4 * I_G + 2 * I_D + I_IN + I_O;
    for (int it = gw; it < NITEMS; it += NGW) {
        int r = it;
        if (r < I_G) { transpose_item(f1g, D, DFF, f1n, WGU1, D, MapGate{0}, scr, r, lane); continue; } r -= I_G;
        if (r < I_G) { transpose_item(f1u, D, DFF, f1n, WGU1, D, MapGate{128}, scr, r, lane); continue; } r -= I_G;
        if (r < I_G) { transpose_item(f2g, D, DFF, f2n, WGU2, D, MapGate{0}, scr, r, lane); continue; } r -= I_G;
        if (r < I_G) { transpose_item(f2u, D, DFF, f2n, WGU2, D, MapGate{128}, scr, r, lane); continue; } r -= I_G;
        if (r < I_D) { transpose_item(f1d, DFF, D, nullptr, WD1, DFF, MapPlain{}, scr, r, lane); continue; } r -= I_D;
        if (r < I_D) { transpose_item(f2d, DFF, D, nullptr, WD2, DFF, MapPlain{}, scr, r, lane); continue; } r -= I_D;
        if (r < I_IN) { transpose_item(win, D, INC, mixn, WIN, D, MapIn{}, scr, r, lane); continue; } r -= I_IN;
        transpose_item(wout, 512, D, nullptr, WOUT, D, MapPlain{}, scr, r, lane);
    }
    for (int j = gw; j < 256; j += NGW) {
        const int bj = j >> 7, wc = (j >> 5) & 3, i = j & 31;
        const bool covered = (wc == 0) || (wc == 1 && bj == 0 && i < 4);
        if (!covered) { GAS v4u* o = (GAS v4u*)(WIN + (size_t)(2304 + j) * D) + lane; o[0] = (v4u){0u, 0u, 0u, 0u}; o[64] = (v4u){0u, 0u, 0u, 0u}; }
    }
    for (int it = gw; it < 4 * 16 * 8; it += NGW) {
        const int g = it >> 7, nb = (it >> 3) & 15, cb = it & 7, n = nb * 64 + lane;
        float ac[16];
#pragma unroll
        for (int cc = 0; cc < 16; ++cc) ac[cc] = 0.f;
        const float* pw = poolw + ((size_t)g * 128 + cb * 16) * 128;
#pragma unroll 4
        for (int d = 0; d < 128; ++d) {
            const float w = wout[(size_t)(512 + g * 128 + d) * D + n] * pools[g * 128 + d];
#pragma unroll
            for (int cc = 0; cc < 16; ++cc) ac[cc] = fmaf(pw[cc * 128 + d], w, ac[cc]);
        }
        GAS v4u* o = (GAS v4u*)(WOUT + (size_t)n * D + 512 + g * 128 + cb * 16);
        o[0] = (v4u){pk2(ac[0], ac[1]), pk2(ac[2], ac[3]), pk2(ac[4], ac[5]), pk2(ac[6], ac[7])};
        o[1] = (v4u){pk2(ac[8], ac[9]), pk2(ac[10], ac[11]), pk2(ac[12], ac[13]), pk2(ac[14], ac[15])};
    }
    float* cosH = (float*)(ws + WS_TAB); float* sinH = cosH + SEQ * 32; float* cosI = sinH + SEQ * 32; float* sinI = cosI + SEQ * 16;
    for (int idx = gw * 64 + lane; idx < SEQ * 48; idx += NGW * 64) {
        if (idx < SEQ * 32) { const int p = idx >> 5, i = idx & 31; const float inv = (float)pow(10000.0, -(double)i / 32.0); const float ang = __fmul_rn((float)p, inv); cosH[idx] = (float)cos((double)ang); sinH[idx] = (float)sin((double)ang); }
        else { const int j = idx - SEQ * 32, p = j >> 4, i = j & 15; const float inv = (float)pow(10000.0, -(double)i / 16.0); const float ang = __fmul_rn((float)p, inv); cosI[j] = (float)cos((double)ang); sinI[j] = (float)sin((double)ang); }
    }
    bf16* XB = (bf16*)(ws + WS_XB); float* sspA = (float*)(ws + WS_SSPA);
    for (int m = gw; m < M; m += NGW) {
        const GAS f32x4* xr = (const GAS f32x4*)(x + (size_t)m * D) + lane; f32x4 v[4]; float s = 0.f;
#pragma unroll
        for (int j = 0; j < 4; ++j) { v[j] = xr[64 * j]; s += (v[j].x * v[j].x + v[j].y * v[j].y) + (v[j].z * v[j].z + v[j].w * v[j].w); }
        s = wave_sum(s);
        GAS unsigned long long* o8 = (GAS unsigned long long*)(XB + (size_t)m * D) + lane;
#pragma unroll
        for (int j = 0; j < 4; ++j) o8[64 * j] = (unsigned long long)pk2(v[j].x, v[j].y) | ((unsigned long long)pk2(v[j].z, v[j].w) << 32);
        if (lane < 16) sspA[(size_t)m * 16 + lane] = (lane == 0) ? s : 0.f;
    }
}

__device__ __forceinline__ float bf2f(bf16 v) { return __uint_as_float((unsigned)v << 16); }
__device__ __forceinline__ unsigned sortable(float f) { const unsigned u = __float_as_uint(f); return (u & 0x80000000u) ? ~u : (u | 0x80000000u); }
__device__ __forceinline__ int block_sum_i(int v, int* s_red) {
#pragma unroll
    for (int o = 1; o < 64; o <<= 1) v += __shfl_xor(v, o);
    __syncthreads();
    if ((threadIdx.x & 63) == 0) s_red[threadIdx.x >> 6] = v;
    __syncthreads();
    return s_red[0] + s_red[1] + s_red[2] + s_red[3];
}
__device__ __forceinline__ float block_max_f(float v, float* s_red) {
#pragma unroll
    for (int o = 1; o < 64; o <<= 1) v = fmaxf(v, __shfl_xor(v, o));
    __syncthreads();
    if ((threadIdx.x & 63) == 0) s_red[threadIdx.x >> 6] = v;
    __syncthreads();
    return fmaxf(fmaxf(s_red[0], s_red[1]), fmaxf(s_red[2], s_red[3]));
}
__device__ __forceinline__ float block_sum_f(float v, float* s_red) {
#pragma unroll
    for (int o = 1; o < 64; o <<= 1) v += __shfl_xor(v, o);
    __syncthreads();
    if ((threadIdx.x & 63) == 0) s_red[threadIdx.x >> 6] = v;
    __syncthreads();
    return (s_red[0] + s_red[1]) + (s_red[2] + s_red[3]);
}
__global__ __launch_bounds__(256) void k_dsa_b(const bf16* q, const bf16* k, const bf16* v, const bf16* qi, const bf16* ki, const float* wi, bf16* mix, float qmul, const unsigned long long* mask) {
    constexpr int S = 2048, TOPK = 256;
    const int row = blockIdx.x, b = row / S, t = row % S, tid = threadIdx.x;
    __shared__ float s_qi[256];
    __shared__ float s_w[4];
    __shared__ unsigned s_key[S];
    __shared__ int s_list[256];
    __shared__ float s_p[256];
    __shared__ float s_q[512];
    __shared__ int s_redi[4];
    __shared__ float s_redf[4];
    __shared__ int s_wcnt[4];
    __shared__ float s_part[4][64];
    s_qi[tid] = bf2f(qi[(size_t)row * 256 + tid]);
    if (tid < 4) s_w[tid] = wi[(size_t)row * 4 + tid];
    s_q[tid] = bf2f(q[(size_t)row * 512 + tid]) * qmul; s_q[tid + 256] = bf2f(q[(size_t)row * 512 + 256 + tid]) * qmul;
    __syncthreads();
    for (int s = tid; s < S; s += 256) {
        unsigned key = 0u;
        if (s <= t) {
            const bf16* kp = ki + (size_t)(b * S + s) * 64;
            float a0 = 0.f, a1 = 0.f, a2 = 0.f, a3 = 0.f;
            for (int d = 0; d < 64; ++d) { const float kv = bf2f(kp[d]); a0 = fmaf(s_qi[d], kv, a0); a1 = fmaf(s_qi[64 + d], kv, a1); a2 = fmaf(s_qi[128 + d], kv, a2); a3 = fmaf(s_qi[192 + d], kv, a3); }
            float sc = 0.f;
            sc = fmaf(s_w[0], fmaxf(a0, 0.f), sc); sc = fmaf(s_w[1], fmaxf(a1, 0.f), sc); sc = fmaf(s_w[2], fmaxf(a2, 0.f), sc); sc = fmaf(s_w[3], fmaxf(a3, 0.f), sc);
            key = sortable(sc);
        }
        s_key[s] = key;
    }
    __syncthreads();
    unsigned thr = 0u; int need_ties = 0;
    if (!mask && t + 1 > TOPK) {
        unsigned prefix = 0u;
        for (int bit = 31; bit >= 0; --bit) {
            const unsigned cand = prefix | (1u << bit);
            int c = 0;
            for (int s = tid; s <= t; s += 256) c += (s_key[s] >= cand) ? 1 : 0;
            c = block_sum_i(c, s_redi);
            if (c >= TOPK) prefix = cand;
        }
        thr = prefix;
        int c = 0;
        for (int s = tid; s <= t; s += 256) c += (s_key[s] > thr) ? 1 : 0;
        c = block_sum_i(c, s_redi);
        need_ties = TOPK - c;
    }
    int base = 0;
    for (int c0 = 0; c0 < S; c0 += 256) {
        const int s = c0 + tid;
        bool f = false;
        if (mask) { f = (mask[((size_t)b * 32 + (s >> 6)) * S + t] >> (s & 63)) & 1ull; }
        else if (s <= t) {
            const unsigned key = s_key[s];
            if (key > thr) f = true;
            else if (key == thr && need_ties > 0) { int r = 0; for (int s2 = 0; s2 < s; ++s2) r += (s_key[s2] == thr) ? 1 : 0; f = r < need_ties; }
        }
        const unsigned long long bal = __ballot(f);
        const int lane = tid & 63, wave = tid >> 6;
        const int pre = __popcll(bal & ((1ull << lane) - 1ull));
        __syncthreads();
        if (lane == 0) s_wcnt[wave] = __popcll(bal);
        __syncthreads();
        int off = base;
        for (int w = 0; w < wave; ++w) off += s_wcnt[w];
        if (f) s_list[off + pre] = s;
        base += s_wcnt[0] + s_wcnt[1] + s_wcnt[2] + s_wcnt[3];
    }
    __syncthreads();
    const int nsel = base;
    for (int h = 0; h < 8; ++h) {
        float lg = -INFINITY;
        if (tid < nsel) {
            const bf16* kp = k + (size_t)(b * S + s_list[tid]) * 512 + h * 64;
            float a = 0.f;
            for (int d = 0; d < 64; ++d) a = fmaf(s_q[h * 64 + d], bf2f(kp[d]), a);
            lg = a * 0.125f;
        }
        const float mx = block_max_f(lg, s_redf);
        const float e = (tid < nsel) ? expf(lg - mx) : 0.f;
        const float sum = block_sum_f(e, s_redf);
        s_p[tid] = e;
        __syncthreads();
        const int d = tid & 63, part = tid >> 6;
        float a = 0.f;
        for (int j = part; j < nsel; j += 4) a = fmaf(s_p[j], bf2f(v[(size_t)(b * S + s_list[j]) * 512 + h * 64 + d]), a);
        s_part[part][d] = a;
        __syncthreads();
        if (tid < 64) mix[(size_t)row * 1024 + h * 64 + tid] = (bf16)f2bf(((s_part[0][tid] + s_part[1][tid]) + (s_part[2][tid] + s_part[3][tid])) / sum);
        __syncthreads();
    }
}
__global__ __launch_bounds__(256) void k_pool_b(const bf16* u, bf16* mix) {
    const int row = blockIdx.x, t = row % 2048;
    for (int c = threadIdx.x; c < 512; c += 256) {
        const int g = c >> 7, w = 2 << g;
        const int n = (t + 1 < w) ? (t + 1) : w;
        float s = 0.f;
        for (int j = 0; j < n; ++j) s += bf2f(u[(size_t)(row - j) * 512 + c]);
        mix[(size_t)row * 1024 + 512 + c] = (bf16)f2bf(s / (float)n - bf2f(u[(size_t)row * 512 + c]));
    }
}

__device__ __forceinline__ int wave_sum_i(int v) {
#pragma unroll
    for (int o = 1; o < 64; o <<= 1) v += __shfl_xor(v, o);
    return v;
}
template <int NC>
__device__ __forceinline__ void select_row(const LAS unsigned* srow, int nchunks, int t, int lane, GAS unsigned long long* mrow) {
    unsigned kv[NC];
#pragma unroll
    for (int c = 0; c < NC; ++c) kv[c] = (c < nchunks) ? srow[64 * c + lane] : 0u;
    unsigned thr = 0u; int need = 0;
    if (t + 1 > 256) {
        unsigned prefix = 0u; bool exact = false;
        for (int bit = 31; bit >= 0; --bit) {
            const unsigned cand = prefix | (1u << bit);
            int cnt = 0;
#pragma unroll
            for (int c = 0; c < NC; ++c) cnt += (kv[c] >= cand) ? 1 : 0;
            cnt = __builtin_amdgcn_readfirstlane(wave_sum_i(cnt));
            if (cnt >= 256) prefix = cand;
            if (cnt == 256) { exact = true; break; }
        }
        if (exact) { thr = prefix - 1u; need = 0; }
        else {
            int cgt = 0;
#pragma unroll
            for (int c = 0; c < NC; ++c) cgt += (kv[c] > prefix) ? 1 : 0;
            cgt = __builtin_amdgcn_readfirstlane(wave_sum_i(cgt));
            thr = prefix; need = 256 - cgt;
        }
    }
    int tbase = 0;
    const unsigned long long lt = (1ull << lane) - 1ull;
#pragma unroll
    for (int c = 0; c < NC; ++c) {
        const bool eq = (kv[c] == thr);
        const unsigned long long em = __ballot(eq);
        const int pre = __popcll(em & lt);
        const bool sel = (kv[c] > thr) || (eq && (tbase + pre < need));
        tbase += __popcll(em);
        const unsigned long long m = __ballot(sel);
        if (lane == 0) mrow[(size_t)c * SEQ] = m;
    }
    if (lane >= NC && lane < 32) mrow[(size_t)lane * SEQ] = 0ull;
}
__device__ __forceinline__ void select_phase(Frame& F, const bf16* QI, const bf16* KI, const float* WI, unsigned long long* MASK, const bf16* U, bf16* MIX) {
    LAS unsigned* SC = (LAS unsigned*)(F.lds + RING_OFF);
    const int lane = F.lane, wave = F.wave, fr = lane & 15, fq = lane >> 4;
    for (int ui = 0; ui < 4; ++ui) {
        const int b = F.vcu >> 5, j = F.vcu & 31;
        const int g = (ui == 0) ? j : (ui == 1) ? 63 - j : (ui == 2) ? 64 + j : 127 - j;
        const int t0 = 16 * g; const size_t rowbase = (size_t)b * SEQ;
        const int nchunks = (t0 + 16 + 63) >> 6, ntiles = nchunks * 4;
        pg8::bf16x8 afr[4][2];
#pragma unroll
        for (int h = 0; h < 4; ++h)
#pragma unroll
            for (int ks = 0; ks < 2; ++ks) afr[h][ks] = *(const pg8::bf16x8*)(QI + (rowbase + t0 + fr) * 256 + 64 * h + 32 * ks + 8 * fq);
        f32x4 w[4];
#pragma unroll
        for (int r = 0; r < 4; ++r) w[r] = *(const f32x4*)(WI + (rowbase + t0 + 4 * fq + r) * 4);
        for (int tile = wave; tile < ntiles; tile += NWAVES) {
            const int key = 16 * tile + fr;
            const pg8::bf16x8 b0 = *(const pg8::bf16x8*)(KI + (rowbase + key) * 64 + 8 * fq), b1 = *(const pg8::bf16x8*)(KI + (rowbase + key) * 64 + 32 + 8 * fq);
            f32x4 acc[4];
#pragma unroll
            for (int h = 0; h < 4; ++h) {
                acc[h] = __builtin_amdgcn_mfma_f32_16x16x32_bf16(afr[h][0], b0, (f32x4){0.f, 0.f, 0.f, 0.f}, 0, 0, 0);
                acc[h] = __builtin_amdgcn_mfma_f32_16x16x32_bf16(afr[h][1], b1, acc[h], 0, 0, 0);
            }
#pragma unroll
            for (int r = 0; r < 4; ++r) {
                float sc = 0.f;
#pragma unroll
                for (int h = 0; h < 4; ++h) sc = fmaf(w[r][h], fmaxf(acc[h][r], 0.f), sc);
                const int trow = t0 + 4 * fq + r;
                SC[(4 * fq + r) * 2048 + key] = (key <= trow) ? sortable(sc) : 0u;
            }
        }
        LDS_WAIT(); __builtin_amdgcn_s_barrier(); asm volatile("" ::: "memory");
        const int ncr = (nchunks + 3) >> 2;
#pragma unroll 1
        for (int rr = 0; rr < 2; ++rr) {
            const int rl = 2 * wave + rr, t = t0 + rl;
            const LAS unsigned* srow = SC + rl * 2048;
            GAS unsigned long long* mrow = (GAS unsigned long long*)MASK + (size_t)b * 32 * SEQ + t;
            switch (ncr) {
                case 1: select_row<4>(srow, nchunks, t, lane, mrow); break;
                case 2: select_row<8>(srow, nchunks, t, lane, mrow); break;
                case 3: select_row<12>(srow, nchunks, t, lane, mrow); break;
                case 4: select_row<16>(srow, nchunks, t, lane, mrow); break;
                case 5: select_row<20>(srow, nchunks, t, lane, mrow); break;
                case 6: select_row<24>(srow, nchunks, t, lane, mrow); break;
                case 7: select_row<28>(srow, nchunks, t, lane, mrow); break;
                default: select_row<32>(srow, nchunks, t, lane, mrow); break;
            }
        }
        LDS_WAIT(); __builtin_amdgcn_s_barrier(); asm volatile("" ::: "memory");
    }
    const int gw = F.vcu * NWAVES + F.wave, NGW = F.G * NWAVES;
    for (int row = gw; row < M; row += NGW) {
        const int t = row & (SEQ - 1), wl = 2 << (lane >> 4), n = (t + 1 < wl) ? (t + 1) : wl;
        float s[8];
#pragma unroll
        for (int e = 0; e < 8; ++e) s[e] = 0.f;
        float u0[8];
#pragma unroll 1
        for (int jj = 0; jj < n; ++jj) {
            const v4u x = *(const GAS v4u*)(U + (size_t)(row - jj) * 512 + 8 * lane);
            float f[8]; f[0] = __uint_as_float(x.x << 16); f[1] = __uint_as_float(x.x & 0xffff0000u); f[2] = __uint_as_float(x.y << 16); f[3] = __uint_as_float(x.y & 0xffff0000u);
            f[4] = __uint_as_float(x.z << 16); f[5] = __uint_as_float(x.z & 0xffff0000u); f[6] = __uint_as_float(x.w << 16); f[7] = __uint_as_float(x.w & 0xffff0000u);
#pragma unroll
            for (int e = 0; e < 8; ++e) { s[e] += f[e]; if (jj == 0) u0[e] = f[e]; }
        }
        const float inv = 1.0f / (float)n;
        v4u o; o.x = pk2(s[0] * inv - u0[0], s[1] * inv - u0[1]); o.y = pk2(s[2] * inv - u0[2], s[3] * inv - u0[3]); o.z = pk2(s[4] * inv - u0[4], s[5] * inv - u0[5]); o.w = pk2(s[6] * inv - u0[6], s[7] * inv - u0[7]);
        *(GAS v4u*)(MIX + (size_t)row * 1024 + 512 + 8 * lane) = o;
    }
}

#include <hip/hip_bf16.h>
namespace attn_body {
using bf16=__hip_bfloat16;
using bf16x8=__attribute__((ext_vector_type(8)))short;
using s16x4=__attribute__((ext_vector_type(4)))short;
using f32x16=__attribute__((ext_vector_type(16)))float;
using u32x4=__attribute__((ext_vector_type(4)))unsigned;
constexpr int BATCH=8,NHEAD=8,SEQ=2048,D=64,KP=512,OP=1024;
constexpr int NW=8,QBLK=32,QB=QBLK*NW,KVBLK=64,NQB=SEQ/QB;
constexpr int ATTN_UNIT_ROWS=QB;
__device__ __forceinline__ int crow(int r,int hi){return (r&3)+8*(r>>2)+4*hi;}
#define SBAR() __builtin_amdgcn_sched_barrier(0)
__device__ __forceinline__ void cmask(f32x16&p0,f32x16&p1,int jb,int qrel,int hi){
  const float NEG=-INFINITY; int kb=64*jb+4*hi;
  #pragma unroll
  for(int r=0;r<16;++r){int kv=kb+(r&3)+8*(r>>2); if(kv>qrel)p0[r]=NEG; if(kv+32>qrel)p1[r]=NEG;}
}

constexpr int NSLOT=3, SLOTB=8192;
constexpr int LDS_K=0, LDS_V=NSLOT*SLOTB, LDS_WS=2*NSLOT*SLOTB, LDS_OST=LDS_WS+NW*64*4, LDS_BYTES=LDS_OST+NW*4096, LDS_MASK=LDS_BYTES, LDS_TOTAL=LDS_MASK+32*2048;
constexpr float C2=0.125f*1.4426950408889634f;
__device__ __forceinline__ void glds16(const void*gsrc,unsigned lds_dst){unsigned keep;
  asm volatile("s_mov_b32 %0, m0\n\ts_mov_b32 m0, %2\n\ts_nop 0\n\tglobal_load_lds_dwordx4 %1, off\n\ts_mov_b32 m0, %0":"=&s"(keep):"v"(gsrc),"s"(lds_dst):"memory");}
__device__ __forceinline__ float max3f(float a,float b,float c){float r;asm("v_max3_f32 %0, %1, %2, %3":"=v"(r):"v"(a),"v"(b),"v"(c));return r;}
__device__ __forceinline__ float max2f(float a,float b){float r;asm("v_max_f32_e32 %0, %1, %2":"=v"(r):"v"(a),"v"(b));return r;}
__device__ __forceinline__ float fadd_s(float a,float b){float r;asm("v_add_f32_e32 %0, %1, %2":"=v"(r):"v"(a),"v"(b));return r;}
__device__ __forceinline__ float fsub_s(float a,float b){float r;asm("v_sub_f32_e32 %0, %1, %2":"=v"(r):"v"(a),"v"(b));return r;}
typedef float f32x2_t __attribute__((ext_vector_type(2))); typedef __bf16 bf16x2_t __attribute__((ext_vector_type(2)));
__device__ __forceinline__ unsigned cvtpk_s(float lo,float hi){f32x2_t v={lo,hi};bf16x2_t b=__builtin_convertvector(v,bf16x2_t);return __builtin_bit_cast(unsigned,b);}
#define WAIT_BAR(N) asm volatile("s_waitcnt vmcnt(" #N ") lgkmcnt(0)\n\ts_barrier":::"memory")

__device__ __forceinline__ void qkt(f32x16&p0,f32x16&p1,const char*Kslot,const bf16x8*qr,const f32x16&negm,int r32,int hi){
  const char*kb=Kslot+hi*1024+r32*16;
  #pragma unroll
  for(int d0=0;d0<4;++d0){
    const bf16x8 b0=*reinterpret_cast<const bf16x8*>(kb+d0*2048);
    const bf16x8 b1=*reinterpret_cast<const bf16x8*>(kb+d0*2048+512);
    if(d0==0){p0=__builtin_amdgcn_mfma_f32_32x32x16_bf16(b0,qr[0],negm,0,0,0);p1=__builtin_amdgcn_mfma_f32_32x32x16_bf16(b1,qr[0],negm,0,0,0);}
    else{p0=__builtin_amdgcn_mfma_f32_32x32x16_bf16(b0,qr[d0],p0,0,0,0);p1=__builtin_amdgcn_mfma_f32_32x32x16_bf16(b1,qr[d0],p1,0,0,0);}}
}
typedef __attribute__((address_space(3))) const char* lds_cptr;
typedef short v4i16_t __attribute__((ext_vector_type(4)));
__device__ __forceinline__ void kload8(bf16x8*kf,lds_cptr kp){
  kf[0]=*(const __attribute__((address_space(3))) bf16x8*)(kp);      kf[1]=*(const __attribute__((address_space(3))) bf16x8*)(kp+512);
  kf[2]=*(const __attribute__((address_space(3))) bf16x8*)(kp+2048); kf[3]=*(const __attribute__((address_space(3))) bf16x8*)(kp+2560);
  kf[4]=*(const __attribute__((address_space(3))) bf16x8*)(kp+4096); kf[5]=*(const __attribute__((address_space(3))) bf16x8*)(kp+4608);
  kf[6]=*(const __attribute__((address_space(3))) bf16x8*)(kp+6144); kf[7]=*(const __attribute__((address_space(3))) bf16x8*)(kp+6656);
}
__device__ __forceinline__ void kload2(bf16x8*kf,lds_cptr kp,int j){ kf[2*j]=*(const __attribute__((address_space(3))) bf16x8*)(kp+j*2048); kf[2*j+1]=*(const __attribute__((address_space(3))) bf16x8*)(kp+j*2048+512); }
__device__ __forceinline__ s16x4 vtr(lds_cptr p){ return __builtin_bit_cast(s16x4,__builtin_amdgcn_ds_read_tr16_b64_v4i16((__attribute__((address_space(3))) v4i16_t*)p)); }
__device__ __forceinline__ float rowmax(const f32x16&p0,const f32x16&p1){
  float a=max3f(p0[0],p0[1],p1[0]),b=max3f(p0[2],p0[3],p1[1]);a=max3f(a,p1[2],p1[3]);
  #pragma unroll
  for(int r=4;r<16;r+=4){a=max3f(a,p0[r],p0[r+1]);b=max3f(b,p0[r+2],p0[r+3]);a=max3f(a,p1[r],p1[r+1]);b=max3f(b,p1[r+2],p1[r+3]);}
  const float m=max2f(a,b);
  auto rr=__builtin_amdgcn_permlane32_swap(__float_as_uint(m),__float_as_uint(m),false,false);
  return max2f(__uint_as_float(rr[0]),__uint_as_float(rr[1]));
}
__device__ __forceinline__ void pv(f32x16*o,int vb,bf16x8 pa0,bf16x8 pa1,bf16x8 pa2,bf16x8 pa3){
  #pragma unroll
  for(int d0=0;d0<2;++d0){s16x4 lo[4],hi[4];
    #pragma unroll
    for(int ks=0;ks<4;++ks){
      asm volatile("ds_read_b64_tr_b16 %0,%1 offset:%c2":"=&v"(lo[ks]):"v"(vb),"i"(d0*4096+ks*1024):"memory");
      asm volatile("ds_read_b64_tr_b16 %0,%1 offset:%c2":"=&v"(hi[ks]):"v"(vb),"i"(d0*4096+ks*1024+512):"memory");}
    asm volatile("s_waitcnt lgkmcnt(0)":::"memory");SBAR();
    #define PK(k) (bf16x8){lo[k][0],lo[k][1],lo[k][2],lo[k][3],hi[k][0],hi[k][1],hi[k][2],hi[k][3]}
    o[d0]=__builtin_amdgcn_mfma_f32_32x32x16_bf16(pa0,PK(0),o[d0],0,0,0);
    o[d0]=__builtin_amdgcn_mfma_f32_32x32x16_bf16(pa1,PK(1),o[d0],0,0,0);
    o[d0]=__builtin_amdgcn_mfma_f32_32x32x16_bf16(pa2,PK(2),o[d0],0,0,0);
    o[d0]=__builtin_amdgcn_mfma_f32_32x32x16_bf16(pa3,PK(3),o[d0],0,0,0);
    #undef PK
  }
}

#ifndef ATTN_STORE16
#define ATTN_STORE16(p,v) (*(u32x4*)(p)=(v))
#endif
template<int THRL> __device__ __forceinline__ void attn_unit(int b,int h,int qb,const bf16*Q,const bf16*__restrict__ K,const bf16*__restrict__ V,bf16*O,const unsigned long long*MASKT,char*shm){
  const int tid=threadIdx.x,lane=tid&63,r32=lane&31,hi=lane>>5; const int wid=__builtin_amdgcn_readfirstlane(tid>>6);
  const long rowbase=(long)b*SEQ; const int q0=qb*QB; const int NT=(q0+QB)/KVBLK;
  const bf16*Qw=Q+(rowbase+q0+wid*QBLK)*KP+h*D;
  const bf16*Kh=K+rowbase*KP+h*D,*Vh=V+rowbase*KP+h*D;
  const unsigned lds0=(unsigned)(uintptr_t)shm;
  float*wsf=(float*)(shm+LDS_WS)+wid*64;
  const bf16*ksrc=Kh+(long)lane*KP+wid*8;
  const bf16*vsrc=Vh+(long)(16*(wid&3)+(lane>>2))*KP+(wid>>2)*32+(lane&3)*8;
  const unsigned kdst=lds0+LDS_K+wid*1024, vdst=lds0+LDS_V+wid*1024;
  #define DMA_K(t,slot) glds16(ksrc+(long)(t)*KVBLK*KP,(unsigned)__builtin_amdgcn_readfirstlane(kdst+(slot)))
  #define DMA_V(t,slot) glds16(vsrc+(long)(t)*KVBLK*KP,(unsigned)__builtin_amdgcn_readfirstlane(vdst+(slot)))
  const int vb0=(int)(lds0+LDS_V)+((lane>>4)&1)*32+(lane&3)*8+(4*hi+((lane&15)>>2))*64;
  const char*Kbase=shm+LDS_K; bf16x8 kf[8];
  const lds_cptr shm3=(lds_cptr)shm; const lds_cptr kp0=shm3+LDS_K+hi*1024+r32*16; const lds_cptr vp0=shm3+LDS_V+((lane>>4)&1)*32+(lane&3)*8+(4*hi+((lane&15)>>2))*64;
  { int tl=tid; asm volatile("":"+v"(tl));
    const int npc=NT*128; const unsigned long long*msrc=MASKT+((long)b*32)*SEQ+q0; u32x4 mv[8];
    #pragma unroll
    for(int i=0;i<8;++i){ const int p=tl+i*NW*64; if(p<npc)mv[i]=*reinterpret_cast<const u32x4*>(msrc+(long)(p>>7)*SEQ+(p&127)*2); }
    #pragma unroll
    for(int i=0;i<8;++i){ const int p=tl+i*NW*64; if(p<npc)*reinterpret_cast<__attribute__((address_space(3))) u32x4*>((__attribute__((address_space(3))) char*)(lds_cptr)shm+LDS_MASK+(p>>7)*2048+(p&127)*16)=mv[i]; } }
  asm volatile("s_waitcnt vmcnt(0) lgkmcnt(0)":::"memory");
  DMA_K(0,0);DMA_V(0,0);DMA_K(1,SLOTB);
  bf16x8 qr[4];
  #pragma unroll
  for(int d0=0;d0<4;++d0)qr[d0]=*reinterpret_cast<const bf16x8*>(&Qw[(long)r32*KP+d0*16+hi*8]);
  const lds_cptr mkp=(lds_cptr)shm+LDS_MASK+(wid*QBLK+r32)*8;
  #define BP(r) (((r)&3)+8*((r)>>2))
  #define EXM(x,w,r) __uint_as_float(__float_as_uint(__builtin_amdgcn_exp2f(x))&(unsigned)__builtin_amdgcn_sbfe((int)(w),BP(r),1))
  #define MASKLD(tt,m0,m1) const unsigned long long mw_=*(const __attribute__((address_space(3))) unsigned long long*)(mkp+(tt)*2048); const unsigned m0=((unsigned)mw_)>>(4*hi),m1=((unsigned)(mw_>>32))>>(4*hi)
  float mhat=0.f,l_reg=0.f;f32x16 o[2];o[0]=f32x16{};o[1]=f32x16{};f32x16 negm=f32x16{};asm volatile("":"+v"(negm));
  const int qrel=wid*QBLK+r32;
  #define CMASK(P0,P1,t) do{}while(0)
  bool resc=false;
  #define START(P0,P1) do{ const float rm=rowmax(P0,P1); resc=false; \
    { const float dl=rm; mhat=fadd_s(mhat,dl); \
      _Pragma("unroll") for(int r=0;r<16;++r){P0[r]=fsub_s(P0[r],dl);P1[r]=fsub_s(P1[r],dl);} \
      _Pragma("unroll") for(int r=0;r<16;++r)negm[r]=-mhat; asm volatile("":"+v"(negm)); } \
    _Pragma("unroll") for(int r=0;r<16;++r)P0[r]=EXM(P0[r],mS0,r); }while(0)
  #define RESC() do{ if(resc){ asm volatile("s_waitcnt lgkmcnt(0)":::"memory"); \
      _Pragma("unroll") for(int d_=0;d_<2;++d_) _Pragma("unroll") for(int r=0;r<16;++r)o[d_][r]*=wsf[crow(r,hi)]; } }while(0)
  f32x16 pA0,pA1,pB0,pB1;
  int sl_prev=0,sl_cur=0,sl_next=SLOTB;
  #define ROT() do{sl_prev=sl_cur;sl_cur=sl_next;sl_next=(sl_next==(NSLOT-1)*SLOTB)?0:sl_next+SLOTB;}while(0)
  DMA_K(2,2*SLOTB);
  WAIT_BAR(3);
  qkt(pA0,pA1,Kbase,qr,negm,r32,hi);asm volatile("s_nop 15\n\ts_nop 7":"+v"(pA0),"+v"(pA1));CMASK(pA0,pA1,0);
  { MASKLD(0,mS0,mS1);
  START(pA0,pA1);
  _Pragma("unroll") for(int r=0;r<16;++r)pA1[r]=EXM(pA1[r],mS1,r); }
  WAIT_BAR(0);
  DMA_K(3,0);DMA_V(1,SLOTB);
  ROT();
  kload8(kf,kp0+sl_cur);
  WAIT_BAR(2);
  s16x4 vlo[8],vhi[8]; u32x4 pw0,pw1,pw2,pw3;
  #define PKW(P,B) cvtpk_s(P[B],P[B+1])
  #define PAF(k) __builtin_bit_cast(bf16x8,pw##k)
  #define VFR(i) (bf16x8){vlo[i][0],vlo[i][1],vlo[i][2],vlo[i][3],vhi[i][0],vhi[i][1],vhi[i][2],vhi[i][3]}
  #define PIN(x) asm volatile("":"+v"(x))
  #define MX3(a,b,c) __builtin_fmaxf(__builtin_fmaxf((a),(b)),(c))
  #define GAPA(MF,A0,A1,A2,A3,W0,W1,PW) do{ MF; sacc+=A0; sacc+=A1; sacc+=A2; sacc+=A3; PIN(sacc); W0; W1; PIN(PW); SBAR(); }while(0)
  #define EX(v) __builtin_amdgcn_exp2f(v)
  #define GAPB(MF,X,B,W) do{ MF; X[B]=EXM(X[B],W,B); X[B+1]=EXM(X[B+1],W,B+1); X[B+2]=EXM(X[B+2],W,B+2); X[B+3]=EXM(X[B+3],W,B+3); PIN(X); SBAR(); }while(0)
  #define VRD(i) do{ vlo[i]=vtr(vp_+(((i)>>2)*4096+((i)&3)*1024)); vhi[i]=vtr(vp_+(((i)>>2)*4096+((i)&3)*1024+512)); }while(0)
  #define KRD(G,j) do{ if(G){ kload2(kf,kp0+sl_next,j); SBAR(); } }while(0)
  #define STEP(C0,C1,P0,P1,t,GK,GV,GL) do{ SBAR(); \
    const lds_cptr vp_=vp0+sl_prev; \
    VRD(0); SBAR(); float sacc=(P0[0]+P0[1]); \
    GAPA(C0=__builtin_amdgcn_mfma_f32_32x32x16_bf16(kf[0],qr[0],negm,0,0,0), P0[2],P0[3],P0[4],P0[5],     pw0[0]=PKW(P0,0), pw0[1]=PKW(P0,2), pw0); \
    VRD(4); SBAR(); GAPA(C1=__builtin_amdgcn_mfma_f32_32x32x16_bf16(kf[1],qr[0],negm,0,0,0), P0[6],P0[7],P0[8],P0[9],     pw0[2]=PKW(P0,4), pw0[3]=PKW(P0,6), pw0); \
    VRD(1); SBAR(); GAPA(C0=__builtin_amdgcn_mfma_f32_32x32x16_bf16(kf[2],qr[1],C0,0,0,0),   P0[10],P0[11],P0[12],P0[13], pw1[0]=PKW(P0,8), pw1[1]=PKW(P0,10), pw1); \
    VRD(5); SBAR(); GAPA(C1=__builtin_amdgcn_mfma_f32_32x32x16_bf16(kf[3],qr[1],C1,0,0,0),   P0[14],P0[15],P1[0],P1[1],   pw1[2]=PKW(P0,12),pw1[3]=PKW(P0,14), pw1); \
    VRD(2); SBAR(); GAPA(C0=__builtin_amdgcn_mfma_f32_32x32x16_bf16(kf[4],qr[2],C0,0,0,0),   P1[2],P1[3],P1[4],P1[5],     pw2[0]=PKW(P1,0), pw2[1]=PKW(P1,2), pw2); \
    VRD(6); SBAR(); GAPA(C1=__builtin_amdgcn_mfma_f32_32x32x16_bf16(kf[5],qr[2],C1,0,0,0),   P1[6],P1[7],P1[8],P1[9],     pw2[2]=PKW(P1,4), pw2[3]=PKW(P1,6), pw2); \
    VRD(3); SBAR(); GAPA(C0=__builtin_amdgcn_mfma_f32_32x32x16_bf16(kf[6],qr[3],C0,0,0,0),   P1[10],P1[11],P1[12],P1[13], pw3[0]=PKW(P1,8), pw3[1]=PKW(P1,10), pw3); \
    VRD(7); SBAR(); GAPA(C1=__builtin_amdgcn_mfma_f32_32x32x16_bf16(kf[7],qr[3],C1,0,0,0),   P1[14],P1[15],0.f,0.f,       pw3[2]=PKW(P1,12),pw3[3]=PKW(P1,14), pw3); \
    l_reg+=sacc; \
    if(GK){DMA_K((t)+3,sl_cur);} if(GV){DMA_V((t)+1,sl_next);} \
    MASKLD(t,mA_,mB_); \
    { float a=MX3(C0[0],C0[1],C1[0]),b=MX3(C0[2],C0[3],C1[1]); a=MX3(a,C1[2],C1[3]); \
      _Pragma("unroll") for(int r=4;r<16;r+=4){a=MX3(a,C0[r],C0[r+1]);b=MX3(b,C0[r+2],C0[r+3]);a=MX3(a,C1[r],C1[r+1]);b=MX3(b,C1[r+2],C1[r+3]);} \
      float rm=__builtin_fmaxf(a,b); { auto rr=__builtin_amdgcn_permlane32_swap(__float_as_uint(rm),__float_as_uint(rm),false,false); rm=__builtin_fmaxf(__uint_as_float(rr[0]),__uint_as_float(rr[1])); } \
      resc=false; \
      if(__builtin_expect(__any(rm>(float)THRL),0)){ const float dl=__builtin_fmaxf(rm,0.f); mhat+=dl; \
        _Pragma("unroll") for(int r=0;r<16;++r){C0[r]-=dl;C1[r]-=dl;} \
        _Pragma("unroll") for(int r=0;r<16;++r)negm[r]=-mhat; asm volatile("":"+v"(negm)); \
        const float f=__builtin_amdgcn_exp2f(-dl); l_reg*=f; if(hi==0)wsf[r32]=f; resc=true; } } \
    SBAR(); \
    GAPB(o[0]=__builtin_amdgcn_mfma_f32_32x32x16_bf16(PAF(0),VFR(0),o[0],0,0,0), C0,0,mA_); \
    GAPB(o[1]=__builtin_amdgcn_mfma_f32_32x32x16_bf16(PAF(0),VFR(4),o[1],0,0,0), C0,4,mA_); \
    KRD(GL,0); GAPB(o[0]=__builtin_amdgcn_mfma_f32_32x32x16_bf16(PAF(1),VFR(1),o[0],0,0,0), C0,8,mA_); \
    KRD(GL,1); GAPB(o[1]=__builtin_amdgcn_mfma_f32_32x32x16_bf16(PAF(1),VFR(5),o[1],0,0,0), C0,12,mA_); \
    KRD(GL,2); GAPB(o[0]=__builtin_amdgcn_mfma_f32_32x32x16_bf16(PAF(2),VFR(2),o[0],0,0,0), C1,0,mB_); \
    KRD(GL,3); GAPB(o[1]=__builtin_amdgcn_mfma_f32_32x32x16_bf16(PAF(2),VFR(6),o[1],0,0,0), C1,4,mB_); \
    GAPB(o[0]=__builtin_amdgcn_mfma_f32_32x32x16_bf16(PAF(3),VFR(3),o[0],0,0,0), C1,8,mB_); \
    GAPB(o[1]=__builtin_amdgcn_mfma_f32_32x32x16_bf16(PAF(3),VFR(7),o[1],0,0,0), C1,12,mB_); \
    }while(0)
  int t=1;
  #undef CMASK
  #define CMASK(P0,P1,t) do{}while(0)
  for(;t+5<NT;t+=2){
    STEP(pB0,pB1,pA0,pA1,t,true,true,true);     WAIT_BAR(2); RESC(); ROT();
    STEP(pA0,pA1,pB0,pB1,t+1,true,true,true);   WAIT_BAR(2); RESC(); ROT();
  }
  #undef CMASK
  #define CMASK(P0,P1,t) do{}while(0)
  #define ENDW(tt) do{ if((tt)+3<NT){WAIT_BAR(2);} else if((tt)+2<NT){WAIT_BAR(1);} else {WAIT_BAR(0);} }while(0)
  for(;t+1<NT;t+=2){
    STEP(pB0,pB1,pA0,pA1,t,(t+3<NT),(t+1<NT),(t+1<NT));       ENDW(t);   RESC(); ROT();
    STEP(pA0,pA1,pB0,pB1,t+1,(t+4<NT),(t+2<NT),(t+2<NT));     ENDW(t+1); RESC(); ROT();
  }
  STEP(pB0,pB1,pA0,pA1,NT-1,false,false,false); RESC();
  { float sacc=pB0[0]+pB0[1]; _Pragma("unroll") for(int r=2;r<16;++r)sacc+=pB0[r]; _Pragma("unroll") for(int r=0;r<16;++r)sacc+=pB1[r]; l_reg+=sacc;
    pw0=(u32x4){PKW(pB0,0),PKW(pB0,2),PKW(pB0,4),PKW(pB0,6)};pw1=(u32x4){PKW(pB0,8),PKW(pB0,10),PKW(pB0,12),PKW(pB0,14)};pw2=(u32x4){PKW(pB1,0),PKW(pB1,2),PKW(pB1,4),PKW(pB1,6)};pw3=(u32x4){PKW(pB1,8),PKW(pB1,10),PKW(pB1,12),PKW(pB1,14)};
    SBAR(); pv(o,vb0+sl_cur,PAF(0),PAF(1),PAF(2),PAF(3)); }
  #undef PKW
  #undef PAF
  #undef VFR
  #undef PIN
  #undef MX3
  #undef GAPA
  #undef GAPB
  #undef EX
  #undef VRD
  #undef KRD
  #undef STEP
  #undef ENDW
  {auto rr=__builtin_amdgcn_permlane32_swap(__float_as_uint(l_reg),__float_as_uint(l_reg),false,false);l_reg=__uint_as_float(rr[0])+__uint_as_float(rr[1]);}
  if(hi==0)wsf[32+r32]=l_reg;asm volatile("s_waitcnt lgkmcnt(0)":::"memory");
  float rli[16];
  #pragma unroll
  for(int r=0;r<16;++r)rli[r]=__builtin_amdgcn_rcpf(wsf[32+crow(r,hi)]);
  bf16*Ow=O+(rowbase+q0+wid*QBLK)*OP+h*D;
  { bf16*stg=(bf16*)(shm+LDS_OST)+wid*2048;
    #pragma unroll
    for(int r=0;r<16;++r){const int orow=crow(r,hi);
      #pragma unroll
      for(int d0=0;d0<2;++d0)stg[orow*64+d0*32+r32]=__float2bfloat16(o[d0][r]*rli[r]);}
    asm volatile("s_waitcnt lgkmcnt(0)":::"memory");
    #pragma unroll
    for(int i=0;i<4;++i){const int row=i*8+(lane>>3),ch=lane&7; const u32x4 v=*(const u32x4*)(stg+row*64+ch*8); ATTN_STORE16(Ow+(long)row*OP+ch*8,v);} }
  asm volatile("s_waitcnt lgkmcnt(0)\n\ts_barrier":::"memory");
  #undef DMA_K
  #undef DMA_V
  #undef CMASK
  #undef START
  #undef RESC
  #undef ROT
  #undef BP
  #undef EXM
  #undef MASKLD
}
constexpr int ATTN_LDS_BYTES=LDS_BYTES;
struct AttnTensors { const bf16* Q; const bf16* K; const bf16* V; bf16* O; const unsigned long long* MASKT; };
struct AttnUnit { int bh; int qb; };
struct StaticOrder {
  int vcu;
  __device__ __forceinline__ explicit StaticOrder(int grid,int block):vcu((block%8)*(grid/8)+block/8){}
  __device__ __forceinline__ bool next(int i,AttnUnit&u)const{ if(i>=2)return false; const int s=vcu&3; u.bh=vcu>>2; u.qb=(i==0)?7-s:s; return true; }
  __device__ __forceinline__ void a_ready(const AttnUnit&)const{}
  __device__ __forceinline__ void done(const AttnUnit&)const{}
};
template<class Sched,int THRL=8> __device__ __forceinline__ void attn_phase(char*lds,const AttnTensors&T,const Sched&S){
  AttnUnit u;
  for(int i=0;S.next(i,u);++i){ S.a_ready(u); attn_unit<THRL>(u.bh/NHEAD,u.bh%NHEAD,u.qb,T.Q,T.K,T.V,T.O,T.MASKT,lds); S.done(u); }
}
#undef SBAR
#undef WAIT_BAR
}


__global__ void __launch_bounds__(NWAVES * 64, 2) mk_fwd(Args args) {
    extern __shared__ __attribute__((aligned(16))) unsigned char lds[];
    Frame F;
    F.lds = (LAS unsigned char*)lds;
    F.MISC = (volatile LAS unsigned*)(F.lds + MISC_OFF);
    F.tid = threadIdx.x; F.lane = F.tid & 63; F.wave = __builtin_amdgcn_readfirstlane(F.tid >> 6);
    F.G = gridDim.x; { const int bx = blockIdx.x; F.vcu = (F.G % 8 == 0) ? (bx % 8) * (F.G / 8) + bx / 8 : bx; }
    unsigned char* ws = args.ws;
    F.ctl = (gu32*)(ws + WS_CTL);
    for (int u = F.tid; u < (LDS_BYTES - LDSCTL_OFF) / 4; u += NWAVES * 64) ((LAS unsigned*)(F.lds + LDSCTL_OFF))[u] = 0u;
    __syncthreads();
    XcdBarrier bar = xcd_barrier_post((unsigned*)(F.ctl + CW_BAR) + args.li * XCD_BAR_WORDS, F.MISC + 8);
    const int lo = args.ph_lo, hi = args.ph_hi;
#define IN(k) (lo <= (k) && (k) < hi)
#define BOTH(k) (IN(k) && IN((k) + 1))
#define GRID_BAR() xcd_barrier(bar)
    bf16* XB = (bf16*)(ws + WS_XB); bf16* MIX = (bf16*)(ws + WS_MIX); bf16* H = (bf16*)(ws + WS_H);
    float* sspA = (float*)(ws + WS_SSPA); float* sspB = (float*)(ws + WS_SSPB);
    float* cosH = (float*)(ws + WS_TAB); float* sinH = cosH + SEQ * 32; float* cosI = sinH + SEQ * 32; float* sinI = cosI + SEQ * 16;
    const float* x = args.in[0]; float* out = args.out;

    if (IN(0)) { p0_prologue(F, args); if (BOTH(0)) GRID_BAR(); }
    if (IN(1)) {
        pg8::Gemm g{XB, (bf16*)(ws + WS_WGU1), M, NGU, D}; pg8::StaticOrder S; S.init(M, NGU, F.G, (int)blockIdx.x);
        pg8::EpiSwiGLU E{H, sspA};
        pg8::gemm_phase<pg8::EpiSwiGLU, pg8::StaticOrder, PG8_ALIGN, PG8_SP2>(F.lds + RING_OFF, g, S, E);
        if (BOTH(1)) GRID_BAR();
    }
    if (IN(2)) {
        pg8::Gemm g{H, (bf16*)(ws + WS_WD1), M, D, DFF}; pg8::StaticOrder S; S.init(M, D, F.G, (int)blockIdx.x);
        pg8::EpiResid E{x, out, XB, sspA, 0.5f, 1};
        pg8::gemm_phase<pg8::EpiResid, pg8::StaticOrder, PG8_ALIGN, PG8_SP2>(F.lds + RING_OFF, g, S, E);
        if (BOTH(2)) GRID_BAR();
    }
    if (IN(3)) {
        pg8::Gemm g{XB, (bf16*)(ws + WS_WIN), M, NIN, D}; pg8::StaticOrder S; S.init(M, NIN, F.G, (int)blockIdx.x);
        pg8::EpiInProj E{sspA, (bf16*)(ws + WS_Q), (bf16*)(ws + WS_K), (bf16*)(ws + WS_V), (bf16*)(ws + WS_U), (bf16*)(ws + WS_QI), (bf16*)(ws + WS_KI), (float*)(ws + WS_WI),
                         args.in[7], args.in[8], cosH, sinH, cosI, sinI, C2};
        pg8::gemm_phase<pg8::EpiInProj, pg8::StaticOrder, PG8_ALIGN, PG8_SP2>(F.lds + RING_OFF, g, S, E);
        if (BOTH(3)) GRID_BAR();
    }
    if (IN(4)) {
        select_phase(F, (const bf16*)(ws + WS_QI), (const bf16*)(ws + WS_KI), (const float*)(ws + WS_WI), (unsigned long long*)(ws + WS_MASK), (const bf16*)(ws + WS_U), MIX);
        if (BOTH(4)) GRID_BAR();
    }
    if (IN(5)) {
        static_assert(attn_body::LDS_TOTAL <= LDSCTL_OFF, "attention LDS");
        const attn_body::AttnTensors AT{(const attn_body::bf16*)(ws + WS_Q), (const attn_body::bf16*)(ws + WS_K), (const attn_body::bf16*)(ws + WS_V), (attn_body::bf16*)MIX, (const unsigned long long*)(ws + WS_MASK)};
        const attn_body::StaticOrder S((int)F.G, (int)blockIdx.x);
        attn_body::attn_phase<attn_body::StaticOrder>((char*)lds + RING_OFF, AT, S);
        if (BOTH(5)) GRID_BAR();
    }
    if (IN(6)) {
        pg8::Gemm g{MIX, (bf16*)(ws + WS_WOUT), M, D, D}; pg8::StaticOrder S; S.init(M, D, F.G, (int)blockIdx.x);
        pg8::EpiResid E{out, out, XB, sspB, 1.0f, 1};
        pg8::gemm_phase<pg8::EpiResid, pg8::StaticOrder, PG8_ALIGN, PG8_SP2>(F.lds + RING_OFF, g, S, E);
        if (BOTH(6)) GRID_BAR();
    }
    if (IN(7)) {
        pg8::Gemm g{XB, (bf16*)(ws + WS_WGU2), M, NGU, D}; pg8::StaticOrder S; S.init(M, NGU, F.G, (int)blockIdx.x);
        pg8::EpiSwiGLU E{H, sspB};
        pg8::gemm_phase<pg8::EpiSwiGLU, pg8::StaticOrder, PG8_ALIGN, PG8_SP2>(F.lds + RING_OFF, g, S, E);
        if (BOTH(7)) GRID_BAR();
    }
    if (IN(8)) {
        pg8::Gemm g{H, (bf16*)(ws + WS_WD2), M, D, DFF}; pg8::StaticOrder S; S.init(M, D, F.G, (int)blockIdx.x);
        pg8::EpiResid E{out, out, nullptr, nullptr, 0.5f, 0};
        pg8::gemm_phase<pg8::EpiResid, pg8::StaticOrder, PG8_ALIGN, PG8_SP2>(F.lds + RING_OFF, g, S, E);
    }
#undef IN
#undef BOTH
}

extern "C" void kernel_launch(void* const* d_in, const int* in_sizes, int n_in, void* d_out, int out_size, void* d_ws, size_t ws_size, hipStream_t stream) {
    static int grid = 0;
    if (grid == 0) {
        if (n_in != 16 || out_size != M * D || ws_size < WS_END) { fprintf(stderr, "kernel_launch: unexpected shapes (n_in %d out %d ws %zu)\n", n_in, out_size, ws_size); grid = -1; return; }
        int dev = 0, cus = 0, per_cu = 0;
        if (hipGetDevice(&dev) != hipSuccess || hipDeviceGetAttribute(&cus, hipDeviceAttributeMultiprocessorCount, dev) != hipSuccess) { grid = -1; return; }
        if (hipFuncSetAttribute((const void*)mk_fwd, hipFuncAttributeMaxDynamicSharedMemorySize, LDS_BYTES) != hipSuccess) { fprintf(stderr, "kernel_launch: hipFuncSetAttribute failed\n"); grid = -1; return; }
        if (hipOccupancyMaxActiveBlocksPerMultiprocessor(&per_cu, (const void*)mk_fwd, NWAVES * 64, LDS_BYTES) != hipSuccess || per_cu < 1) fprintf(stderr, "kernel_launch: occupancy query reports %d\n", per_cu);
        (void)hipGetLastError();
        grid = cus;
    }
    if (grid < 0) return;
    (void)hipMemsetAsync((char*)d_ws + WS_CTL, 0, CTL_ZERO_BYTES, stream);
    Args a{};
    for (int i = 0; i < 16; ++i) a.in[i] = (const float*)d_in[i];
    a.out = (float*)d_out; a.ws = (unsigned char*)d_ws;
    a.ph_lo = 0; a.ph_hi = 9; a.li = 0;
    hipLaunchKernelGGL(mk_fwd, dim3(grid), dim3(NWAVES * 64), LDS_BYTES, stream, a);
}
```

```cpp
#include <hip/hip_runtime.h>
#include <cstdio>
#include <cstdint>
#include <math.h>
namespace pg8 {
#define PG8_LAS __attribute__((address_space(3)))
typedef unsigned short bf16_t;
typedef short bf16x8 __attribute__((ext_vector_type(8)));
typedef float f32x4 __attribute__((ext_vector_type(4)));
typedef unsigned u32x4 __attribute__((ext_vector_type(4)));
constexpr int BM = 256, BK = 64, HALF = 128, HTB = HALF * BK * 2  , STAGE_BYTES = 8 * HTB, NXCD = 8, WGM = 8;

__host__ __device__ __forceinline__ int lds_byte(int r, int c) { const int st = (r >> 4) * 2 + (c >> 5), rr = r & 15, cc = c & 31, ob = rr * 64 + cc * 2; return st * 1024 + (ob ^ (((ob >> 9) & 1) << 5)); }
__host__ __device__ __forceinline__ void stage_rc(int b, int& R, int& C) { const int st = b / 1024, sb = b % 1024, swz = sb ^ (((sb >> 9) & 1) << 5); R = (st >> 1) * 16 + swz / 64; C = (st & 1) * 32 + (swz % 64) / 2; }
__host__ __device__ __forceinline__ int perm32(int rho) { const int n = rho >> 4, i = rho & 15; return 8 * (i >> 2) + 4 * n + (i & 3); }

struct Unit { int pm, pn; };
struct Gemm { const bf16_t* A; const bf16_t* Bt; int M, N, K; };

struct StaticOrder {
    int nM, nN, nwg, G, c;
    __host__ __device__ void init(int M, int N, int G_, int c_) { nM = M / BM; nN = N / BM; nwg = nM * nN; G = G_; c = c_; }
    __host__ __device__ bool next(int i, Unit& u) const {
        const long L = (long)i * G + c; if (L >= nwg) return false;
        int wgid = (int)L; { const int q = nwg / NXCD, r = nwg % NXCD, xcd = wgid % NXCD, off = wgid / NXCD; wgid = (xcd < r ? xcd * (q + 1) : r * (q + 1) + (xcd - r) * q) + off; }
        const int nig = WGM * nN, gid = wgid / nig, fm = gid * WGM, gsz = (nM - fm) < WGM ? (nM - fm) : WGM;
        u.pm = fm + ((wgid % nig) % gsz); u.pn = (wgid % nig) / gsz; return true;
    }
    __device__ __forceinline__ void a_ready(const Unit&) const {}
    __device__ __forceinline__ void done(const Unit&) const {}
};


__device__ __forceinline__ unsigned cvt_pk_bf16(float lo, float hi) { unsigned r; asm volatile("v_cvt_pk_bf16_f32 %0, %1, %2" : "=v"(r) : "v"(lo), "v"(hi)); return r; }
typedef float f32x2 __attribute__((ext_vector_type(2)));

typedef float f32x2 __attribute__((ext_vector_type(2)));
__device__ __forceinline__ float fq_sum(float s) {
    { auto r = __builtin_amdgcn_permlane16_swap(__float_as_uint(s), __float_as_uint(s), false, false); s = __uint_as_float(r[0]) + __uint_as_float(r[1]); }
    { auto r = __builtin_amdgcn_permlane32_swap(__float_as_uint(s), __float_as_uint(s), false, false); s = __uint_as_float(r[0]) + __uint_as_float(r[1]); }
    return s;
}
__device__ __forceinline__ float rrow(const float* ssp, int row, int fq) {
    const f32x4 p = *(const f32x4*)(ssp + (size_t)row * 16 + 4 * fq);
    float s = (p[0] + p[1]) + (p[2] + p[3]);
    s = fq_sum(s);
    return __builtin_amdgcn_rsqf(s * (1.0f / 1024.0f) + 1e-6f);
}
__device__ __forceinline__ f32x4 silu_mul(f32x4 g, f32x4 u, float c1, float r2) {
    f32x4 o;
#pragma unroll
    for (int e = 0; e < 4; ++e) { const float t = __builtin_amdgcn_exp2f(g[e] * c1); o[e] = (g[e] * u[e]) * (r2 * __builtin_amdgcn_rcpf(1.0f + t)); }
    return o;
}
__device__ __forceinline__ u32x4 pack8(f32x4 a, f32x4 b) { u32x4 w; w.x = cvt_pk_bf16(a[0], a[1]); w.y = cvt_pk_bf16(a[2], a[3]); w.z = cvt_pk_bf16(b[0], b[1]); w.w = cvt_pk_bf16(b[2], b[3]); return w; }
__device__ __forceinline__ void st16_wt(void* p, u32x4 v) { asm volatile("global_store_dwordx4 %0, %1, off sc1\n\ts_nop 1" :: "v"(p), "v"(v) : "memory"); }
__device__ __forceinline__ float dot4(f32x4 a) { return (a[0] * a[0] + a[1] * a[1]) + (a[2] * a[2] + a[3] * a[3]); }

struct EpiSwiGLU {
    static constexpr bool PERM = true, AFTER_DRAIN = false;
    bf16_t* H; const float* ssp;
    __device__ __forceinline__ void operator()(const f32x4 (&acc)[2][2][4][2], const Unit& u, int wr, int wc, int fr, int fq) const {
        const int row0 = u.pm * BM + wr * 64 + fr, hc0 = u.pn * 128 + wc * 32 + 8 * fq;
        float rs[2][4];
#pragma unroll
        for (int ai = 0; ai < 2; ++ai)
#pragma unroll
            for (int m = 0; m < 4; ++m) rs[ai][m] = rrow(ssp, row0 + ai * HALF + m * 16, fq);
#pragma unroll
        for (int ai = 0; ai < 2; ++ai)
#pragma unroll
            for (int m = 0; m < 4; ++m) {
                const int row = row0 + ai * HALF + m * 16; const float r = rs[ai][m], c1 = r * -1.4426950408889634f, r2 = r * r;
                const f32x4 h0 = silu_mul(acc[ai][0][m][0], acc[ai][1][m][0], c1, r2), h1 = silu_mul(acc[ai][0][m][1], acc[ai][1][m][1], c1, r2);
                *(u32x4*)(H + (size_t)row * 2816 + hc0) = pack8(h0, h1);
            }
    }
};
template <bool RB, bool OF, bool WB>
struct EpiResid {
    static constexpr bool PERM = true, AFTER_DRAIN = false;
    const float* R; float* OUT; bf16_t* XB; float* ssp; float alpha;
    __device__ __forceinline__ void operator()(const f32x4 (&acc)[2][2][4][2], const Unit& u, int wr, int wc, int fr, int fq) const {
        const int row0 = u.pm * BM + wr * 64 + fr, c0 = u.pn * BM + wc * 32 + 8 * fq;
#pragma unroll
        for (int ai = 0; ai < 2; ++ai) {
            f32x4 rv[4][2][2];
#pragma unroll
            for (int m = 0; m < 4; ++m)
#pragma unroll
                for (int bj = 0; bj < 2; ++bj) {
                    const size_t off = (size_t)(row0 + ai * HALF + m * 16) * 1024 + c0 + bj * HALF;
                    if (RB) { const u32x4 w = *(const u32x4*)(XB + off);
                        rv[m][bj][0] = (f32x4){__uint_as_float(w.x << 16), __uint_as_float(w.x & 0xffff0000u), __uint_as_float(w.y << 16), __uint_as_float(w.y & 0xffff0000u)};
                        rv[m][bj][1] = (f32x4){__uint_as_float(w.z << 16), __uint_as_float(w.z & 0xffff0000u), __uint_as_float(w.w << 16), __uint_as_float(w.w & 0xffff0000u)}; }
                    else { rv[m][bj][0] = *(const f32x4*)(R + off); rv[m][bj][1] = *(const f32x4*)(R + off + 4); }
                }
            asm volatile("" ::: "memory");
#pragma unroll
            for (int m = 0; m < 4; ++m) {
                const int row = row0 + ai * HALF + m * 16; float ss = 0.f;
#pragma unroll
                for (int bj = 0; bj < 2; ++bj) {
                    const size_t off = (size_t)row * 1024 + c0 + bj * HALF;
                    const f32x4 o0 = rv[m][bj][0] + acc[ai][bj][m][0] * alpha, o1 = rv[m][bj][1] + acc[ai][bj][m][1] * alpha;
                    if (OF) { *(f32x4*)(OUT + off) = o0; *(f32x4*)(OUT + off + 4) = o1; }
                    if (WB) { *(u32x4*)(XB + off) = pack8(o0, o1); ss += dot4(o0) + dot4(o1); }
                }
                if (WB) { ss = fq_sum(ss); if (fq == 0) ssp[(size_t)row * 16 + u.pn * 4 + wc] = ss; }
            }
            asm volatile("" ::: "memory");
        }
    }
};
struct EpiInProj {
    static constexpr bool PERM = true, AFTER_DRAIN = false;
    const float* ssp; bf16_t *Q, *K, *V, *U, *QI, *KI; float* WI; const float *qn, *kn, *cosH, *sinH, *cosI, *sinI; float qscale;
    __device__ __forceinline__ void operator()(const f32x4 (&acc)[2][2][4][2], const Unit& u, int wr, int wc, int fr, int fq) const {
        const int row0 = u.pm * BM + wr * 64 + fr, pn = u.pn;
#define PG8_SEP(t) __builtin_assume_separate_storage(t, Q); __builtin_assume_separate_storage(t, K); __builtin_assume_separate_storage(t, V); __builtin_assume_separate_storage(t, U); \
        __builtin_assume_separate_storage(t, QI); __builtin_assume_separate_storage(t, KI); __builtin_assume_separate_storage(t, WI);
        PG8_SEP(ssp) PG8_SEP(qn) PG8_SEP(kn) PG8_SEP(cosH) PG8_SEP(sinH) PG8_SEP(cosI) PG8_SEP(sinI)
#undef PG8_SEP
        float rs[2][4];
#pragma unroll
        for (int ai = 0; ai < 2; ++ai)
#pragma unroll
            for (int m = 0; m < 4; ++m) rs[ai][m] = rrow(ssp, row0 + ai * HALF + m * 16, fq);
#pragma unroll
        for (int ai = 0; ai < 2; ++ai)
#pragma unroll
            for (int m = 0; m < 4; ++m) {
                const int row = row0 + ai * HALF + m * 16, pos = row & 2047; const float r = rs[ai][m];
                const f32x4 a00 = acc[ai][0][m][0] * r, a01 = acc[ai][0][m][1] * r, a10 = acc[ai][1][m][0] * r, a11 = acc[ai][1][m][1] * r;
                if (pn < 4) {
                    float ss = (dot4(a00) + dot4(a01)) + (dot4(a10) + dot4(a11));
                    ss = fq_sum(ss);
                    const float rh = __builtin_amdgcn_rsqf(ss * (1.0f / 64.0f) + 1e-6f);
                    const float* gp = (pn < 2) ? qn : kn;
                    const f32x4 g00 = *(const f32x4*)(gp + 8 * fq), g01 = *(const f32x4*)(gp + 8 * fq + 4), g10 = *(const f32x4*)(gp + 32 + 8 * fq), g11 = *(const f32x4*)(gp + 36 + 8 * fq);
                    const f32x4 x1a = a00 * rh * g00, x1b = a01 * rh * g01, x2a = a10 * rh * g10, x2b = a11 * rh * g11;
                    const f32x4 ca = *(const f32x4*)(cosH + pos * 32 + 8 * fq), cb = *(const f32x4*)(cosH + pos * 32 + 8 * fq + 4);
                    const f32x4 sa = *(const f32x4*)(sinH + pos * 32 + 8 * fq), sb = *(const f32x4*)(sinH + pos * 32 + 8 * fq + 4);
                    const float sc = (pn < 2) ? qscale : 1.0f;
                    const f32x4 o1a = (x1a * ca - x2a * sa) * sc, o1b = (x1b * cb - x2b * sb) * sc, o2a = (x2a * ca + x1a * sa) * sc, o2b = (x2b * cb + x1b * sb) * sc;
                    if (pn < 2) { bf16_t* dst = Q + (size_t)row * 512 + ((pn & 1) * 4 + wc) * 64 + 8 * fq; *(u32x4*)dst = pack8(o1a, o1b); *(u32x4*)(dst + 32) = pack8(o2a, o2b); }
                    else {
                        bf16_t* dst = K + ((size_t)((row >> 11) * 8 + (pn & 1) * 4 + wc) * 32 + (pos >> 6)) * 4096 + (pos & 63) * 8 + fq * 512;
                        *(u32x4*)dst = pack8(o1a, o1b); *(u32x4*)(dst + 4 * 512) = pack8(o2a, o2b); }
                } else if (pn < 8) {
                    if (pn >= 6) { bf16_t* dst = U + (size_t)row * 512 + (pn & 1) * 256 + wc * 32 + 8 * fq; *(u32x4*)dst = pack8(a00, a01); *(u32x4*)(dst + 128) = pack8(a10, a11); }
                    else {
                        const int col = (pn & 1) * 256 + wc * 32, hd = col >> 6, ch = (col >> 5) & 1;
                        bf16_t* dst = V + ((size_t)((row >> 11) * 8 + hd) * 32 + (pos >> 6)) * 4096 + (ch * 4 + ((pos & 63) >> 4)) * 512 + ((pos & 15) * 4 + fq) * 8;
                        *(u32x4*)dst = pack8(a00, a01); *(u32x4*)(dst + (size_t)2 * 32 * 4096) = pack8(a10, a11); }
                } else if (pn == 8 || wc == 0) {
                    const int tq = (fq & 1) * 8;
                    f32x4 ca = *(const f32x4*)(cosI + pos * 16 + tq), cb = *(const f32x4*)(cosI + pos * 16 + tq + 4);
                    f32x4 sa = *(const f32x4*)(sinI + pos * 16 + tq), sb = *(const f32x4*)(sinI + pos * 16 + tq + 4);
                    if (fq >= 2) { ca = (f32x4){1.f, 1.f, 1.f, 1.f}; cb = ca; sa = (f32x4){0.f, 0.f, 0.f, 0.f}; sb = sa; }
                    const f32x4 o1a = a00 * ca - a10 * sa, o1b = a01 * cb - a11 * sb, o2a = a10 * ca + a00 * sa, o2b = a11 * cb + a01 * sb;
                    const int d1 = 8 * fq + ((fq >= 2) ? 16 : 0);
                    if (pn == 8) { bf16_t* dst = QI + (size_t)row * 256 + wc * 64 + d1; *(u32x4*)dst = pack8(o1a, o1b); *(u32x4*)(dst + 16) = pack8(o2a, o2b); }
                    else {
                        const int d2 = d1 + 16; bf16_t* tb = KI + (size_t)(row >> 4) * 1024 + (row & 15) * 8;
                        *(u32x4*)(tb + ((d1 >> 5) * 4 + ((d1 & 31) >> 3)) * 128) = pack8(o1a, o1b); *(u32x4*)(tb + ((d2 >> 5) * 4 + ((d2 & 31) >> 3)) * 128) = pack8(o2a, o2b); }
                } else if (wc == 1) {
                    if (fq == 0) *(f32x4*)(WI + (size_t)row * 4) = a00 * 0.0625f;
                }
            }
    }
};
template <class Epi, class Sched, bool ALIGN_EPI = false, bool SP2 = false>
__device__ __forceinline__ void gemm_phase(PG8_LAS unsigned char* lds, const Gemm g, const Sched& S, const Epi& E, const int wave_id) {
    const int wid = wave_id, lane = (int)__builtin_amdgcn_mbcnt_hi(~0u, __builtin_amdgcn_mbcnt_lo(~0u, 0u)), tid = wid * 64 + lane,     wr = wid >> 2, wc = wid & 3, fr = lane & 15, fq = lane >> 4;
    const int K = g.K, nt = K / BK;
    unsigned voffA[2], voffB[2];
#pragma unroll
    for (int i = 0; i < 2; ++i) { int R, C; stage_rc(tid * 16 + i * 8192, R, C); const int Rb = Epi::PERM ? ((R & ~31) + perm32(R & 31)) : R;
        voffA[i] = (unsigned)(R * K + C) * 2u; voffB[i] = (unsigned)(Rb * K + C) * 2u; }
    const size_t kstep = (size_t)(BK * 2);
    const size_t hstep = (size_t)HALF * K * 2;
    const size_t tstep = 2 * hstep;
    const unsigned ldsw = (unsigned)wid * 1024u;
    const int aoff = lds_byte(wr * 64 + fr, fq * 8), boff = lds_byte(wc * 32 + fr, fq * 8);
#define PG8_SA(b, h) (((b) * 2 + (h)) * HTB)
#define PG8_SB(b, h) ((4 + (b) * 2 + (h)) * HTB)
#define PG8_STAGE(bufoff, gbase, voff) do { _Pragma("unroll") for (int _i = 0; _i < 2; ++_i) \
        __builtin_amdgcn_global_load_lds((const unsigned*)((const char*)(gbase) + (voff)[_i]), (PG8_LAS unsigned*)(lds + (bufoff) + ldsw + _i * 8192), 16, 0, 0); } while (0)
#define PG8_LDA(dst, b, h) do { _Pragma("unroll") for (int m = 0; m < 4; ++m) _Pragma("unroll") for (int k = 0; k < 2; ++k) dst[m][k] = *(const PG8_LAS bf16x8*)(lds + PG8_SA(b, h) + aoff + m * 2048 + k * 1024); } while (0)
#define PG8_LDB(dst, b, h) do { _Pragma("unroll") for (int n = 0; n < 2; ++n) _Pragma("unroll") for (int k = 0; k < 2; ++k) dst[n][k] = *(const PG8_LAS bf16x8*)(lds + PG8_SB(b, h) + boff + n * 2048 + k * 1024); } while (0)
#define PG8_MMA(ai, bj, At, Bt) do { __builtin_amdgcn_s_setprio(1); _Pragma("unroll") for (int m = 0; m < 4; ++m) _Pragma("unroll") for (int n = 0; n < 2; ++n) _Pragma("unroll") for (int k = 0; k < 2; ++k) \
        acc[ai][bj][m][n] = __builtin_amdgcn_mfma_f32_16x16x32_bf16(Bt[n][k], At[m][k], acc[ai][bj][m][n], 0, 0, 0); __builtin_amdgcn_s_setprio(0); } while (0)
#define PG8_WAIT_V(n) asm volatile("s_waitcnt vmcnt(" #n ")" ::: "memory")
#define PG8_WAIT_L(n) asm volatile("s_waitcnt lgkmcnt(" #n ")" ::: "memory")
#define PG8_BAR __builtin_amdgcn_s_barrier()
#define PG8_SCHED __builtin_amdgcn_sched_barrier(0)
    Unit cur, nxt; int ui = 0;
    if (!S.next(0, cur)) return;
    f32x4 acc[2][2][4][2];
#pragma unroll
    for (int a = 0; a < 2; ++a)
#pragma unroll
        for (int b = 0; b < 2; ++b)
#pragma unroll
            for (int m = 0; m < 4; ++m)
#pragma unroll
                for (int n = 0; n < 2; ++n) acc[a][b][m][n] = (f32x4){0.f, 0.f, 0.f, 0.f};
    bf16x8 At[4][2], B0[2][2], B1[2][2];
    const char* cA = (const char*)g.A + (size_t)cur.pm * tstep; const char* cB = (const char*)g.Bt + (size_t)cur.pn * tstep;
    S.a_ready(cur);
    if constexpr (SP2) {
        PG8_STAGE(PG8_SB(0, 0), cB, voffB); PG8_STAGE(PG8_SB(0, 1), cB + hstep, voffB); PG8_STAGE(PG8_SA(0, 0), cA, voffA); PG8_STAGE(PG8_SA(0, 1), cA + hstep, voffA);
        if (wr == 1) PG8_BAR;
        PG8_WAIT_V(2); PG8_BAR;
        PG8_STAGE(PG8_SB(1, 0), cB + kstep, voffB); PG8_STAGE(PG8_SA(1, 0), cA + kstep, voffA); PG8_STAGE(PG8_SB(1, 1), cB + hstep + kstep, voffB);
        PG8_WAIT_V(6); PG8_BAR;
    } else {
        PG8_STAGE(PG8_SB(0, 0), cB, voffB); PG8_STAGE(PG8_SA(0, 0), cA, voffA); PG8_STAGE(PG8_SB(0, 1), cB + hstep, voffB); PG8_STAGE(PG8_SA(0, 1), cA + hstep, voffA);
        if (wr == 1) PG8_BAR;
        PG8_WAIT_V(4); PG8_BAR;
        PG8_STAGE(PG8_SB(1, 0), cB + kstep, voffB); PG8_STAGE(PG8_SA(1, 0), cA + kstep, voffA); PG8_STAGE(PG8_SB(1, 1), cB + hstep + kstep, voffB);
        PG8_WAIT_V(6); PG8_BAR;
    }
    for (;;) {
        const bool has_next = S.next(ui + 1, nxt);
        const char* nA = has_next ? (const char*)g.A + (size_t)nxt.pm * tstep : cA; const char* nB = has_next ? (const char*)g.Bt + (size_t)nxt.pn * tstep : cB;
        for (int t = 0; t < nt; t += 2) {
            const bool last = (t == nt - 2);
            const char* a1 = cA + (size_t)(t + 1) * kstep;
            const char* a2 = last ? nA : cA + (size_t)(t + 2) * kstep; const char* b2 = last ? nB : cB + (size_t)(t + 2) * kstep;
            const char* a3 = a2 + kstep; const char* b3 = b2 + kstep;
            if (last && has_next) S.a_ready(nxt);
            if constexpr (SP2) {
            PG8_LDB(B0, 0, 0); PG8_LDB(B1, 0, 1); PG8_SCHED; PG8_LDA(At, 0, 0); PG8_STAGE(PG8_SA(1, 1), a1 + hstep, voffA);
            PG8_WAIT_V(8); PG8_WAIT_L(0); PG8_BAR; PG8_MMA(0, 0, At, B0); PG8_MMA(0, 1, At, B1); PG8_BAR; PG8_SCHED;
            PG8_LDA(At, 0, 1); PG8_STAGE(PG8_SB(0, 0), b2, voffB); PG8_STAGE(PG8_SB(0, 1), b2 + hstep, voffB); PG8_STAGE(PG8_SA(0, 0), a2, voffA);
            PG8_WAIT_V(8); PG8_WAIT_L(0); PG8_BAR; PG8_MMA(1, 0, At, B0); PG8_MMA(1, 1, At, B1); PG8_BAR; PG8_SCHED;
            PG8_LDB(B0, 1, 0); PG8_LDB(B1, 1, 1); PG8_SCHED; PG8_LDA(At, 1, 0); PG8_STAGE(PG8_SA(0, 1), a2 + hstep, voffA);
            PG8_WAIT_V(8); PG8_WAIT_L(0); PG8_BAR; PG8_MMA(0, 0, At, B0); PG8_MMA(0, 1, At, B1); PG8_BAR; PG8_SCHED;
            PG8_LDA(At, 1, 1); PG8_STAGE(PG8_SB(1, 0), b3, voffB); PG8_STAGE(PG8_SB(1, 1), b3 + hstep, voffB); PG8_STAGE(PG8_SA(1, 0), a3, voffA);
            PG8_WAIT_V(8); PG8_WAIT_L(0); PG8_BAR; PG8_MMA(1, 0, At, B0); PG8_MMA(1, 1, At, B1); PG8_BAR; PG8_SCHED;
            } else {
            PG8_LDB(B0, 0, 0); PG8_SCHED; PG8_LDA(At, 0, 0); PG8_STAGE(PG8_SA(1, 1), a1 + hstep, voffA);
            PG8_WAIT_L(8); PG8_BAR; PG8_WAIT_L(0); PG8_MMA(0, 0, At, B0); PG8_BAR; PG8_SCHED;
            PG8_LDB(B1, 0, 1); PG8_STAGE(PG8_SB(0, 0), b2, voffB);
            PG8_BAR; PG8_WAIT_L(0); PG8_MMA(0, 1, At, B1); PG8_BAR;
            PG8_LDA(At, 0, 1); PG8_STAGE(PG8_SA(0, 0), a2, voffA);
            PG8_BAR; PG8_WAIT_L(0); PG8_MMA(1, 0, At, B0); PG8_BAR; PG8_SCHED;
            PG8_STAGE(PG8_SB(0, 1), b2 + hstep, voffB);
            PG8_WAIT_V(6); PG8_BAR; PG8_MMA(1, 1, At, B1); PG8_BAR;
            PG8_LDB(B0, 1, 0); PG8_SCHED; PG8_LDA(At, 1, 0); PG8_STAGE(PG8_SA(0, 1), a2 + hstep, voffA);
            PG8_WAIT_L(8); PG8_BAR; PG8_WAIT_L(0); PG8_MMA(0, 0, At, B0); PG8_BAR; PG8_SCHED;
            PG8_LDB(B1, 1, 1); PG8_STAGE(PG8_SB(1, 0), b3, voffB);
            PG8_BAR; PG8_WAIT_L(0); PG8_MMA(0, 1, At, B1); PG8_BAR;
            PG8_LDA(At, 1, 1); PG8_STAGE(PG8_SA(1, 0), a3, voffA);
            PG8_BAR; PG8_WAIT_L(0); PG8_MMA(1, 0, At, B0); PG8_BAR; PG8_SCHED;
            PG8_STAGE(PG8_SB(1, 1), b3 + hstep, voffB);
            PG8_WAIT_V(6); PG8_BAR; PG8_MMA(1, 1, At, B1); PG8_BAR;
            }
        }
        if constexpr (ALIGN_EPI) { if (wr == 0) PG8_BAR; }
        if constexpr (!Epi::AFTER_DRAIN) { E(acc, cur, wr, wc, fr, fq); S.done(cur); }
        if (!has_next) break;
#pragma unroll
        for (int a = 0; a < 2; ++a)
#pragma unroll
            for (int b = 0; b < 2; ++b)
#pragma unroll
                for (int m = 0; m < 4; ++m)
#pragma unroll
                    for (int n = 0; n < 2; ++n) acc[a][b][m][n] = (f32x4){0.f, 0.f, 0.f, 0.f};
        cur = nxt; cA = nA; cB = nB; ++ui;
        if constexpr (ALIGN_EPI) { if (wr == 1) PG8_BAR; }
    }
    PG8_WAIT_V(0);
    if constexpr (!ALIGN_EPI) { if (wr == 0) PG8_BAR; }
    PG8_BAR;
    if constexpr (Epi::AFTER_DRAIN) { E.fused(acc, cur, wr, wc, fr, fq, lds, wid, lane); S.done(cur); }
#undef PG8_SA
#undef PG8_SB
#undef PG8_STAGE
#undef PG8_LDA
#undef PG8_LDB
#undef PG8_MMA
#undef PG8_WAIT_V
#undef PG8_WAIT_L
#undef PG8_BAR
#undef PG8_SCHED
}
}


#ifndef PG8_SP2
#define PG8_SP2 true
#endif
#ifndef PG8_ALIGN
#define PG8_ALIGN true
#endif

#ifndef PROBE_REP
#define PROBE_REP 0
#endif
#define TS_SCALE 0.01f
constexpr int NWAVES = 8;
constexpr int BATCH = 8, SEQ = 2048, D = 1024, M = BATCH * SEQ, DFF = 2816, NGU = 2 * DFF, NIN = 2560, INC = 2372;
constexpr size_t MiB = 1u << 20;
constexpr size_t WS_CTL = 0, CTL_ZERO_BYTES = 64 * 1024;
constexpr size_t WS_SSPA = 2 * MiB, WS_SSPB = 3 * MiB;
constexpr size_t WS_TAB = 4 * MiB;
constexpr size_t WS_WI = 5 * MiB;
constexpr size_t WS_MASK = 6 * MiB;
constexpr size_t WS_WGU1 = 10 * MiB, WS_WD1 = 21 * MiB, WS_WIN = 27 * MiB, WS_WOUT = 32 * MiB, WS_WGU2 = 34 * MiB, WS_WD2 = 45 * MiB;
constexpr size_t WS_XB = 52 * MiB;
constexpr size_t WS_MIX = 84 * MiB;
constexpr size_t WS_H = 116 * MiB;
constexpr size_t WS_Q = 116 * MiB, WS_K = 132 * MiB, WS_V = 148 * MiB, WS_U = 164 * MiB, WS_QI = 180 * MiB, WS_KI = 188 * MiB;
constexpr size_t WS_END = 204 * MiB;
constexpr int CW_BAR = 4096;
constexpr int RING_OFF = 0, RING_BYTES = 131072;
constexpr int LDS_BYTES = 163840;
constexpr int LDSCTL_OFF = LDS_BYTES - 1024, MISC_OFF = LDSCTL_OFF + 320;
constexpr float C2 = 0.125f * 1.4426950408889634f;

#define GAS __attribute__((address_space(1)))
#define LAS __attribute__((address_space(3)))
typedef unsigned short bf16;
typedef unsigned v4u __attribute__((ext_vector_type(4)));
typedef float f32x4 __attribute__((ext_vector_type(4)));
typedef short bf16x8 __attribute__((ext_vector_type(8)));
typedef GAS unsigned gu32;
typedef GAS unsigned long long gu64;
#define RLX_AGENT __ATOMIC_RELAXED, __HIP_MEMORY_SCOPE_AGENT
#define LDS_WAIT() asm volatile("s_waitcnt lgkmcnt(0)" ::: "memory")
#define VM_WAIT() asm volatile("s_waitcnt vmcnt(0)" ::: "memory")
__device__ __forceinline__ unsigned long long rt() { return __builtin_amdgcn_s_memrealtime(); }
__device__ __forceinline__ unsigned f2bf(float f) { unsigned u = __builtin_bit_cast(unsigned, f); return (u + 0x7fffu + ((u >> 16) & 1u)) >> 16; }
__device__ __forceinline__ unsigned pk2(float lo, float hi) { return f2bf(lo) | (f2bf(hi) << 16); }

#define XB_TMO      128
#define XB_XCNT(j)  (256  + 64 * (j))
#define XB_XSUB(j)  (1280 + 64 * (j))
#define XB_XGEN(j)  (2304 + 64 * (j))
#define XB_TOP      3328
#define XB_TOPGEN   3392
#define XCD_BAR_WORDS 3456
#define XB_SPIN_CAP (1u << 18)

__device__ __forceinline__ unsigned xb_ld(unsigned* p)              { return __hip_atomic_load(p, __ATOMIC_RELAXED, __HIP_MEMORY_SCOPE_AGENT); }
__device__ __forceinline__ unsigned xb_add(unsigned* p, unsigned v) { return __hip_atomic_fetch_add(p, v, __ATOMIC_RELAXED, __HIP_MEMORY_SCOPE_AGENT); }
__device__ __forceinline__ unsigned xb_xcc_id() { return (unsigned)__builtin_amdgcn_s_getreg((3 << 11) | 20) & 0xFu; }
#define XB_SPIN(cond, bar) do { unsigned _sp = 0; while (cond) { __builtin_amdgcn_s_sleep(1); \
    if ((++_sp & 255u) == 0u) { if (xb_ld(&(bar)[XB_TMO])) break; if (_sp > XB_SPIN_CAP) { atomicAdd(&(bar)[XB_TMO], 1u); break; } } } } while (0)

struct XcdBarrier {
    unsigned* bar; unsigned x; int leader;
    volatile LAS unsigned* st;
};

__device__ __forceinline__ bool xb_is_thread0(int leader) { return leader && __builtin_amdgcn_mbcnt_hi(~0u, __builtin_amdgcn_mbcnt_lo(~0u, 0u)) == 0u; }
__device__ __forceinline__ XcdBarrier xcd_barrier_post(unsigned* bar, volatile LAS unsigned* st, int wave_id) {
    XcdBarrier b; b.bar = bar; b.x = xb_xcc_id(); b.st = st; b.leader = (wave_id == 0) ? 1 : 0;
    if (xb_is_thread0(b.leader)) (void)xb_add(&bar[XB_XCNT(b.x)], 1u);
    return b;
}
__device__ __forceinline__ void xcd_barrier_complete(unsigned* bar, unsigned x, unsigned& nloc, unsigned& nx) {
    const unsigned G = gridDim.x * gridDim.y * gridDim.z;
    unsigned sum, cnt, mine, sp = 0u;
    for (;;) {
        sum = 0u; cnt = 0u; mine = 0u;
#pragma unroll
        for (unsigned j = 0; j < 16; ++j) { const unsigned c = xb_ld(&bar[XB_XCNT(j)]); sum += c; cnt += (c > 0u) ? 1u : 0u; mine = (j == x) ? c : mine; }
        if (sum == G) break;
        __builtin_amdgcn_s_sleep(1);
        if ((++sp & 255u) == 0u) { if (xb_ld(&bar[XB_TMO])) break; if (sp > XB_SPIN_CAP) { atomicAdd(&bar[XB_TMO], 1u); break; } }
    }
    nloc = mine > 0u ? mine : 1u; nx = cnt > 0u ? cnt : 1u;
}

__device__ __forceinline__ void xcd_barrier(const XcdBarrier& b) {
    asm volatile("s_waitcnt vmcnt(0)" ::: "memory");
    __syncthreads();
    if (xb_is_thread0(b.leader)) {
        unsigned* bar = b.bar;
        __builtin_amdgcn_s_waitcnt(0);
        unsigned nloc = b.st[0], nx = b.st[1];
        if (nloc == 0u) { xcd_barrier_complete(bar, b.x, nloc, nx); b.st[0] = nloc; b.st[1] = nx; }
        const unsigned old = xb_add(&bar[XB_XSUB(b.x)], 1u);
        const unsigned gen = old / nloc;
        if (old + 1u == (gen + 1u) * nloc) {
            __builtin_amdgcn_fence(__ATOMIC_RELEASE, "agent");
            asm volatile("s_waitcnt vmcnt(0)" ::: "memory");
            const unsigned og = xb_add(&bar[XB_TOP], 1u);
            const unsigned tg = og / nx;
            if (og + 1u == (tg + 1u) * nx) xb_add(&bar[XB_TOPGEN], 1u);
            else XB_SPIN(xb_ld(&bar[XB_TOPGEN]) == tg, bar);
            __builtin_amdgcn_fence(__ATOMIC_ACQUIRE, "agent");
            xb_add(&bar[XB_XGEN(b.x)], 1u);
            asm volatile("s_waitcnt vmcnt(0)" ::: "memory");
        } else {
            XB_SPIN(xb_ld(&bar[XB_XGEN(b.x)]) == gen, bar);
            __builtin_amdgcn_fence(__ATOMIC_ACQUIRE, "agent");
            asm volatile("s_waitcnt vmcnt(0)" ::: "memory");
        }
    }
    __syncthreads();
}


struct Frame {
    LAS unsigned char* lds;
    volatile LAS unsigned* MISC;
    gu32* ctl;
    int tid, lane, wave;
    int vcu, G;
};
__device__ __forceinline__ float wave_sum(float v) {
#pragma unroll
    for (int o = 1; o < 64; o <<= 1) v += __shfl_xor(v, o);
    return v;
}
template <class Map>
__device__ __forceinline__ void transpose_item(const float* W, int K, int N, const float* gk, bf16* WT, int ldk, Map map, LAS float* scr, int item, int lane) {
    const int nblk = (N + 31) / 32, kb = item / nblk, nb = item % nblk, k0 = 64 * kb, n0 = 32 * nb;
    (void)K;
    float tv[32];
    { const int n = n0 + (lane & 31); const bool ok = n < N; const float* wp = W + (size_t)(k0 + (lane >> 5)) * N + (ok ? n : 0);
#pragma unroll
      for (int i = 0; i < 32; ++i) tv[i] = wp[(size_t)(2 * i) * N];
      if (gk) {
#pragma unroll
          for (int i = 0; i < 32; ++i) tv[i] *= gk[k0 + 2 * i + (lane >> 5)];
      }
#pragma unroll
      for (int i = 0; i < 32; ++i) scr[(2 * i + (lane >> 5)) * 33 + (lane & 31)] = ok ? tv[i] : 0.f; }
    LDS_WAIT(); asm volatile("" ::: "memory");
    const int c = lane & 7;
#pragma unroll
    for (int j = 0; j < 4; ++j) { const int nn = (lane >> 3) + 8 * j, n = n0 + nn; const LAS float* s = scr + (8 * c) * 33 + nn;
        if (n < N) { const int dst = map(n);
            v4u o; o.x = pk2(s[0 * 33], s[1 * 33]); o.y = pk2(s[2 * 33], s[3 * 33]); o.z = pk2(s[4 * 33], s[5 * 33]); o.w = pk2(s[6 * 33], s[7 * 33]);
            *(GAS v4u*)(WT + (size_t)dst * ldk + k0 + 8 * c) = o; } }
    LDS_WAIT(); asm volatile("" ::: "memory");
}
struct MapPlain { __device__ __forceinline__ int operator()(int n) const { return n; } };
struct MapGate { int add; __device__ __forceinline__ int operator()(int n) const { return 256 * (n >> 7) + (n & 127) + add; } };
__device__ __forceinline__ int idx_slot(int d) { return (d < 16) ? d : (d < 32) ? 128 + (d - 16) : (d < 48) ? 16 + (d - 32) : 128 + 16 + (d - 48); }
struct MapIn {
    __device__ __forceinline__ int operator()(int n) const {
        if (n < 1024) { const int kq = n >> 9, nn = n & 511, head = nn >> 6, d = nn & 63; return kq * 512 + 256 * (head >> 2) + 128 * (d >> 5) + 32 * (head & 3) + (d & 31); }
        if (n < 1536) return n;
        if (n < 1792) { const int nn = n - 1536, h = nn >> 6, d = nn & 63; return 2048 + 32 * h + idx_slot(d); }
        if (n < 1856) return 2304 + idx_slot(n - 1792);
        if (n < 1860) return 2304 + 32 + (n - 1856);
        return 1536 + (n - 1860);
    }
};

struct Args { const float* in[16]; float* out; unsigned char* ws; int ph_lo, ph_hi, li, pad; };

__device__ __forceinline__ void weight_items(Frame& F, const Args& a, int set, int gw, int NGW) {
    unsigned char* ws = a.ws;
    LAS float* scr = (LAS float*)(F.lds + RING_OFF + F.wave * 16384);
    const int lane = F.lane;
    const float *f1n = a.in[1], *f1g = a.in[2], *f1u = a.in[3], *f1d = a.in[4], *mixn = a.in[5], *win = a.in[6], *poolw = a.in[9], *pools = a.in[10], *wout = a.in[11],
                *f2n = a.in[12], *f2g = a.in[13], *f2u = a.in[14], *f2d = a.in[15];
    bf16* WGU1 = (bf16*)(ws + WS_WGU1); bf16* WD1 = (bf16*)(ws + WS_WD1); bf16* WIN = (bf16*)(ws + WS_WIN); bf16* WOUT = (bf16*)(ws + WS_WOUT); bf16* WGU2 = (bf16*)(ws + WS_WGU2); bf16* WD2 = (bf16*)(ws + WS_WD2);
    constexpr int I_G = (D / 64) * (DFF / 32), I_D = (DFF / 64) * (D / 32), I_IN = (D / 64) * ((INC + 31) / 32), I_O = (512 / 64) * (D / 32);
    if (set == 0) {
        for (int it = gw; it < 2 * I_G; it += NGW) {
            if (it < I_G) transpose_item(f1g, D, DFF, f1n, WGU1, D, MapGate{0}, scr, it, lane);
            else transpose_item(f1u, D, DFF, f1n, WGU1, D, MapGate{128}, scr, it - I_G, lane);
        }
    } else if (set == 2) {
        for (int it = gw; it < 2 * I_G; it += NGW) {
            if (it < I_G) transpose_item(f2g, D, DFF, f2n, WGU2, D, MapGate{0}, scr, it, lane);
            else transpose_item(f2u, D, DFF, f2n, WGU2, D, MapGate{128}, scr, it - I_G, lane);
        }
    } else if (set == 3) {
        for (int it = gw; it < I_D; it += NGW) transpose_item(f2d, DFF, D, nullptr, WD2, DFF, MapPlain{}, scr, it, lane);
    } else {
        for (int it = gw; it < I_D + I_IN + I_O; it += NGW) {
            int r = it;
            if (r < I_D) { transpose_item(f1d, DFF, D, nullptr, WD1, DFF, MapPlain{}, scr, r, lane); continue; } r -= I_D;
            if (r < I_IN) { transpose_item(win, D, INC, mixn, WIN, D, MapIn{}, scr, r, lane); continue; } r -= I_IN;
            transpose_item(wout, 512, D, nullptr, WOUT, D, MapPlain{}, scr, r, lane);
        }
    }
    if (set == 1) {
        for (int j = gw; j < 256; j += NGW) {
            const int bj = j >> 7, wc = (j >> 5) & 3, i = j & 31;
            const bool covered = (wc == 0) || (wc == 1 && bj == 0 && i < 4);
            if (!covered) { GAS v4u* o = (GAS v4u*)(WIN + (size_t)(2304 + j) * D) + lane; o[0] = (v4u){0u, 0u, 0u, 0u}; o[64] = (v4u){0u, 0u, 0u, 0u}; }
        }
    }
}
__device__ __forceinline__ void wpo_items(Frame& F, const Args& a, int gw, int NGW, int it_lo, int it_hi) {
    unsigned char* ws = a.ws; bf16* WOUT = (bf16*)(ws + WS_WOUT);
    LAS float* scr = (LAS float*)(F.lds + RING_OFF + F.wave * 16384);
    const int lane = F.lane; const float *poolw = a.in[9], *pools = a.in[10], *wout = a.in[11];
#pragma unroll 1
    for (int it = it_lo + gw; it < it_hi; it += NGW) {
        const int g = it >> 9, nb = (it >> 5) & 15, cb = it & 31, n = nb * 64 + lane;
        float ac[4] = {0.f, 0.f, 0.f, 0.f};
        const float* pw = poolw + ((size_t)g * 128 + cb * 4) * 128;
        const float* wsrc = wout + (size_t)(512 + g * 128) * D + nb * 64; const float* psrc = pools + g * 128;
#pragma unroll 1
        for (int half = 0; half < 2; ++half) {
#pragma unroll
            for (int dd = 0; dd < 64; ++dd)
                __builtin_amdgcn_global_load_lds((const unsigned*)(wsrc + (size_t)(half * 64 + dd) * D) + lane, (LAS unsigned*)(scr + dd * 64), 4, 0, 0);
            asm volatile("s_waitcnt vmcnt(0)" ::: "memory");
#pragma unroll 8
            for (int dd = 0; dd < 64; ++dd) { const float w = scr[dd * 64 + lane] * psrc[half * 64 + dd];
#pragma unroll
                for (int cc = 0; cc < 4; ++cc) ac[cc] = fmaf(pw[cc * 128 + half * 64 + dd], w, ac[cc]); }
            LDS_WAIT(); asm volatile("" ::: "memory");
        }
        *(GAS unsigned long long*)(WOUT + (size_t)n * D + 512 + g * 128 + cb * 4) = (unsigned long long)pk2(ac[0], ac[1]) | ((unsigned long long)pk2(ac[2], ac[3]) << 32);
    }
}
__device__ __forceinline__ void p0_prologue(Frame& F, const Args& a) {
    unsigned char* ws = a.ws;
    const int gw = F.vcu * NWAVES + F.wave, NGW = F.G * NWAVES, lane = F.lane;
    const float* x = a.in[0];
    weight_items(F, a, 0, gw, NGW);
    if (F.G != 256) wpo_items(F, a, gw, NGW, 0, 2048);
    if (F.G != 256) { weight_items(F, a, 1, gw, NGW); weight_items(F, a, 2, gw, NGW); weight_items(F, a, 3, gw, NGW); }
    float* cosH = (float*)(ws + WS_TAB); float* sinH = cosH + SEQ * 32; float* cosI = sinH + SEQ * 32; float* sinI = cosI + SEQ * 16;
    for (int idx = gw * 64 + lane; idx < SEQ * 48; idx += NGW * 64) {
        if (idx < SEQ * 32) { const int p = idx >> 5, i = idx & 31; const float inv = (float)pow(10000.0, -(double)i / 32.0); const float ang = __fmul_rn((float)p, inv); cosH[idx] = (float)cos((double)ang); sinH[idx] = (float)sin((double)ang); }
        else { const int j = idx - SEQ * 32, p = j >> 4, i = j & 15; const float inv = (float)pow(10000.0, -(double)i / 16.0); const float ang = __fmul_rn((float)p, inv); cosI[j] = (float)cos((double)ang); sinI[j] = (float)sin((double)ang); }
    }
    bf16* XB = (bf16*)(ws + WS_XB); float* sspA = (float*)(ws + WS_SSPA);
    for (int m0 = gw; m0 < M; m0 += 4 * NGW) {
        f32x4 v[4][4]; float s[4];
#pragma unroll
        for (int q = 0; q < 4; ++q) { const GAS f32x4* xr = (const GAS f32x4*)(x + (size_t)(m0 + q * NGW) * D) + lane;
#pragma unroll
            for (int j = 0; j < 4; ++j) v[q][j] = xr[64 * j]; }
#pragma unroll
        for (int q = 0; q < 4; ++q) { float a = 0.f;
#pragma unroll
            for (int j = 0; j < 4; ++j) a += (v[q][j].x * v[q][j].x + v[q][j].y * v[q][j].y) + (v[q][j].z * v[q][j].z + v[q][j].w * v[q][j].w);
            s[q] = wave_sum(a); }
#pragma unroll
        for (int q = 0; q < 4; ++q) { const int m = m0 + q * NGW;
            GAS unsigned long long* o8 = (GAS unsigned long long*)(XB + (size_t)m * D) + lane;
#pragma unroll
            for (int j = 0; j < 4; ++j) o8[64 * j] = (unsigned long long)pk2(v[q][j].x, v[q][j].y) | ((unsigned long long)pk2(v[q][j].z, v[q][j].w) << 32);
            if (lane < 16) sspA[(size_t)m * 16 + lane] = (lane == 0) ? s[q] : 0.f; }
    }
}

#ifndef SEL_REP
#define SEL_REP 1
#endif
#ifndef SEL_ABL
#define SEL_ABL 1
#endif
#ifndef POOL_REP
#define POOL_REP 1
#endif
__device__ __forceinline__ int wave_sum_dpp(int v) {
    v += __builtin_amdgcn_update_dpp(0, v, 0x111, 0xf, 0xf, false);
    v += __builtin_amdgcn_update_dpp(0, v, 0x112, 0xf, 0xf, false);
    v += __builtin_amdgcn_update_dpp(0, v, 0x114, 0xf, 0xf, false);
    v += __builtin_amdgcn_update_dpp(0, v, 0x118, 0xf, 0xf, false);
    v += __builtin_amdgcn_update_dpp(0, v, 0x142, 0xa, 0xf, false);
    v += __builtin_amdgcn_update_dpp(0, v, 0x143, 0xc, 0xf, false);
    return __builtin_amdgcn_readlane(v, 63);
}
__device__ __forceinline__ void cnt4(int& na, int& nb, unsigned ka0, unsigned kb0, unsigned ka1, unsigned kb1, unsigned ca, unsigned cb) {
    unsigned long long s0, s1, s2;
    asm volatile("v_cmp_le_u32_e32 vcc, %9, %5\n\t"
                 "v_cmp_le_u32_e64 %2, %10, %6\n\t"
                 "v_cmp_le_u32_e64 %3, %9, %7\n\t"
                 "v_cmp_le_u32_e64 %4, %10, %8\n\t"
                 "v_addc_co_u32_e32 %0, vcc, 0, %0, vcc\n\t"
                 "v_addc_co_u32_e64 %1, %2, 0, %1, %2\n\t"
                 "v_addc_co_u32_e64 %0, %3, 0, %0, %3\n\t"
                 "v_addc_co_u32_e64 %1, %4, 0, %1, %4"
                 : "+v"(na), "+v"(nb), "=&s"(s0), "=&s"(s1), "=&s"(s2) : "v"(ka0), "v"(kb0), "v"(ka1), "v"(kb1), "s"(ca), "s"(cb) : "vcc");
}
template <int NC>
__device__ __forceinline__ void build_mask(const unsigned (&kv)[NC], unsigned thr, int need, int lane, GAS unsigned long long* mrow) {
    unsigned mlo = 0u, mhi = 0u; int tbase = 0;
#pragma unroll
    for (int c = 0; c < NC; ++c) {
        unsigned long long m = __ballot(kv[c] > thr);
        if (need > 0 && tbase < need) {
            const unsigned long long em = __ballot(kv[c] == thr);
            const int ce = __popcll(em);
            if (tbase + ce <= need) m |= em;
            else { const int pre = __builtin_amdgcn_mbcnt_hi((unsigned)(em >> 32), __builtin_amdgcn_mbcnt_lo((unsigned)em, 0u)); m |= __ballot(kv[c] == thr && pre < need - tbase); }
            tbase += ce;
        }
        asm volatile("s_nop 1\n\tv_writelane_b32 %0, %2, %4\n\tv_writelane_b32 %1, %3, %4" : "+v"(mlo), "+v"(mhi) : "s"((unsigned)m), "s"((unsigned)(m >> 32)), "i"(c));
    }
    if (lane < 32) mrow[(size_t)lane * SEQ] = ((unsigned long long)mhi << 32) | mlo;
}
__device__ __forceinline__ unsigned wave_max_dpp(unsigned v) {
    unsigned t;
    t = (unsigned)__builtin_amdgcn_update_dpp(0, (int)v, 0x111, 0xf, 0xf, false); v = v > t ? v : t;
    t = (unsigned)__builtin_amdgcn_update_dpp(0, (int)v, 0x112, 0xf, 0xf, false); v = v > t ? v : t;
    t = (unsigned)__builtin_amdgcn_update_dpp(0, (int)v, 0x114, 0xf, 0xf, false); v = v > t ? v : t;
    t = (unsigned)__builtin_amdgcn_update_dpp(0, (int)v, 0x118, 0xf, 0xf, false); v = v > t ? v : t;
    t = (unsigned)__builtin_amdgcn_update_dpp(0, (int)v, 0x142, 0xa, 0xf, false); v = v > t ? v : t;
    t = (unsigned)__builtin_amdgcn_update_dpp(0, (int)v, 0x143, 0xc, 0xf, false); v = v > t ? v : t;
    return (unsigned)__builtin_amdgcn_readlane((int)v, 63);
}
__device__ __forceinline__ unsigned f2key(float f) { const unsigned u = __float_as_uint(f); return (u & 0x80000000u) ? ~u : (u | 0x80000000u); }
__device__ __forceinline__ float key2f(unsigned k) { return __uint_as_float((k & 0x80000000u) ? (k & 0x7fffffffu) : ~k); }
struct RowSearch {
    unsigned lo, hi, thr; int cl, ch, need, last; float wl, wh; bool act;
    bool first;
    __device__ __forceinline__ void init(bool wanted, int ncausal, int cz0, unsigned kmax, unsigned kmin) {
        act = false; thr = 0u; need = 0; lo = 0u; hi = 0u; cl = 0; ch = 0; last = 0; wl = 1.f; wh = 1.f; first = false;
        if (!wanted) return;
        if (cz0 == 256) { thr = 0x7fffffffu; return; }
        act = true;
        if (cz0 > 256) { lo = 0x80000000u; cl = cz0; hi = kmax + 1u; ch = 0; first = true; }
        else { lo = kmin; cl = ncausal; hi = 0x80000000u; ch = cz0; }
        wl = (float)(cl - 256); wh = (float)(256 - ch);
    }
    __device__ __forceinline__ unsigned next_cand(int it) {
        if (!act) return 0xffffffffu;
        if (hi - lo <= 1u) { thr = lo; need = 256 - ch; act = false; return 0xffffffffu; }
        if (first) { first = false; return 0x80000001u; }
        const float fl = key2f(lo), fh = key2f(hi);
        unsigned c = f2key((fl * wh + fh * wl) * __builtin_amdgcn_rcpf(wl + wh));
        if (it >= 24) c = lo + ((hi - lo) >> 1);
        if (c <= lo) c = lo + 1u;
        if (c >= hi) c = hi - 1u;
        return c;
    }
    __device__ __forceinline__ void update(unsigned c, int cnt) {
        if (!act) return;
        if (cnt == 256) { thr = c - 1u; need = 0; act = false; }
        else if (cnt > 256) { lo = c; cl = cnt; wl = (float)(cnt - 256); if (last == 1) wh *= 0.5f; last = 1; }
        else { hi = c; ch = cnt; wh = (float)(256 - cnt); if (last == -1) wl *= 0.5f; last = -1; }
    }
};
constexpr int SC_LD = 2052;
template <int NC>
__device__ __forceinline__ void select_rows2(const LAS unsigned* sa, int nchunks, int ta, int lane, GAS unsigned long long* ma) {
    unsigned ka[NC], kb[NC];
#pragma unroll
    for (int c = 0; c < NC; ++c) { ka[c] = (c < nchunks) ? sa[64 * c + lane] : 0u; kb[c] = (c < nchunks) ? sa[SC_LD + 64 * c + lane] : 0u; }
    LDS_WAIT(); __builtin_amdgcn_s_barrier(); asm volatile("" ::: "memory");
    RowSearch A, B;
    if (ta + 2 > 256) {
        int a0 = 0, b0 = 0;
#pragma unroll
        for (int c = 0; c < NC; c += 2) cnt4(a0, b0, ka[c], kb[c], ka[c + 1], kb[c + 1], 0x80000000u, 0x80000000u);
        unsigned mxa = 0u, mxb = 0u;
#pragma unroll
        for (int c = 0; c < NC; ++c) { mxa = ka[c] > mxa ? ka[c] : mxa; mxb = kb[c] > mxb ? kb[c] : mxb; }
        const int t0s = wave_sum_dpp(a0 | (b0 << 16));
        const unsigned kmxa = wave_max_dpp(mxa), kmxb = wave_max_dpp(mxb);
        unsigned kmna = 0u, kmnb = 0u;
        if ((t0s & 0xffff) < 256 || (t0s >> 16) < 256) {
            unsigned mna = 0u, mnb = 0u;
#pragma unroll
            for (int c = 0; c < NC; ++c) { const unsigned ia = ~(ka[c] - 1u), ib = ~(kb[c] - 1u); mna = ia > mna ? ia : mna; mnb = ib > mnb ? ib : mnb; }
            kmna = ~wave_max_dpp(mna) + 1u; kmnb = ~wave_max_dpp(mnb) + 1u;
        }
        A.init(ta + 1 > 256, ta + 1, t0s & 0xffff, kmxa, kmna);
        B.init(true, ta + 2, t0s >> 16, kmxb, kmnb);
        for (int it = 0; it < 64; ++it) {
            const unsigned ca = A.next_cand(it), cb = B.next_cand(it);
            if (!(A.act || B.act)) break;
            int na = 0, nb = 0;
#pragma unroll
            for (int c = 0; c < NC; c += 2) cnt4(na, nb, ka[c], kb[c], ka[c + 1], kb[c + 1], ca, cb);
            const int tot = wave_sum_dpp(na | (nb << 16));
            A.update(ca, tot & 0xffff); B.update(cb, tot >> 16);
        }
    } else { A.init(false, 0, 0, 0u, 0u); B.init(false, 0, 0, 0u, 0u); }
    build_mask<NC>(ka, A.thr, A.need, lane, ma);
    build_mask<NC>(kb, B.thr, B.need, lane, ma + 1);
}
__device__ __forceinline__ void select_phase(Frame& F, const bf16* QI, const bf16* KI, const float* WI, unsigned long long* MASK, const bf16* U, bf16* MIX) {
    LAS unsigned* SC = (LAS unsigned*)(F.lds + RING_OFF);
    const int lane = F.lane, wave = F.wave, fr = lane & 15, fq = lane >> 4;
    LAS unsigned* jobctr = (LAS unsigned*)(F.lds + LDSCTL_OFF + 512);
    if (F.tid < 16) jobctr[F.tid] = 0u;
    LDS_WAIT(); __builtin_amdgcn_s_barrier(); asm volatile("" ::: "memory");
    pg8::bf16x8 afr[4][2]; f32x4 w[4];
#pragma unroll 1
    for (int uu_ = 0; uu_ < 4 * SEL_REP; ++uu_) {
        const int ui = uu_ & 3, b = F.vcu >> 5, j = F.vcu & 31;
        const int g = (ui == 0) ? 127 - j : (ui == 1) ? 64 + j : (ui == 2) ? 63 - j : j;
        const int t0 = 16 * g; const size_t rowbase = (size_t)b * SEQ;
        const int nchunks = (t0 + 16 + 63) >> 6, ntiles = nchunks * 4;
        if (uu_ == 0) {
#pragma unroll
            for (int h = 0; h < 4; ++h)
#pragma unroll
                for (int ks = 0; ks < 2; ++ks) afr[h][ks] = *(const pg8::bf16x8*)(QI + (rowbase + t0 + fr) * 256 + 64 * h + 32 * ks + 8 * fq);
#pragma unroll
            for (int r = 0; r < 4; ++r) w[r] = *(const f32x4*)(WI + (rowbase + t0 + 4 * fq + r) * 4);
        }
#ifdef TS_SEL
        const unsigned long long tq0_ = rt();
#endif
        if (uu_ < 4 || SEL_ABL != 3) {
        LAS unsigned* ctr = jobctr + uu_;
#define SEL_DRAW(dst) { unsigned j_ = 0u; if (lane == 0) j_ = __hip_atomic_fetch_add(ctr, 1u, __ATOMIC_RELAXED, __HIP_MEMORY_SCOPE_WORKGROUP); dst = __builtin_amdgcn_readfirstlane((int)j_); }
#define SEL_LOAD(buf, jb) { const int jn_ = ((jb) < nchunks) ? (jb) : 0; _Pragma("unroll") for (int i = 0; i < 4; ++i) { const bf16* kp = KI + ((rowbase >> 4) + 4 * jn_ + i) * 1024 + (fq * 16 + fr) * 8; buf[i][0] = *(const pg8::bf16x8*)kp; buf[i][1] = *(const pg8::bf16x8*)(kp + 512); } }
        int job, nx1; SEL_DRAW(job); SEL_DRAW(nx1);
        pg8::bf16x8 bfr[4][2], bn1[4][2];
        SEL_LOAD(bfr, job); SEL_LOAD(bn1, nx1);
#pragma unroll 1
        while (job < nchunks) {
            int nx2; SEL_DRAW(nx2);
            pg8::bf16x8 bn2[4][2];
            SEL_LOAD(bn2, nx2);
#pragma unroll
            for (int i = 0; i < 4; ++i) {
                const int tile = 4 * job + i;
                {
                    const int key = 16 * tile + fr;
                    f32x4 acc[4];
#pragma unroll
                    for (int h = 0; h < 4; ++h) {
                        acc[h] = __builtin_amdgcn_mfma_f32_16x16x32_bf16(afr[h][0], bfr[i][0], (f32x4){0.f, 0.f, 0.f, 0.f}, 0, 0, 0);
                        acc[h] = __builtin_amdgcn_mfma_f32_16x16x32_bf16(afr[h][1], bfr[i][1], acc[h], 0, 0, 0);
                    }
                    const bool edge = 16 * tile + 15 > t0;
#pragma unroll
                    for (int r = 0; r < 4; ++r) {
                        float sc = 0.f;
#pragma unroll
                        for (int h = 0; h < 4; ++h) { const int ri = __float_as_int(acc[h][r]); sc = fmaf(w[r][h], __int_as_float(ri > 0 ? ri : 0), sc); }
                        const int u = __float_as_int(sc);
                        unsigned sk = (unsigned)u ^ ((unsigned)(u >> 31) | 0x80000000u);
                        if (edge) sk = (key <= t0 + 4 * fq + r) ? sk : 0u;
                        SC[(4 * fq + r) * SC_LD + key] = sk;
                    }
                }
            }
#pragma unroll
            for (int i = 0; i < 4; ++i) { bfr[i][0] = bn1[i][0]; bfr[i][1] = bn1[i][1]; bn1[i][0] = bn2[i][0]; bn1[i][1] = bn2[i][1]; }
            job = nx1; nx1 = nx2;
        }
#undef SEL_DRAW
#undef SEL_LOAD
        }
        if (uu_ + 1 < 4 * SEL_REP) {
            const int ui2 = (uu_ + 1) & 3, g2 = (ui2 == 0) ? 127 - j : (ui2 == 1) ? 64 + j : (ui2 == 2) ? 63 - j : j, t02 = 16 * g2;
#pragma unroll
            for (int h = 0; h < 4; ++h)
#pragma unroll
                for (int ks = 0; ks < 2; ++ks) afr[h][ks] = *(const pg8::bf16x8*)(QI + (rowbase + t02 + fr) * 256 + 64 * h + 32 * ks + 8 * fq);
#pragma unroll
            for (int r = 0; r < 4; ++r) w[r] = *(const f32x4*)(WI + (rowbase + t02 + 4 * fq + r) * 4);
        }
#ifdef TS_SEL
        const unsigned long long tq1_ = rt();
#endif
        LDS_WAIT(); __builtin_amdgcn_s_barrier(); asm volatile("" ::: "memory");
#ifdef TS_SEL
        const unsigned long long tq2_ = rt();
#endif
        {
            const int ncr = (nchunks + 3) >> 2;
            const int rl = 2 * wave, t = t0 + rl;
            const LAS unsigned* srow = SC + rl * SC_LD;
            GAS unsigned long long* mrow = (GAS unsigned long long*)MASK + (uu_ >= 4 ? (size_t)202 * 1024 * 1024 / 8 : (size_t)0) + (size_t)b * 32 * SEQ + t;
            if (uu_ < 4 || SEL_ABL == 1 || SEL_ABL == 3) switch (ncr) {
                case 1: select_rows2<4>(srow, nchunks, t, lane, mrow); break;
                case 2: select_rows2<8>(srow, nchunks, t, lane, mrow); break;
                case 3: select_rows2<12>(srow, nchunks, t, lane, mrow); break;
                case 4: select_rows2<16>(srow, nchunks, t, lane, mrow); break;
                case 5: select_rows2<20>(srow, nchunks, t, lane, mrow); break;
                case 6: select_rows2<24>(srow, nchunks, t, lane, mrow); break;
                case 7: select_rows2<28>(srow, nchunks, t, lane, mrow); break;
                default: select_rows2<32>(srow, nchunks, t, lane, mrow); break;
            }
            else { LDS_WAIT(); __builtin_amdgcn_s_barrier(); asm volatile("" ::: "memory"); }
        }
#ifdef TS_SEL
        if (blockIdx.x == 0 && F.tid == 0) { F.MISC[80] += (unsigned)(tq1_ - tq0_); F.MISC[81] += (unsigned)(tq2_ - tq1_); F.MISC[82] += (unsigned)(rt() - tq2_); }
#endif
    }
    const int gw = F.vcu * NWAVES + F.wave, NGW = F.G * NWAVES;
#pragma unroll 1
    for (int task = gw; task < POOL_REP * (M / 4); task += NGW) {
        const int row0 = (task & (M / 4 - 1)) * 4, tq = row0 & (SEQ - 1);
        v4u uu[19];
#pragma unroll
        for (int i = 0; i < 19; ++i) { const int dt = i - 15; uu[i] = (tq + dt >= 0) ? *(const GAS v4u*)(U + (size_t)(row0 + dt) * 512 + 8 * lane) : (v4u){0u, 0u, 0u, 0u}; }
        const int gsel = lane >> 4;
#pragma unroll
        for (int i = 0; i < 4; ++i) {
            const int t = tq + i, wl = 2 << gsel, n = (t + 1 < wl) ? (t + 1) : wl; const float inv = 1.0f / (float)n;
            unsigned ow[4];
#pragma unroll
            for (int q = 0; q < 4; ++q) {
                float lo[16], hi[16];
#pragma unroll
                for (int jj = 0; jj < 16; ++jj) { const unsigned x = uu[15 + i - jj][q]; lo[jj] = __uint_as_float(x << 16); hi[jj] = __uint_as_float(x & 0xffff0000u); }
                const float l2 = lo[0] + lo[1], h2 = hi[0] + hi[1];
                const float l4 = l2 + (lo[2] + lo[3]), h4 = h2 + (hi[2] + hi[3]);
                const float l8 = l4 + ((lo[4] + lo[5]) + (lo[6] + lo[7])), h8 = h4 + ((hi[4] + hi[5]) + (hi[6] + hi[7]));
                const float l16 = l8 + (((lo[8] + lo[9]) + (lo[10] + lo[11])) + ((lo[12] + lo[13]) + (lo[14] + lo[15]))), h16 = h8 + (((hi[8] + hi[9]) + (hi[10] + hi[11])) + ((hi[12] + hi[13]) + (hi[14] + hi[15])));
                const float sl = (gsel == 0) ? l2 : (gsel == 1) ? l4 : (gsel == 2) ? l8 : l16, sh = (gsel == 0) ? h2 : (gsel == 1) ? h4 : (gsel == 2) ? h8 : h16;
                ow[q] = pk2(sl * inv - lo[0], sh * inv - hi[0]);
            }
            *(GAS v4u*)(MIX + (size_t)(row0 + i) * 1024 + 512 + 8 * lane) = (v4u){ow[0], ow[1], ow[2], ow[3]};
        }
    }
}

#include <hip/hip_bf16.h>
namespace attn_body {
using bf16=__hip_bfloat16;
using bf16x8=__attribute__((ext_vector_type(8)))short;
using s16x4=__attribute__((ext_vector_type(4)))short;
using f32x16=__attribute__((ext_vector_type(16)))float;
using u32x4=__attribute__((ext_vector_type(4)))unsigned;
constexpr int BATCH=8,NHEAD=8,SEQ=2048,D=64,KP=512,OP=1024;
constexpr int NW=8,QBLK=32,QB=QBLK*NW,KVBLK=64,NQB=SEQ/QB;
constexpr int ATTN_UNIT_ROWS=QB;
__device__ __forceinline__ int crow(int r,int hi){return (r&3)+8*(r>>2)+4*hi;}
#define SBAR() __builtin_amdgcn_sched_barrier(0)
__device__ __forceinline__ void cmask(f32x16&p0,f32x16&p1,int jb,int qrel,int hi){
  const float NEG=-INFINITY; int kb=64*jb+4*hi;
  #pragma unroll
  for(int r=0;r<16;++r){int kv=kb+(r&3)+8*(r>>2); if(kv>qrel)p0[r]=NEG; if(kv+32>qrel)p1[r]=NEG;}
}

constexpr int NSLOT=3, SLOTB=8192;
constexpr int LDS_K=0, LDS_V=NSLOT*SLOTB, LDS_WS=2*NSLOT*SLOTB, LDS_OST=LDS_WS+NW*64*4, LDS_BYTES=LDS_OST+NW*4096, LDS_MASK=LDS_BYTES, LDS_TOTAL=LDS_MASK+32*2048;
constexpr float C2=0.125f*1.4426950408889634f;
__device__ __forceinline__ void glds16(const void*sbase,unsigned voff,unsigned lds_dst){unsigned keep;
  asm volatile("s_mov_b32 %0, m0\n\ts_mov_b32 m0, %2\n\ts_nop 4\n\tglobal_load_lds_dwordx4 %1, %3\n\ts_mov_b32 m0, %0":"=&s"(keep):"v"(voff),"s"(lds_dst),"s"(sbase):"memory");}
__device__ __forceinline__ float max3f(float a,float b,float c){float r;asm("v_max3_f32 %0, %1, %2, %3":"=v"(r):"v"(a),"v"(b),"v"(c));return r;}
__device__ __forceinline__ float max2f(float a,float b){float r;asm("v_max_f32_e32 %0, %1, %2":"=v"(r):"v"(a),"v"(b));return r;}
__device__ __forceinline__ float fadd_s(float a,float b){float r;asm("v_add_f32_e32 %0, %1, %2":"=v"(r):"v"(a),"v"(b));return r;}
__device__ __forceinline__ float fsub_s(float a,float b){float r;asm("v_sub_f32_e32 %0, %1, %2":"=v"(r):"v"(a),"v"(b));return r;}
typedef float f32x2_t __attribute__((ext_vector_type(2))); typedef __bf16 bf16x2_t __attribute__((ext_vector_type(2)));
__device__ __forceinline__ unsigned cvtpk_s(float lo,float hi){f32x2_t v={lo,hi};bf16x2_t b=__builtin_convertvector(v,bf16x2_t);return __builtin_bit_cast(unsigned,b);}
#define WAIT_BAR(N) asm volatile("s_waitcnt vmcnt(" #N ") lgkmcnt(0)\n\ts_barrier":::"memory")

__device__ __forceinline__ void qkt(f32x16&p0,f32x16&p1,const char*Kslot,const bf16x8*qr,const f32x16&negm,int r32,int hi){
  const char*kb=Kslot+hi*1024+r32*16;
  #pragma unroll
  for(int d0=0;d0<4;++d0){
    const bf16x8 b0=*reinterpret_cast<const bf16x8*>(kb+d0*2048);
    const bf16x8 b1=*reinterpret_cast<const bf16x8*>(kb+d0*2048+512);
    if(d0==0){p0=__builtin_amdgcn_mfma_f32_32x32x16_bf16(b0,qr[0],negm,0,0,0);p1=__builtin_amdgcn_mfma_f32_32x32x16_bf16(b1,qr[0],negm,0,0,0);}
    else{p0=__builtin_amdgcn_mfma_f32_32x32x16_bf16(b0,qr[d0],p0,0,0,0);p1=__builtin_amdgcn_mfma_f32_32x32x16_bf16(b1,qr[d0],p1,0,0,0);}}
}
typedef __attribute__((address_space(3))) const char* lds_cptr;
typedef short v4i16_t __attribute__((ext_vector_type(4)));
__device__ __forceinline__ void kload8(bf16x8*kf,lds_cptr kp){
  kf[0]=*(const __attribute__((address_space(3))) bf16x8*)(kp);      kf[1]=*(const __attribute__((address_space(3))) bf16x8*)(kp+512);
  kf[2]=*(const __attribute__((address_space(3))) bf16x8*)(kp+2048); kf[3]=*(const __attribute__((address_space(3))) bf16x8*)(kp+2560);
  kf[4]=*(const __attribute__((address_space(3))) bf16x8*)(kp+4096); kf[5]=*(const __attribute__((address_space(3))) bf16x8*)(kp+4608);
  kf[6]=*(const __attribute__((address_space(3))) bf16x8*)(kp+6144); kf[7]=*(const __attribute__((address_space(3))) bf16x8*)(kp+6656);
}
__device__ __forceinline__ void kload2(bf16x8*kf,lds_cptr kp,int j){ kf[2*j]=*(const __attribute__((address_space(3))) bf16x8*)(kp+j*2048); kf[2*j+1]=*(const __attribute__((address_space(3))) bf16x8*)(kp+j*2048+512); }
__device__ __forceinline__ s16x4 vtr(lds_cptr p){ return __builtin_bit_cast(s16x4,__builtin_amdgcn_ds_read_tr16_b64_v4i16((__attribute__((address_space(3))) v4i16_t*)p)); }
__device__ __forceinline__ float rowmax(const f32x16&p0,const f32x16&p1){
  float a=max3f(p0[0],p0[1],p1[0]),b=max3f(p0[2],p0[3],p1[1]);a=max3f(a,p1[2],p1[3]);
  #pragma unroll
  for(int r=4;r<16;r+=4){a=max3f(a,p0[r],p0[r+1]);b=max3f(b,p0[r+2],p0[r+3]);a=max3f(a,p1[r],p1[r+1]);b=max3f(b,p1[r+2],p1[r+3]);}
  const float m=max2f(a,b);
  auto rr=__builtin_amdgcn_permlane32_swap(__float_as_uint(m),__float_as_uint(m),false,false);
  return max2f(__uint_as_float(rr[0]),__uint_as_float(rr[1]));
}
__device__ __forceinline__ void pv(f32x16*o,int vb,bf16x8 pa0,bf16x8 pa1,bf16x8 pa2,bf16x8 pa3){
  #pragma unroll
  for(int d0=0;d0<2;++d0){s16x4 lo[4],hi[4];
    #pragma unroll
    for(int ks=0;ks<4;++ks){
      asm volatile("ds_read_b64_tr_b16 %0,%1 offset:%c2":"=&v"(lo[ks]):"v"(vb),"i"(d0*4096+ks*1024):"memory");
      asm volatile("ds_read_b64_tr_b16 %0,%1 offset:%c2":"=&v"(hi[ks]):"v"(vb),"i"(d0*4096+ks*1024+512):"memory");}
    asm volatile("s_waitcnt lgkmcnt(0)":::"memory");SBAR();
    #define PK(k) (bf16x8){lo[k][0],lo[k][1],lo[k][2],lo[k][3],hi[k][0],hi[k][1],hi[k][2],hi[k][3]}
    o[d0]=__builtin_amdgcn_mfma_f32_32x32x16_bf16(pa0,PK(0),o[d0],0,0,0);
    o[d0]=__builtin_amdgcn_mfma_f32_32x32x16_bf16(pa1,PK(1),o[d0],0,0,0);
    o[d0]=__builtin_amdgcn_mfma_f32_32x32x16_bf16(pa2,PK(2),o[d0],0,0,0);
    o[d0]=__builtin_amdgcn_mfma_f32_32x32x16_bf16(pa3,PK(3),o[d0],0,0,0);
    #undef PK
  }
}

#ifndef ATTN_STORE16
#define ATTN_STORE16(p,v) (*(u32x4*)(p)=(v))
#endif
template<int THRL> __device__ __forceinline__ void attn_unit(int b,int h,int qb,const bf16*Q,const bf16*__restrict__ K,const bf16*__restrict__ V,bf16*O,const unsigned long long*MASKT,char*shm,const int wave_id){
  const int wid=wave_id,lane=(int)__builtin_amdgcn_mbcnt_hi(~0u,__builtin_amdgcn_mbcnt_lo(~0u,0u)),tid=wid*64+lane,r32=lane&31,hi=lane>>5;
  const long rowbase=(long)b*SEQ; const int q0=qb*QB; const int NT=(q0+QB)/KVBLK;
  const bf16*Qw=Q+(rowbase+q0+wid*QBLK)*KP+h*D;
  const bf16*Kh=K+((long)(b*NHEAD+h)*(SEQ/KVBLK))*4096,*Vh=V+((long)(b*NHEAD+h)*(SEQ/KVBLK))*4096;
  const unsigned lds0=(unsigned)(uintptr_t)shm;
  float*wsf=(float*)(shm+LDS_WS)+wid*64;
  const bf16*ksrc=Kh+wid*512,*vsrc=Vh+wid*512; const unsigned dmaoff=(unsigned)lane*16u;
  const unsigned kdst=lds0+LDS_K+wid*1024, vdst=lds0+LDS_V+wid*1024;
  #define DMA_K(t,slot) glds16(ksrc+(long)(t)*4096,dmaoff,(unsigned)__builtin_amdgcn_readfirstlane(kdst+(slot)))
  #define DMA_V(t,slot) glds16(vsrc+(long)(t)*4096,dmaoff,(unsigned)__builtin_amdgcn_readfirstlane(vdst+(slot)))
  const char*Kbase=shm+LDS_K; bf16x8 kf[8];
  const lds_cptr shm3=(lds_cptr)shm; const lds_cptr kp0=shm3+LDS_K+hi*1024+r32*16; const lds_cptr vp0=shm3+LDS_V+((lane>>4)&1)*32+(lane&3)*8+(4*hi+((lane&15)>>2))*64;
  { int tl=tid; asm volatile("":"+v"(tl));
    const int npc=NT*128; const unsigned long long*msrc=MASKT+((long)b*32)*SEQ+q0; u32x4 mv[8];
    #pragma unroll
    for(int i=0;i<8;++i){ const int p=tl+i*NW*64; if(p<npc)mv[i]=*reinterpret_cast<const u32x4*>(msrc+(long)(p>>7)*SEQ+(p&127)*2); }
    #pragma unroll
    for(int i=0;i<8;++i){ const int p=tl+i*NW*64; if(p<npc)*reinterpret_cast<__attribute__((address_space(3))) u32x4*>((__attribute__((address_space(3))) char*)(lds_cptr)shm+LDS_MASK+(p>>7)*2048+(p&127)*16)=mv[i]; } }
  asm volatile("s_waitcnt vmcnt(0) lgkmcnt(0)":::"memory");
  DMA_K(0,0);DMA_V(0,0);DMA_K(1,SLOTB);
  bf16x8 qr[4];
  #pragma unroll
  for(int d0=0;d0<4;++d0)qr[d0]=*reinterpret_cast<const bf16x8*>(&Qw[(long)r32*KP+d0*16+hi*8]);
  #define BP(r) (((r)&3)+8*((r)>>2))
  #define EXM(x,w,r) __uint_as_float(__float_as_uint(__builtin_amdgcn_exp2f(x))&(unsigned)__builtin_amdgcn_sbfe((int)(w),BP(r),1))
  #define MASKLD(tt,m0,m1) int ro_=r32; asm volatile("":"+v"(ro_)); const unsigned long long mw_=*(const __attribute__((address_space(3))) unsigned long long*)((lds_cptr)shm+LDS_MASK+wid*(QBLK*8)+ro_*8+(tt)*2048); const unsigned m0=((unsigned)mw_)>>(4*hi),m1=((unsigned)(mw_>>32))>>(4*hi)
  float mhat=0.f,l_reg=0.f;f32x16 o[2];o[0]=f32x16{};o[1]=f32x16{};f32x16 negm=f32x16{};asm volatile("":"+v"(negm));
  const int qrel=wid*QBLK+r32;
  #define CMASK(P0,P1,t) do{}while(0)
  bool resc=false;
  #define START(P0,P1) do{ const float rm=rowmax(P0,P1); resc=false; \
    { const float dl=rm; mhat=fadd_s(mhat,dl); \
      _Pragma("unroll") for(int r=0;r<16;++r){P0[r]=fsub_s(P0[r],dl);P1[r]=fsub_s(P1[r],dl);} \
      _Pragma("unroll") for(int r=0;r<16;++r)negm[r]=-mhat; asm volatile("":"+v"(negm)); } \
    _Pragma("unroll") for(int r=0;r<16;++r)P0[r]=EXM(P0[r],mS0,r); }while(0)
  #define RESC() do{ if(resc){ asm volatile("s_waitcnt lgkmcnt(0)":::"memory"); \
      _Pragma("unroll") for(int d_=0;d_<2;++d_) _Pragma("unroll") for(int r=0;r<16;++r)o[d_][r]*=wsf[crow(r,hi)]; } }while(0)
  f32x16 pA0,pA1,pB0,pB1;
  int sl_prev=0,sl_cur=0,sl_next=SLOTB;
  #define ROT() do{sl_prev=sl_cur;sl_cur=sl_next;sl_next=(sl_next==(NSLOT-1)*SLOTB)?0:sl_next+SLOTB;}while(0)
  DMA_K(2,2*SLOTB);
  WAIT_BAR(3);
  qkt(pA0,pA1,Kbase,qr,negm,r32,hi);asm volatile("s_nop 15\n\ts_nop 7":"+v"(pA0),"+v"(pA1));CMASK(pA0,pA1,0);
  { MASKLD(0,mS0,mS1);
  START(pA0,pA1);
  _Pragma("unroll") for(int r=0;r<16;++r)pA1[r]=EXM(pA1[r],mS1,r); }
  WAIT_BAR(0);
  DMA_K(3,0);DMA_V(1,SLOTB);
  ROT();
  kload8(kf,kp0+sl_cur);
  WAIT_BAR(2);
  s16x4 vlo[8],vhi[8]; u32x4 pw0,pw1,pw2,pw3;
  #define PKW(P,B) cvtpk_s(P[B],P[B+1])
  #define PAF(k) __builtin_bit_cast(bf16x8,pw##k)
  #define VFR(i) (bf16x8){vlo[i][0],vlo[i][1],vlo[i][2],vlo[i][3],vhi[i][0],vhi[i][1],vhi[i][2],vhi[i][3]}
  #define PIN(x) asm volatile("":"+v"(x))
  #define MX3(a,b,c) __builtin_fmaxf(__builtin_fmaxf((a),(b)),(c))
  #define GAPA(MF,A0,A1,A2,A3,W0,W1,PW) do{ MF; sacc+=A0; sacc+=A1; sacc+=A2; sacc+=A3; PIN(sacc); W0; W1; PIN(PW); SBAR(); }while(0)
  #define EX(v) __builtin_amdgcn_exp2f(v)
  #define GAPB(MF,X,B,W) do{ MF; X[B]=EXM(X[B],W,B); X[B+1]=EXM(X[B+1],W,B+1); X[B+2]=EXM(X[B+2],W,B+2); X[B+3]=EXM(X[B+3],W,B+3); PIN(X); SBAR(); }while(0)
  #define VRD(i) do{ vlo[i]=vtr(vp_+(((i)>>2)*4096+((i)&3)*1024)); vhi[i]=vtr(vp_+(((i)>>2)*4096+((i)&3)*1024+512)); }while(0)
  #define KRD(G,j) do{ if(G){ kload2(kf,kp0+sl_next,j); SBAR(); } }while(0)
  #define STEP(C0,C1,P0,P1,t,GK,GV,GL) do{ SBAR(); \
    const lds_cptr vp_=vp0+sl_prev; \
    VRD(0); SBAR(); float sacc=(P0[0]+P0[1]); \
    GAPA(C0=__builtin_amdgcn_mfma_f32_32x32x16_bf16(kf[0],qr[0],negm,0,0,0), P0[2],P0[3],P0[4],P0[5],     pw0[0]=PKW(P0,0), pw0[1]=PKW(P0,2), pw0); \
    VRD(4); SBAR(); GAPA(C1=__builtin_amdgcn_mfma_f32_32x32x16_bf16(kf[1],qr[0],negm,0,0,0), P0[6],P0[7],P0[8],P0[9],     pw0[2]=PKW(P0,4), pw0[3]=PKW(P0,6), pw0); \
    VRD(1); SBAR(); GAPA(C0=__builtin_amdgcn_mfma_f32_32x32x16_bf16(kf[2],qr[1],C0,0,0,0),   P0[10],P0[11],P0[12],P0[13], pw1[0]=PKW(P0,8), pw1[1]=PKW(P0,10), pw1); \
    VRD(5); SBAR(); GAPA(C1=__builtin_amdgcn_mfma_f32_32x32x16_bf16(kf[3],qr[1],C1,0,0,0),   P0[14],P0[15],P1[0],P1[1],   pw1[2]=PKW(P0,12),pw1[3]=PKW(P0,14), pw1); \
    VRD(2); SBAR(); GAPA(C0=__builtin_amdgcn_mfma_f32_32x32x16_bf16(kf[4],qr[2],C0,0,0,0),   P1[2],P1[3],P1[4],P1[5],     pw2[0]=PKW(P1,0), pw2[1]=PKW(P1,2), pw2); \
    VRD(6); SBAR(); GAPA(C1=__builtin_amdgcn_mfma_f32_32x32x16_bf16(kf[5],qr[2],C1,0,0,0),   P1[6],P1[7],P1[8],P1[9],     pw2[2]=PKW(P1,4), pw2[3]=PKW(P1,6), pw2); \
    VRD(3); SBAR(); GAPA(C0=__builtin_amdgcn_mfma_f32_32x32x16_bf16(kf[6],qr[3],C0,0,0,0),   P1[10],P1[11],P1[12],P1[13], pw3[0]=PKW(P1,8), pw3[1]=PKW(P1,10), pw3); \
    VRD(7); SBAR(); GAPA(C1=__builtin_amdgcn_mfma_f32_32x32x16_bf16(kf[7],qr[3],C1,0,0,0),   P1[14],P1[15],0.f,0.f,       pw3[2]=PKW(P1,12),pw3[3]=PKW(P1,14), pw3); \
    l_reg+=sacc; \
    if(GK){DMA_K((t)+3,sl_cur);} if(GV){DMA_V((t)+1,sl_next);} \
    MASKLD(t,mA_,mB_); \
    { float a=MX3(C0[0],C0[1],C1[0]),b=MX3(C0[2],C0[3],C1[1]); a=MX3(a,C1[2],C1[3]); \
      _Pragma("unroll") for(int r=4;r<16;r+=4){a=MX3(a,C0[r],C0[r+1]);b=MX3(b,C0[r+2],C0[r+3]);a=MX3(a,C1[r],C1[r+1]);b=MX3(b,C1[r+2],C1[r+3]);} \
      float rm=__builtin_fmaxf(a,b); { auto rr=__builtin_amdgcn_permlane32_swap(__float_as_uint(rm),__float_as_uint(rm),false,false); rm=__builtin_fmaxf(__uint_as_float(rr[0]),__uint_as_float(rr[1])); } \
      resc=false; \
      if(__builtin_expect(__any(rm>(float)THRL),0)){ const float dl=__builtin_fmaxf(rm,0.f); mhat+=dl; \
        _Pragma("unroll") for(int r=0;r<16;++r){C0[r]-=dl;C1[r]-=dl;} \
        _Pragma("unroll") for(int r=0;r<16;++r)negm[r]=-mhat; asm volatile("":"+v"(negm)); \
        const float f=__builtin_amdgcn_exp2f(-dl); l_reg*=f; { int rq_=r32; asm volatile("":"+v"(rq_)); if(hi==0)wsf[rq_]=f; } resc=true; } } \
    SBAR(); \
    GAPB(o[0]=__builtin_amdgcn_mfma_f32_32x32x16_bf16(PAF(0),VFR(0),o[0],0,0,0), C0,0,mA_); \
    GAPB(o[1]=__builtin_amdgcn_mfma_f32_32x32x16_bf16(PAF(0),VFR(4),o[1],0,0,0), C0,4,mA_); \
    KRD(GL,0); GAPB(o[0]=__builtin_amdgcn_mfma_f32_32x32x16_bf16(PAF(1),VFR(1),o[0],0,0,0), C0,8,mA_); \
    KRD(GL,1); GAPB(o[1]=__builtin_amdgcn_mfma_f32_32x32x16_bf16(PAF(1),VFR(5),o[1],0,0,0), C0,12,mA_); \
    KRD(GL,2); GAPB(o[0]=__builtin_amdgcn_mfma_f32_32x32x16_bf16(PAF(2),VFR(2),o[0],0,0,0), C1,0,mB_); \
    KRD(GL,3); GAPB(o[1]=__builtin_amdgcn_mfma_f32_32x32x16_bf16(PAF(2),VFR(6),o[1],0,0,0), C1,4,mB_); \
    GAPB(o[0]=__builtin_amdgcn_mfma_f32_32x32x16_bf16(PAF(3),VFR(3),o[0],0,0,0), C1,8,mB_); \
    GAPB(o[1]=__builtin_amdgcn_mfma_f32_32x32x16_bf16(PAF(3),VFR(7),o[1],0,0,0), C1,12,mB_); \
    }while(0)
  int t=1;
  #undef CMASK
  #define CMASK(P0,P1,t) do{}while(0)
  for(;t+5<NT;t+=2){
    STEP(pB0,pB1,pA0,pA1,t,true,true,true);     WAIT_BAR(2); RESC(); ROT();
    STEP(pA0,pA1,pB0,pB1,t+1,true,true,true);   WAIT_BAR(2); RESC(); ROT();
  }
  #undef CMASK
  #define CMASK(P0,P1,t) do{}while(0)
  #define ENDW(tt) do{ if((tt)+3<NT){WAIT_BAR(2);} else if((tt)+2<NT){WAIT_BAR(1);} else {WAIT_BAR(0);} }while(0)
  for(;t+1<NT;t+=2){
    STEP(pB0,pB1,pA0,pA1,t,(t+3<NT),(t+1<NT),(t+1<NT));       ENDW(t);   RESC(); ROT();
    STEP(pA0,pA1,pB0,pB1,t+1,(t+4<NT),(t+2<NT),(t+2<NT));     ENDW(t+1); RESC(); ROT();
  }
  STEP(pB0,pB1,pA0,pA1,NT-1,false,false,false); RESC();
  { float sacc=pB0[0]+pB0[1]; _Pragma("unroll") for(int r=2;r<16;++r)sacc+=pB0[r]; _Pragma("unroll") for(int r=0;r<16;++r)sacc+=pB1[r]; l_reg+=sacc;
    pw0=(u32x4){PKW(pB0,0),PKW(pB0,2),PKW(pB0,4),PKW(pB0,6)};pw1=(u32x4){PKW(pB0,8),PKW(pB0,10),PKW(pB0,12),PKW(pB0,14)};pw2=(u32x4){PKW(pB1,0),PKW(pB1,2),PKW(pB1,4),PKW(pB1,6)};pw3=(u32x4){PKW(pB1,8),PKW(pB1,10),PKW(pB1,12),PKW(pB1,14)};
    SBAR(); { int lq_=lane; asm volatile("":"+v"(lq_)); const int vb0=(int)(lds0+LDS_V)+((lq_>>4)&1)*32+(lq_&3)*8+(4*(lq_>>5)+((lq_&15)>>2))*64; pv(o,vb0+sl_cur,PAF(0),PAF(1),PAF(2),PAF(3)); } }
  #undef PKW
  #undef PAF
  #undef VFR
  #undef PIN
  #undef MX3
  #undef GAPA
  #undef GAPB
  #undef EX
  #undef VRD
  #undef KRD
  #undef STEP
  #undef ENDW
  {auto rr=__builtin_amdgcn_permlane32_swap(__float_as_uint(l_reg),__float_as_uint(l_reg),false,false);l_reg=__uint_as_float(rr[0])+__uint_as_float(rr[1]);}
  if(hi==0)wsf[32+r32]=l_reg;asm volatile("s_waitcnt lgkmcnt(0)":::"memory");
  float rli[16];
  #pragma unroll
  for(int r=0;r<16;++r)rli[r]=__builtin_amdgcn_rcpf(wsf[32+crow(r,hi)]);
  bf16*Ow=O+(rowbase+q0+wid*QBLK)*OP+h*D;
  { bf16*stg=(bf16*)(shm+LDS_OST)+wid*2048;
    #pragma unroll
    for(int r=0;r<16;++r){const int orow=crow(r,hi);
      #pragma unroll
      for(int d0=0;d0<2;++d0)stg[orow*64+d0*32+r32]=__float2bfloat16(o[d0][r]*rli[r]);}
    asm volatile("s_waitcnt lgkmcnt(0)":::"memory");
    #pragma unroll
    for(int i=0;i<4;++i){const int row=i*8+(lane>>3),ch=lane&7; const u32x4 v=*(const u32x4*)(stg+row*64+ch*8); ATTN_STORE16(Ow+(long)row*OP+ch*8,v);} }
  asm volatile("s_waitcnt lgkmcnt(0)\n\ts_barrier":::"memory");
  #undef DMA_K
  #undef DMA_V
  #undef CMASK
  #undef START
  #undef RESC
  #undef ROT
  #undef BP
  #undef EXM
  #undef MASKLD
}
constexpr int ATTN_LDS_BYTES=LDS_BYTES;
struct AttnTensors { const bf16* Q; const bf16* K; const bf16* V; bf16* O; const unsigned long long* MASKT; };
struct AttnUnit { int bh; int qb; };
struct StaticOrder {
  int vcu;
  __device__ __forceinline__ explicit StaticOrder(int grid,int block):vcu((block%8)*(grid/8)+block/8){}
  __device__ __forceinline__ bool next(int i,AttnUnit&u)const{ if(i>=2)return false; const int s=vcu&3; u.bh=vcu>>2; u.qb=(i==0)?7-s:s; return true; }
  __device__ __forceinline__ void a_ready(const AttnUnit&)const{}
  __device__ __forceinline__ void done(const AttnUnit&)const{}
};
template<class Sched,int THRL=8> __device__ __forceinline__ void attn_phase(char*lds,const AttnTensors&T,const Sched&S,const int wave_id){
  AttnUnit u;
  for(int i=0;S.next(i,u);++i){ S.a_ready(u); attn_unit<THRL>(u.bh/NHEAD,u.bh%NHEAD,u.qb,T.Q,T.K,T.V,T.O,T.MASKT,lds,wave_id); S.done(u); }
}
#undef SBAR
#undef WAIT_BAR
}


__global__ void __launch_bounds__(NWAVES * 64, 2) mk_fwd(Args args) {
    extern __shared__ __attribute__((aligned(16))) unsigned char lds[];
    Frame F;
    F.lds = (LAS unsigned char*)lds;
    F.MISC = (volatile LAS unsigned*)(F.lds + MISC_OFF);
    F.wave = __builtin_amdgcn_readfirstlane((int)threadIdx.x >> 6); F.lane = (int)__builtin_amdgcn_mbcnt_hi(~0u, __builtin_amdgcn_mbcnt_lo(~0u, 0u)); F.tid = F.wave * 64 + F.lane;
    F.G = gridDim.x; { const int bx = blockIdx.x; F.vcu = (F.G % 8 == 0) ? (bx % 8) * (F.G / 8) + bx / 8 : bx; }
    unsigned char* ws = args.ws;
    F.ctl = (gu32*)(ws + WS_CTL);
    for (int u = F.tid; u < (LDS_BYTES - LDSCTL_OFF) / 4; u += NWAVES * 64) ((LAS unsigned*)(F.lds + LDSCTL_OFF))[u] = 0u;
    __syncthreads();
    XcdBarrier bar = xcd_barrier_post((unsigned*)(F.ctl + CW_BAR) + args.li * XCD_BAR_WORDS, F.MISC + 8, F.wave);
    const int lo = args.ph_lo, hi = args.ph_hi;
#define IN(k) (lo <= (k) && (k) < hi)
#define BOTH(k) (IN(k) && IN((k) + 1))
#ifdef TS_SEL
    const unsigned long long ts0_ = rt();
#define GRID_BAR() do { xcd_barrier(bar); if (blockIdx.x == 0 && F.tid == 0) F.MISC[16 + (ts_n_++)] = (unsigned)(rt() - ts0_); } while (0)
    int ts_n_ = 0;
#else
#define GRID_BAR() xcd_barrier(bar)
#endif
    bf16* XB = (bf16*)(ws + WS_XB); bf16* MIX = (bf16*)(ws + WS_MIX); bf16* H = (bf16*)(ws + WS_H);
    float* sspA = (float*)(ws + WS_SSPA); float* sspB = (float*)(ws + WS_SSPB);
    float* cosH = (float*)(ws + WS_TAB); float* sinH = cosH + SEQ * 32; float* cosI = sinH + SEQ * 32; float* sinI = cosI + SEQ * 16;
    const float* x = args.in[0]; float* out = args.out;

    if (IN(0)) { p0_prologue(F, args);
#if PROBE_REP & 1
        GRID_BAR(); p0_prologue(F, args);
#endif
        if (BOTH(0)) GRID_BAR();
#ifdef PROBE_BARS
        for (int i_ = 0; i_ < PROBE_BARS; ++i_) GRID_BAR();
#endif
        }
    if (IN(1)) {
        {
        pg8::Gemm g{XB, (bf16*)(ws + WS_WGU1), M, NGU, D}; pg8::StaticOrder S; S.init(M, NGU, F.G, (int)blockIdx.x);
        pg8::EpiSwiGLU E{H, sspA};
        pg8::gemm_phase<pg8::EpiSwiGLU, pg8::StaticOrder, PG8_ALIGN, PG8_SP2>(F.lds + RING_OFF, g, S, E, F.wave);
#ifdef TS_SEL
        if (F.tid == 0 && blockIdx.x == 0) F.MISC[40] = (unsigned)(rt() - ts0_);
        if (F.tid == 0 && blockIdx.x == 200) ((gu32*)(ws + WS_CTL))[8192 + 0] = (unsigned)(rt() - ts0_);
#endif
        if (F.G == 256 && blockIdx.x >= 128) { weight_items(F, args, 1, ((int)blockIdx.x - 128) * NWAVES + F.wave, 128 * NWAVES); wpo_items(F, args, ((int)blockIdx.x - 128) * NWAVES + F.wave, 128 * NWAVES, 0, 1024); }
#ifdef TS_SEL
        asm volatile("s_waitcnt vmcnt(0)" ::: "memory");
        if (F.tid == 0 && blockIdx.x == 200) ((gu32*)(ws + WS_CTL))[8192 + 64] = (unsigned)(rt() - ts0_);
#endif
        }
#if PROBE_REP & (1 << 1)
        GRID_BAR();
        {
        pg8::Gemm g{XB, (bf16*)(ws + WS_WGU1), M, NGU, D}; pg8::StaticOrder S; S.init(M, NGU, F.G, (int)blockIdx.x);
        pg8::EpiSwiGLU E{H, sspA};
        pg8::gemm_phase<pg8::EpiSwiGLU, pg8::StaticOrder, PG8_ALIGN, PG8_SP2>(F.lds + RING_OFF, g, S, E, F.wave);
        }
#endif
        if (BOTH(1)) GRID_BAR();
    }
    if (IN(2)) {
        {
        pg8::Gemm g{H, (bf16*)(ws + WS_WD1), M, D, DFF}; pg8::StaticOrder S; S.init(M, D, F.G, (int)blockIdx.x);
        pg8::EpiResid<true, false, true> E{nullptr, nullptr, XB, sspA, 0.5f};
        pg8::gemm_phase<pg8::EpiResid<true, false, true>, pg8::StaticOrder, PG8_ALIGN, PG8_SP2>(F.lds + RING_OFF, g, S, E, F.wave);
#ifdef TS_SEL
        if (F.tid == 0) { const unsigned t_ = (unsigned)(rt() - ts0_); __hip_atomic_fetch_max((gu32*)(ws + WS_CTL) + 9216 + 128 * 1, 0x40000000u - t_, RLX_AGENT); __hip_atomic_fetch_max((gu32*)(ws + WS_CTL) + 9216 + 128 * 1 + 64, t_, RLX_AGENT); }
#endif

        }
#if PROBE_REP & (1 << 2)
        GRID_BAR();
        {
        pg8::Gemm g{H, (bf16*)(ws + WS_WD1), M, D, DFF}; pg8::StaticOrder S; S.init(M, D, F.G, (int)blockIdx.x);
        pg8::EpiResid<true, false, true> E{nullptr, nullptr, XB, sspA, 0.5f};
        pg8::gemm_phase<pg8::EpiResid<true, false, true>, pg8::StaticOrder, PG8_ALIGN, PG8_SP2>(F.lds + RING_OFF, g, S, E, F.wave);
        }
#endif
        if (BOTH(2)) GRID_BAR();
    }
    if (IN(3)) {
        {
        pg8::Gemm g{XB, (bf16*)(ws + WS_WIN), M, NIN, D}; pg8::StaticOrder S; S.init(M, NIN, F.G, (int)blockIdx.x);
        pg8::EpiInProj E{sspA, (bf16*)(ws + WS_Q), (bf16*)(ws + WS_K), (bf16*)(ws + WS_V), (bf16*)(ws + WS_U), (bf16*)(ws + WS_QI), (bf16*)(ws + WS_KI), (float*)(ws + WS_WI),
                         args.in[7], args.in[8], cosH, sinH, cosI, sinI, C2};
        pg8::gemm_phase<pg8::EpiInProj, pg8::StaticOrder, PG8_ALIGN, PG8_SP2>(F.lds + RING_OFF, g, S, E, F.wave);
#ifdef TS_SEL
        if (F.tid == 0 && blockIdx.x == 0) F.MISC[41] = (unsigned)(rt() - ts0_);
        if (F.tid == 0 && blockIdx.x == 200) ((gu32*)(ws + WS_CTL))[8192 + 128] = (unsigned)(rt() - ts0_);
#endif
        if (F.G == 256 && blockIdx.x >= 128) { weight_items(F, args, 2, ((int)blockIdx.x - 128) * NWAVES + F.wave, 128 * NWAVES); wpo_items(F, args, ((int)blockIdx.x - 128) * NWAVES + F.wave, 128 * NWAVES, 1024, 2048); }
#ifdef TS_SEL
        asm volatile("s_waitcnt vmcnt(0)" ::: "memory");
        if (F.tid == 0 && blockIdx.x == 200) ((gu32*)(ws + WS_CTL))[8192 + 192] = (unsigned)(rt() - ts0_);
#endif
        }
#if PROBE_REP & (1 << 3)
        GRID_BAR();
        {
        pg8::Gemm g{XB, (bf16*)(ws + WS_WIN), M, NIN, D}; pg8::StaticOrder S; S.init(M, NIN, F.G, (int)blockIdx.x);
        pg8::EpiInProj E{sspA, (bf16*)(ws + WS_Q), (bf16*)(ws + WS_K), (bf16*)(ws + WS_V), (bf16*)(ws + WS_U), (bf16*)(ws + WS_QI), (bf16*)(ws + WS_KI), (float*)(ws + WS_WI),
                         args.in[7], args.in[8], cosH, sinH, cosI, sinI, C2};
        pg8::gemm_phase<pg8::EpiInProj, pg8::StaticOrder, PG8_ALIGN, PG8_SP2>(F.lds + RING_OFF, g, S, E, F.wave);
        }
#endif
        if (BOTH(3)) GRID_BAR();
    }
    if (IN(4)) {
        {
        select_phase(F, (const bf16*)(ws + WS_QI), (const bf16*)(ws + WS_KI), (const float*)(ws + WS_WI), (unsigned long long*)(ws + WS_MASK), (const bf16*)(ws + WS_U), MIX);
        }
#if PROBE_REP & (1 << 4)
        GRID_BAR();
        {
        select_phase(F, (const bf16*)(ws + WS_QI), (const bf16*)(ws + WS_KI), (const float*)(ws + WS_WI), (unsigned long long*)(ws + WS_MASK), (const bf16*)(ws + WS_U), MIX);
        }
#endif
        if (BOTH(4)) GRID_BAR();
    }
    if (IN(5)) {
        {
        static_assert(attn_body::LDS_TOTAL <= LDSCTL_OFF, "attention LDS");
        const attn_body::AttnTensors AT{(const attn_body::bf16*)(ws + WS_Q), (const attn_body::bf16*)(ws + WS_K), (const attn_body::bf16*)(ws + WS_V), (attn_body::bf16*)MIX, (const unsigned long long*)(ws + WS_MASK)};
        const attn_body::StaticOrder S((int)F.G, (int)blockIdx.x);
        attn_body::attn_phase<attn_body::StaticOrder>((char*)lds + RING_OFF, AT, S, F.wave);
        }
#if PROBE_REP & (1 << 5)
        GRID_BAR();
        {
        static_assert(attn_body::LDS_TOTAL <= LDSCTL_OFF, "attention LDS");
        const attn_body::AttnTensors AT{(const attn_body::bf16*)(ws + WS_Q), (const attn_body::bf16*)(ws + WS_K), (const attn_body::bf16*)(ws + WS_V), (attn_body::bf16*)MIX, (const unsigned long long*)(ws + WS_MASK)};
        const attn_body::StaticOrder S((int)F.G, (int)blockIdx.x);
        attn_body::attn_phase<attn_body::StaticOrder>((char*)lds + RING_OFF, AT, S, F.wave);
        }
#endif
        if (BOTH(5)) GRID_BAR();
    }
    if (IN(6)) {
        pg8::Gemm g{MIX, (bf16*)(ws + WS_WOUT), M, D, D}; pg8::StaticOrder S; S.init(M, D, F.G, (int)blockIdx.x);
        pg8::EpiResid<true, false, true> E{nullptr, nullptr, XB, sspB, 1.0f};
        pg8::gemm_phase<pg8::EpiResid<true, false, true>, pg8::StaticOrder, PG8_ALIGN, PG8_SP2>(F.lds + RING_OFF, g, S, E, F.wave);
#if PROBE_REP & (1 << 6)
        GRID_BAR();
        { pg8::EpiResid<true, false, true> E2{nullptr, nullptr, (bf16*)(ws + 208 * MiB), (float*)(ws + 244 * MiB), 1.0f};
          pg8::gemm_phase<pg8::EpiResid<true, false, true>, pg8::StaticOrder, PG8_ALIGN, PG8_SP2>(F.lds + RING_OFF, g, S, E2, F.wave); }
#endif
        if (BOTH(6)) GRID_BAR();
    }
    if (IN(7)) {
        {
        pg8::Gemm g{XB, (bf16*)(ws + WS_WGU2), M, NGU, D}; pg8::StaticOrder S; S.init(M, NGU, F.G, (int)blockIdx.x);
        pg8::EpiSwiGLU E{H, sspB};
        pg8::gemm_phase<pg8::EpiSwiGLU, pg8::StaticOrder, PG8_ALIGN, PG8_SP2>(F.lds + RING_OFF, g, S, E, F.wave);
        if (F.G == 256 && blockIdx.x >= 128) weight_items(F, args, 3, ((int)blockIdx.x - 128) * NWAVES + F.wave, 128 * NWAVES);
        }
#if PROBE_REP & (1 << 7)
        GRID_BAR();
        {
        pg8::Gemm g{XB, (bf16*)(ws + WS_WGU2), M, NGU, D}; pg8::StaticOrder S; S.init(M, NGU, F.G, (int)blockIdx.x);
        pg8::EpiSwiGLU E{H, sspB};
        pg8::gemm_phase<pg8::EpiSwiGLU, pg8::StaticOrder, PG8_ALIGN, PG8_SP2>(F.lds + RING_OFF, g, S, E, F.wave);
        }
#endif
        if (BOTH(7)) GRID_BAR();
    }
    if (IN(8)) {
        {
        pg8::Gemm g{H, (bf16*)(ws + WS_WD2), M, D, DFF}; pg8::StaticOrder S; S.init(M, D, F.G, (int)blockIdx.x);
        pg8::EpiResid<true, true, false> E{nullptr, out, XB, nullptr, 0.5f};
        pg8::gemm_phase<pg8::EpiResid<true, true, false>, pg8::StaticOrder, PG8_ALIGN, PG8_SP2>(F.lds + RING_OFF, g, S, E, F.wave);
        }
#if PROBE_REP & (1 << 8)
        GRID_BAR();
        {
        pg8::Gemm g{H, (bf16*)(ws + WS_WD2), M, D, DFF}; pg8::StaticOrder S; S.init(M, D, F.G, (int)blockIdx.x);
        pg8::EpiResid<true, true, false> E{nullptr, out, XB, nullptr, 0.5f};
        pg8::gemm_phase<pg8::EpiResid<true, true, false>, pg8::StaticOrder, PG8_ALIGN, PG8_SP2>(F.lds + RING_OFF, g, S, E, F.wave);
        }
#endif
    }
#ifdef TS_SEL
    if (blockIdx.x == 0 && F.tid == 0) {
        const unsigned now = (unsigned)(rt() - ts0_);
        const unsigned v = (TS_SEL >= 50 && TS_SEL <= 52) ? F.MISC[TS_SEL + 30] : (TS_SEL == 41) ? (__hip_atomic_load((gu32*)(ws + WS_CTL) + 9216 + 128 + 64, RLX_AGENT) - (0x40000000u - __hip_atomic_load((gu32*)(ws + WS_CTL) + 9216 + 128, RLX_AGENT))) : (TS_SEL == 30) ? F.MISC[41] : (TS_SEL == 31) ? __hip_atomic_load((gu32*)(ws + WS_CTL) + 8192 + 128, RLX_AGENT) : (TS_SEL == 32) ? __hip_atomic_load((gu32*)(ws + WS_CTL) + 8192 + 192, RLX_AGENT) : (TS_SEL == 20) ? F.MISC[40] : (TS_SEL == 21) ? __hip_atomic_load((gu32*)(ws + WS_CTL) + 8192, RLX_AGENT) : (TS_SEL == 22) ? __hip_atomic_load((gu32*)(ws + WS_CTL) + 8192 + 64, RLX_AGENT) : (TS_SEL >= 8) ? now : F.MISC[16 + TS_SEL];
        asm volatile("s_waitcnt vmcnt(0)" ::: "memory");
        out[0] += (float)v * 0.01f * TS_SCALE;
    }
#endif
#undef IN
#undef BOTH
}

extern "C" void kernel_launch(void* const* d_in, const int* in_sizes, int n_in, void* d_out, int out_size, void* d_ws, size_t ws_size, hipStream_t stream) {
    static int grid = 0;
    if (grid == 0) {
        if (n_in != 16 || out_size != M * D || ws_size < WS_END) { fprintf(stderr, "kernel_launch: unexpected shapes (n_in %d out %d ws %zu)\n", n_in, out_size, ws_size); grid = -1; return; }
        int dev = 0, cus = 0, per_cu = 0;
        if (hipGetDevice(&dev) != hipSuccess || hipDeviceGetAttribute(&cus, hipDeviceAttributeMultiprocessorCount, dev) != hipSuccess) { grid = -1; return; }
        if (hipFuncSetAttribute((const void*)mk_fwd, hipFuncAttributeMaxDynamicSharedMemorySize, LDS_BYTES) != hipSuccess) { fprintf(stderr, "kernel_launch: hipFuncSetAttribute failed\n"); grid = -1; return; }
        if (hipOccupancyMaxActiveBlocksPerMultiprocessor(&per_cu, (const void*)mk_fwd, NWAVES * 64, LDS_BYTES) != hipSuccess || per_cu < 1) fprintf(stderr, "kernel_launch: occupancy query reports %d\n", per_cu);
        (void)hipGetLastError();
        grid = cus;
        if (cus != 256) { fprintf(stderr, "kernel_launch: this kernel is laid out for 256 CUs (MI355X); found %d; nothing launched\n", cus); grid = -1; return; }
    }
    if (grid < 0) return;
    (void)hipMemsetAsync((char*)d_ws + WS_CTL, 0, CTL_ZERO_BYTES, stream);
    Args a{};
    for (int i = 0; i < 16; ++i) a.in[i] = (const float*)d_in[i];
    a.out = (float*)d_out; a.ws = (unsigned char*)d_ws;
    a.ph_lo = 0; a.ph_hi = 9; a.li = 0;
    void* kargs[] = {(void*)&a};
    hipError_t le = hipLaunchCooperativeKernel((const void*)mk_fwd, dim3(grid), dim3(NWAVES * 64), kargs, LDS_BYTES, stream);
    if (le != hipSuccess) { fprintf(stderr, "kernel_launch: cooperative launch failed: %s (grid %d); falling back to a plain launch\n", hipGetErrorString(le), grid); (void)hipGetLastError();
        hipLaunchKernelGGL(mk_fwd, dim3(grid), dim3(NWAVES * 64), LDS_BYTES, stream, a); }
}
```

```cpp
#include <hip/hip_runtime.h>
#include <cstdio>
#include <cstdint>
#include <math.h>
namespace pg8 {
#define PG8_LAS __attribute__((address_space(3)))
typedef unsigned short bf16_t;
typedef short bf16x8 __attribute__((ext_vector_type(8)));
typedef float f32x4 __attribute__((ext_vector_type(4)));
typedef unsigned u32x4 __attribute__((ext_vector_type(4)));
constexpr int BM = 256, BK = 64, HALF = 128, HTB = HALF * BK * 2  , STAGE_BYTES = 8 * HTB, NXCD = 8, WGM = 8;

__host__ __device__ __forceinline__ int lds_byte(int r, int c) { const int st = (r >> 4) * 2 + (c >> 5), rr = r & 15, cc = c & 31, ob = rr * 64 + cc * 2; return st * 1024 + (ob ^ (((ob >> 9) & 1) << 5)); }
__host__ __device__ __forceinline__ void stage_rc(int b, int& R, int& C) { const int st = b / 1024, sb = b % 1024, swz = sb ^ (((sb >> 9) & 1) << 5); R = (st >> 1) * 16 + swz / 64; C = (st & 1) * 32 + (swz % 64) / 2; }
__host__ __device__ __forceinline__ int perm32(int rho) { const int n = rho >> 4, i = rho & 15; return 8 * (i >> 2) + 4 * n + (i & 3); }

struct Unit { int pm, pn; };
struct Gemm { const bf16_t* A; const bf16_t* Bt; int M, N, K; };

struct StaticOrder {
    int nM, nN, nwg, G, c;
    __host__ __device__ void init(int M, int N, int G_, int c_) { nM = M / BM; nN = N / BM; nwg = nM * nN; G = G_; c = c_; }
    __host__ __device__ bool next(int i, Unit& u) const {
        const long L = (long)i * G + c; if (L >= nwg) return false;
        int wgid = (int)L; { const int q = nwg / NXCD, r = nwg % NXCD, xcd = wgid % NXCD, off = wgid / NXCD; wgid = (xcd < r ? xcd * (q + 1) : r * (q + 1) + (xcd - r) * q) + off; }
        const int nig = WGM * nN, gid = wgid / nig, fm = gid * WGM, gsz = (nM - fm) < WGM ? (nM - fm) : WGM;
        u.pm = fm + ((wgid % nig) % gsz); u.pn = (wgid % nig) / gsz; return true;
    }
    __device__ __forceinline__ void a_ready(const Unit&) const {}
    __device__ __forceinline__ void done(const Unit&) const {}
};


__device__ __forceinline__ unsigned cvt_pk_bf16(float lo, float hi) { unsigned r; asm volatile("v_cvt_pk_bf16_f32 %0, %1, %2" : "=v"(r) : "v"(lo), "v"(hi)); return r; }
typedef float f32x2 __attribute__((ext_vector_type(2)));

typedef float f32x2 __attribute__((ext_vector_type(2)));
__device__ __forceinline__ float fq_sum(float s) {
    { auto r = __builtin_amdgcn_permlane16_swap(__float_as_uint(s), __float_as_uint(s), false, false); s = __uint_as_float(r[0]) + __uint_as_float(r[1]); }
    { auto r = __builtin_amdgcn_permlane32_swap(__float_as_uint(s), __float_as_uint(s), false, false); s = __uint_as_float(r[0]) + __uint_as_float(r[1]); }
    return s;
}
__device__ __forceinline__ float rrow(const float* ssp, int row, int fq) {
    const f32x4 p = *(const f32x4*)(ssp + (size_t)row * 16 + 4 * fq);
    float s = (p[0] + p[1]) + (p[2] + p[3]);
    s = fq_sum(s);
    return __builtin_amdgcn_rsqf(s * (1.0f / 1024.0f) + 1e-6f);
}
__device__ __forceinline__ float rrow_lds(const PG8_LAS unsigned char* pf, int lrow, int fq) {
    const f32x4 p = *(const PG8_LAS f32x4*)(pf + lrow * 64 + fq * 16);
    float s = (p[0] + p[1]) + (p[2] + p[3]);
    s = fq_sum(s);
    return __builtin_amdgcn_rsqf(s * (1.0f / 1024.0f) + 1e-6f);
}
__device__ __forceinline__ void ssp_prefetch(const float* ssp, int pm, PG8_LAS unsigned char* pf, int wid, int kp) {
    const char* sbase = (const char*)(ssp + (size_t)pm * (BM * 16)) + wid * 2048 + (kp & 7) * 256;
    const unsigned dst = (unsigned)(unsigned long)pf + (unsigned)wid * 2048u + (unsigned)(kp & 7) * 256u;
    unsigned keep, off;
    asm volatile("s_mov_b32 %0, m0\n\tv_mbcnt_lo_u32_b32 %1, -1, 0\n\tv_mbcnt_hi_u32_b32 %1, -1, %1\n\tv_lshlrev_b32_e32 %1, 2, %1\n\ts_mov_b32 m0, %2\n\ts_nop 4\n\t"
                 "global_load_lds_dword %1, %3\n\ts_mov_b32 m0, %0"
                 : "=&s"(keep), "=&v"(off) : "s"(dst), "s"(sbase) : "memory");
}
__device__ __forceinline__ f32x4 silu_mul(f32x4 g, f32x4 u) {
    f32x4 o;
#pragma unroll
    for (int e = 0; e < 4; ++e) { const float t = __builtin_amdgcn_exp2f(g[e] * -1.4426950408889634f); o[e] = g[e] * __builtin_amdgcn_rcpf(1.0f + t) * u[e]; }
    return o;
}
__device__ __forceinline__ u32x4 pack8(f32x4 a, f32x4 b) { u32x4 w; w.x = cvt_pk_bf16(a[0], a[1]); w.y = cvt_pk_bf16(a[2], a[3]); w.z = cvt_pk_bf16(b[0], b[1]); w.w = cvt_pk_bf16(b[2], b[3]); return w; }
__device__ __forceinline__ float dot4(f32x4 a) { return (a[0] * a[0] + a[1] * a[1]) + (a[2] * a[2] + a[3] * a[3]); }

struct EpiSwiGLU {
    static constexpr bool PERM = true, AFTER_DRAIN = false; static constexpr int NPF = 1;
    bf16_t* H; const float* ssp; PG8_LAS unsigned char* pf;
    __device__ __forceinline__ void prefetch(const Unit& u, int wid, int kp) const { ssp_prefetch(ssp, u.pm, pf, wid, kp); }
    __device__ __forceinline__ void operator()(const f32x4 (&acc)[2][2][4][2], const Unit& u, int wr, int wc, int fr, int fq) const {
        const int row0 = u.pm * BM + wr * 64 + fr, hc0 = u.pn * 128 + wc * 32 + 8 * fq;
        float rs[2][4];
#pragma unroll
        for (int ai = 0; ai < 2; ++ai)
#pragma unroll
            for (int m = 0; m < 4; ++m) rs[ai][m] = rrow_lds(pf, wr * 64 + fr + ai * HALF + m * 16, fq);
#pragma unroll
        for (int ai = 0; ai < 2; ++ai)
#pragma unroll
            for (int m = 0; m < 4; ++m) {
                const int row = row0 + ai * HALF + m * 16; const float r = rs[ai][m];
                const f32x4 h0 = silu_mul(acc[ai][0][m][0] * r, acc[ai][1][m][0] * r), h1 = silu_mul(acc[ai][0][m][1] * r, acc[ai][1][m][1] * r);
                *(u32x4*)(H + (size_t)row * 2816 + hc0) = pack8(h0, h1);
            }
    }
};
template <bool RB, bool OF, bool WB>
struct EpiResid {
    static constexpr bool PERM = true, AFTER_DRAIN = false; static constexpr int NPF = 0;
    const float* R; float* OUT; bf16_t* XB; float* ssp; float alpha;
    __device__ __forceinline__ void operator()(const f32x4 (&acc)[2][2][4][2], const Unit& u, int wr, int wc, int fr, int fq) const {
        const int row0 = u.pm * BM + wr * 64 + fr, c0 = u.pn * BM + wc * 32 + 8 * fq;
#pragma unroll
        for (int ai = 0; ai < 2; ++ai) {
            f32x4 rv[4][2][2];
#pragma unroll
            for (int m = 0; m < 4; ++m)
#pragma unroll
                for (int bj = 0; bj < 2; ++bj) {
                    const size_t off = (size_t)(row0 + ai * HALF + m * 16) * 1024 + c0 + bj * HALF;
                    if (RB) { const u32x4 w = *(const u32x4*)(XB + off);
                        rv[m][bj][0] = (f32x4){__uint_as_float(w.x << 16), __uint_as_float(w.x & 0xffff0000u), __uint_as_float(w.y << 16), __uint_as_float(w.y & 0xffff0000u)};
                        rv[m][bj][1] = (f32x4){__uint_as_float(w.z << 16), __uint_as_float(w.z & 0xffff0000u), __uint_as_float(w.w << 16), __uint_as_float(w.w & 0xffff0000u)}; }
                    else { rv[m][bj][0] = *(const f32x4*)(R + off); rv[m][bj][1] = *(const f32x4*)(R + off + 4); }
                }
            asm volatile("" ::: "memory");
#pragma unroll
            for (int m = 0; m < 4; ++m) {
                const int row = row0 + ai * HALF + m * 16; float ss = 0.f;
#pragma unroll
                for (int bj = 0; bj < 2; ++bj) {
                    const size_t off = (size_t)row * 1024 + c0 + bj * HALF;
                    const f32x4 o0 = rv[m][bj][0] + acc[ai][bj][m][0] * alpha, o1 = rv[m][bj][1] + acc[ai][bj][m][1] * alpha;
                    if (OF) { *(f32x4*)(OUT + off) = o0; *(f32x4*)(OUT + off + 4) = o1; }
                    if (WB) { *(u32x4*)(XB + off) = pack8(o0, o1); ss += dot4(o0) + dot4(o1); }
                }
                if (WB) { ss = fq_sum(ss); if (fq == 0) ssp[(size_t)row * 16 + u.pn * 4 + wc] = ss; }
            }
            asm volatile("" ::: "memory");
        }
    }
};
struct EpiInProj {
    static constexpr bool PERM = true, AFTER_DRAIN = false; static constexpr int NPF = 1;
    const float* ssp; bf16_t *Q, *K, *V, *U, *QI, *KI; float* WI; const float *qn, *kn, *cosH, *sinH, *cosI, *sinI; float qscale; PG8_LAS unsigned char* pf;
    __device__ __forceinline__ void prefetch(const Unit& u, int wid, int kp) const { ssp_prefetch(ssp, u.pm, pf, wid, kp); }
    __device__ __forceinline__ void operator()(const f32x4 (&acc)[2][2][4][2], const Unit& u, int wr, int wc, int fr, int fq) const {
        const int row0 = u.pm * BM + wr * 64 + fr, pn = u.pn;
#define PG8_SEP(t) __builtin_assume_separate_storage(t, Q); __builtin_assume_separate_storage(t, K); __builtin_assume_separate_storage(t, V); __builtin_assume_separate_storage(t, U); \
        __builtin_assume_separate_storage(t, QI); __builtin_assume_separate_storage(t, KI); __builtin_assume_separate_storage(t, WI);
        PG8_SEP(ssp) PG8_SEP(qn) PG8_SEP(kn) PG8_SEP(cosH) PG8_SEP(sinH) PG8_SEP(cosI) PG8_SEP(sinI)
#undef PG8_SEP
        float rs[2][4];
#pragma unroll
        for (int ai = 0; ai < 2; ++ai)
#pragma unroll
            for (int m = 0; m < 4; ++m) rs[ai][m] = rrow_lds(pf, wr * 64 + fr + ai * HALF + m * 16, fq);
#pragma unroll
        for (int ai = 0; ai < 2; ++ai)
#pragma unroll
            for (int m = 0; m < 4; ++m) {
                const int row = row0 + ai * HALF + m * 16, pos = row & 2047; const float r = rs[ai][m];
                const f32x4 a00 = acc[ai][0][m][0] * r, a01 = acc[ai][0][m][1] * r, a10 = acc[ai][1][m][0] * r, a11 = acc[ai][1][m][1] * r;
                if (pn < 4) {
                    float ss = (dot4(a00) + dot4(a01)) + (dot4(a10) + dot4(a11));
                    ss = fq_sum(ss);
                    const float rh = __builtin_amdgcn_rsqf(ss * (1.0f / 64.0f) + 1e-6f);
                    const float* gp = (pn < 2) ? qn : kn;
                    const f32x4 g00 = *(const f32x4*)(gp + 8 * fq), g01 = *(const f32x4*)(gp + 8 * fq + 4), g10 = *(const f32x4*)(gp + 32 + 8 * fq), g11 = *(const f32x4*)(gp + 36 + 8 * fq);
                    const f32x4 x1a = a00 * rh * g00, x1b = a01 * rh * g01, x2a = a10 * rh * g10, x2b = a11 * rh * g11;
                    const f32x4 ca = *(const f32x4*)(cosH + pos * 32 + 8 * fq), cb = *(const f32x4*)(cosH + pos * 32 + 8 * fq + 4);
                    const f32x4 sa = *(const f32x4*)(sinH + pos * 32 + 8 * fq), sb = *(const f32x4*)(sinH + pos * 32 + 8 * fq + 4);
                    const float sc = (pn < 2) ? qscale : 1.0f;
                    const f32x4 o1a = (x1a * ca - x2a * sa) * sc, o1b = (x1b * cb - x2b * sb) * sc, o2a = (x2a * ca + x1a * sa) * sc, o2b = (x2b * cb + x1b * sb) * sc;
                    if (pn < 2) { bf16_t* dst = Q + (size_t)row * 512 + ((pn & 1) * 4 + wc) * 64 + 8 * fq; *(u32x4*)dst = pack8(o1a, o1b); *(u32x4*)(dst + 32) = pack8(o2a, o2b); }
                    else {
                        bf16_t* dst = K + ((size_t)((row >> 11) * 8 + (pn & 1) * 4 + wc) * 32 + (pos >> 6)) * 4096 + (pos & 63) * 8 + fq * 512;
                        *(u32x4*)dst = pack8(o1a, o1b); *(u32x4*)(dst + 4 * 512) = pack8(o2a, o2b); }
                } else if (pn < 8) {
                    if (pn >= 6) { bf16_t* dst = U + (size_t)row * 512 + (pn & 1) * 256 + wc * 32 + 8 * fq; *(u32x4*)dst = pack8(a00, a01); *(u32x4*)(dst + 128) = pack8(a10, a11); }
                    else {
                        const int col = (pn & 1) * 256 + wc * 32, hd = col >> 6, ch = (col >> 5) & 1;
                        bf16_t* dst = V + ((size_t)((row >> 11) * 8 + hd) * 32 + (pos >> 6)) * 4096 + (ch * 4 + ((pos & 63) >> 4)) * 512 + ((pos & 15) * 4 + fq) * 8;
                        *(u32x4*)dst = pack8(a00, a01); *(u32x4*)(dst + (size_t)2 * 32 * 4096) = pack8(a10, a11); }
                } else if (pn == 8 || wc == 0) {
                    const int tq = (fq & 1) * 8;
                    f32x4 ca = *(const f32x4*)(cosI + pos * 16 + tq), cb = *(const f32x4*)(cosI + pos * 16 + tq + 4);
                    f32x4 sa = *(const f32x4*)(sinI + pos * 16 + tq), sb = *(const f32x4*)(sinI + pos * 16 + tq + 4);
                    if (fq >= 2) { ca = (f32x4){1.f, 1.f, 1.f, 1.f}; cb = ca; sa = (f32x4){0.f, 0.f, 0.f, 0.f}; sb = sa; }
                    const f32x4 o1a = a00 * ca - a10 * sa, o1b = a01 * cb - a11 * sb, o2a = a10 * ca + a00 * sa, o2b = a11 * cb + a01 * sb;
                    const int d1 = 8 * fq + ((fq >= 2) ? 16 : 0);
                    if (pn == 8) { bf16_t* dst = QI + (size_t)row * 256 + wc * 64 + d1; *(u32x4*)dst = pack8(o1a, o1b); *(u32x4*)(dst + 16) = pack8(o2a, o2b); }
                    else {
                        const int d2 = d1 + 16; bf16_t* tb = KI + (size_t)(row >> 4) * 1024 + (row & 15) * 8;
                        *(u32x4*)(tb + ((d1 >> 5) * 4 + ((d1 & 31) >> 3)) * 128) = pack8(o1a, o1b); *(u32x4*)(tb + ((d2 >> 5) * 4 + ((d2 & 31) >> 3)) * 128) = pack8(o2a, o2b); }
                } else if (wc == 1) {
                    if (fq == 0) *(f32x4*)(WI + (size_t)row * 4) = a00 * 0.0625f;
                }
            }
    }
};
template <class Epi, class Sched, bool ALIGN_EPI = false, bool SP2 = false>
__device__ __forceinline__ void gemm_phase(PG8_LAS unsigned char* lds, const Gemm g, const Sched& S, const Epi& E, const int wave_id) {
    int lane_ = (int)__builtin_amdgcn_mbcnt_hi(~0u, __builtin_amdgcn_mbcnt_lo(~0u, 0u)); asm volatile("" : "+v"(lane_));
    const int wid = wave_id, lane = lane_, tid = wid * 64 + lane,     wr = wid >> 2, wc = wid & 3, fr = lane & 15, fq = lane >> 4;
    const int K = g.K, nt = K / BK;
    unsigned voffA[2], voffB[2];
#pragma unroll
    for (int i = 0; i < 2; ++i) { int R, C; stage_rc(tid * 16 + i * 8192, R, C); const int Rb = Epi::PERM ? ((R & ~31) + perm32(R & 31)) : R;
        voffA[i] = (unsigned)(R * K + C) * 2u; voffB[i] = (unsigned)(Rb * K + C) * 2u; }
    const size_t kstep = (size_t)(BK * 2);
    const size_t hstep = (size_t)HALF * K * 2;
    const size_t tstep = 2 * hstep;
    const unsigned ldsw = (unsigned)wid * 1024u;
    const int aoff = lds_byte(wr * 64 + fr, fq * 8), boff = lds_byte(wc * 32 + fr, fq * 8);
#define PG8_SA(b, h) (((b) * 2 + (h)) * HTB)
#define PG8_SB(b, h) ((4 + (b) * 2 + (h)) * HTB)
#define PG8_STAGE(bufoff, gbase, voff) do { _Pragma("unroll") for (int _i = 0; _i < 2; ++_i) \
        __builtin_amdgcn_global_load_lds((const unsigned*)((const char*)(gbase) + (voff)[_i]), (PG8_LAS unsigned*)(lds + (bufoff) + ldsw + _i * 8192), 16, 0, 0); } while (0)
#define PG8_LDA(dst, b, h) do { _Pragma("unroll") for (int m = 0; m < 4; ++m) _Pragma("unroll") for (int k = 0; k < 2; ++k) dst[m][k] = *(const PG8_LAS bf16x8*)(lds + PG8_SA(b, h) + aoff + m * 2048 + k * 1024); } while (0)
#define PG8_LDB(dst, b, h) do { _Pragma("unroll") for (int n = 0; n < 2; ++n) _Pragma("unroll") for (int k = 0; k < 2; ++k) dst[n][k] = *(const PG8_LAS bf16x8*)(lds + PG8_SB(b, h) + boff + n * 2048 + k * 1024); } while (0)
#define PG8_MMA(ai, bj, At, Bt) do { __builtin_amdgcn_s_setprio(1); _Pragma("unroll") for (int m = 0; m < 4; ++m) _Pragma("unroll") for (int n = 0; n < 2; ++n) _Pragma("unroll") for (int k = 0; k < 2; ++k) \
        acc[ai][bj][m][n] = __builtin_amdgcn_mfma_f32_16x16x32_bf16(Bt[n][k], At[m][k], acc[ai][bj][m][n], 0, 0, 0); __builtin_amdgcn_s_setprio(0); } while (0)
#define PG8_WAIT_V(n) asm volatile("s_waitcnt vmcnt(" #n ")" ::: "memory")
#define PG8_WAIT_L(n) asm volatile("s_waitcnt lgkmcnt(" #n ")" ::: "memory")
#define PG8_BAR __builtin_amdgcn_s_barrier()
#define PG8_SCHED __builtin_amdgcn_sched_barrier(0)
    Unit cur, nxt; int ui = 0;
    if (!S.next(0, cur)) return;
    f32x4 acc[2][2][4][2];
#pragma unroll
    for (int a = 0; a < 2; ++a)
#pragma unroll
        for (int b = 0; b < 2; ++b)
#pragma unroll
            for (int m = 0; m < 4; ++m)
#pragma unroll
                for (int n = 0; n < 2; ++n) acc[a][b][m][n] = (f32x4){0.f, 0.f, 0.f, 0.f};
    bf16x8 At[4][2], B0[2][2], B1[2][2];
    const char* cA = (const char*)g.A + (size_t)cur.pm * tstep; const char* cB = (const char*)g.Bt + (size_t)cur.pn * tstep;
    S.a_ready(cur);
    if constexpr (SP2) {
        PG8_STAGE(PG8_SB(0, 0), cB, voffB); PG8_STAGE(PG8_SB(0, 1), cB + hstep, voffB); PG8_STAGE(PG8_SA(0, 0), cA, voffA); PG8_STAGE(PG8_SA(0, 1), cA + hstep, voffA);
        if (wr == 1) PG8_BAR;
        PG8_WAIT_V(2); PG8_BAR;
        PG8_STAGE(PG8_SB(1, 0), cB + kstep, voffB); PG8_STAGE(PG8_SA(1, 0), cA + kstep, voffA); PG8_STAGE(PG8_SB(1, 1), cB + hstep + kstep, voffB);
        PG8_WAIT_V(6); PG8_BAR;
    } else {
        PG8_STAGE(PG8_SB(0, 0), cB, voffB); PG8_STAGE(PG8_SA(0, 0), cA, voffA); PG8_STAGE(PG8_SB(0, 1), cB + hstep, voffB); PG8_STAGE(PG8_SA(0, 1), cA + hstep, voffA);
        if (wr == 1) PG8_BAR;
        PG8_WAIT_V(4); PG8_BAR;
        PG8_STAGE(PG8_SB(1, 0), cB + kstep, voffB); PG8_STAGE(PG8_SA(1, 0), cA + kstep, voffA); PG8_STAGE(PG8_SB(1, 1), cB + hstep + kstep, voffB);
        PG8_WAIT_V(6); PG8_BAR;
    }
    for (;;) {
        const bool has_next = S.next(ui + 1, nxt);
        const char* nA = has_next ? (const char*)g.A + (size_t)nxt.pm * tstep : cA; const char* nB = has_next ? (const char*)g.Bt + (size_t)nxt.pn * tstep : cB;
        for (int t = 0; t < nt; t += 2) {
            const bool last = (t == nt - 2);
            const char* a1 = cA + (size_t)(t + 1) * kstep;
            const char* a2 = last ? nA : cA + (size_t)(t + 2) * kstep; const char* b2 = last ? nB : cB + (size_t)(t + 2) * kstep;
            const char* a3 = a2 + kstep; const char* b3 = b2 + kstep;
            if (last && has_next) S.a_ready(nxt);
            if constexpr (SP2) {
            PG8_LDB(B0, 0, 0); PG8_LDB(B1, 0, 1); PG8_SCHED; PG8_LDA(At, 0, 0); PG8_STAGE(PG8_SA(1, 1), a1 + hstep, voffA);
            PG8_WAIT_V(8); PG8_WAIT_L(0); PG8_BAR; PG8_MMA(0, 0, At, B0); PG8_MMA(0, 1, At, B1); PG8_BAR; PG8_SCHED;
            PG8_LDA(At, 0, 1);
            if constexpr (Epi::NPF > 0) { static_assert(Epi::NPF == 1, "wait counts below"); E.prefetch(cur, wid, t >> 1); }
            PG8_STAGE(PG8_SB(0, 0), b2, voffB); PG8_STAGE(PG8_SB(0, 1), b2 + hstep, voffB); PG8_STAGE(PG8_SA(0, 0), a2, voffA);
            if constexpr (Epi::NPF > 0) PG8_WAIT_V(9); else PG8_WAIT_V(8);
            PG8_WAIT_L(0); PG8_BAR; PG8_MMA(1, 0, At, B0); PG8_MMA(1, 1, At, B1); PG8_BAR; PG8_SCHED;
            PG8_LDB(B0, 1, 0); PG8_LDB(B1, 1, 1); PG8_SCHED; PG8_LDA(At, 1, 0); PG8_STAGE(PG8_SA(0, 1), a2 + hstep, voffA);
            if constexpr (Epi::NPF > 0) PG8_WAIT_V(9); else PG8_WAIT_V(8);
            PG8_WAIT_L(0); PG8_BAR; PG8_MMA(0, 0, At, B0); PG8_MMA(0, 1, At, B1); PG8_BAR; PG8_SCHED;
            PG8_LDA(At, 1, 1); PG8_STAGE(PG8_SB(1, 0), b3, voffB); PG8_STAGE(PG8_SB(1, 1), b3 + hstep, voffB); PG8_STAGE(PG8_SA(1, 0), a3, voffA);
            PG8_WAIT_V(8); PG8_WAIT_L(0); PG8_BAR; PG8_MMA(1, 0, At, B0); PG8_MMA(1, 1, At, B1); PG8_BAR; PG8_SCHED;
            } else {
            PG8_LDB(B0, 0, 0); PG8_SCHED; PG8_LDA(At, 0, 0); PG8_STAGE(PG8_SA(1, 1), a1 + hstep, voffA);
            PG8_WAIT_L(8); PG8_BAR; PG8_WAIT_L(0); PG8_MMA(0, 0, At, B0); PG8_BAR; PG8_SCHED;
            PG8_LDB(B1, 0, 1); PG8_STAGE(PG8_SB(0, 0), b2, voffB);
            PG8_BAR; PG8_WAIT_L(0); PG8_MMA(0, 1, At, B1); PG8_BAR;
            PG8_LDA(At, 0, 1); PG8_STAGE(PG8_SA(0, 0), a2, voffA);
            PG8_BAR; PG8_WAIT_L(0); PG8_MMA(1, 0, At, B0); PG8_BAR; PG8_SCHED;
            PG8_STAGE(PG8_SB(0, 1), b2 + hstep, voffB);
            PG8_WAIT_V(6); PG8_BAR; PG8_MMA(1, 1, At, B1); PG8_BAR;
            PG8_LDB(B0, 1, 0); PG8_SCHED; PG8_LDA(At, 1, 0); PG8_STAGE(PG8_SA(0, 1), a2 + hstep, voffA);
            PG8_WAIT_L(8); PG8_BAR; PG8_WAIT_L(0); PG8_MMA(0, 0, At, B0); PG8_BAR; PG8_SCHED;
            PG8_LDB(B1, 1, 1); PG8_STAGE(PG8_SB(1, 0), b3, voffB);
            PG8_BAR; PG8_WAIT_L(0); PG8_MMA(0, 1, At, B1); PG8_BAR;
            PG8_LDA(At, 1, 1); PG8_STAGE(PG8_SA(1, 0), a3, voffA);
            PG8_BAR; PG8_WAIT_L(0); PG8_MMA(1, 0, At, B0); PG8_BAR; PG8_SCHED;
            PG8_STAGE(PG8_SB(1, 1), b3 + hstep, voffB);
            PG8_WAIT_V(6); PG8_BAR; PG8_MMA(1, 1, At, B1); PG8_BAR;
            }
        }
        if constexpr (ALIGN_EPI) { if (wr == 0) PG8_BAR; }
        if constexpr (!Epi::AFTER_DRAIN) { int fr_ = fr, fq_ = fq; asm volatile("" : "+v"(fr_), "+v"(fq_));
            E(acc, cur, wr, wc, fr_, fq_); S.done(cur); }
        if (!has_next) break;
#pragma unroll
        for (int a = 0; a < 2; ++a)
#pragma unroll
            for (int b = 0; b < 2; ++b)
#pragma unroll
                for (int m = 0; m < 4; ++m)
#pragma unroll
                    for (int n = 0; n < 2; ++n) acc[a][b][m][n] = (f32x4){0.f, 0.f, 0.f, 0.f};
        cur = nxt; cA = nA; cB = nB; ++ui;
        if constexpr (ALIGN_EPI) { if (wr == 1) PG8_BAR; }
    }
    PG8_WAIT_V(0);
    if constexpr (!ALIGN_EPI) { if (wr == 0) PG8_BAR; }
    PG8_BAR;
    if constexpr (Epi::AFTER_DRAIN) { E.fused(acc, cur, wr, wc, fr, fq, lds, wid, lane); S.done(cur); }
#undef PG8_SA
#undef PG8_SB
#undef PG8_STAGE
#undef PG8_LDA
#undef PG8_LDB
#undef PG8_MMA
#undef PG8_WAIT_V
#undef PG8_WAIT_L
#undef PG8_BAR
#undef PG8_SCHED
}
}


#ifndef PG8_SP2
#define PG8_SP2 true
#endif
#ifndef PG8_ALIGN
#define PG8_ALIGN true
#endif

#ifndef PROBE_REP
#define PROBE_REP 0
#endif
#define TS_SCALE 0.01f
constexpr int NWAVES = 8;
constexpr int BATCH = 8, SEQ = 2048, D = 1024, M = BATCH * SEQ, DFF = 2816, NGU = 2 * DFF, NIN = 2560, INC = 2372;
constexpr size_t MiB = 1u << 20;
constexpr size_t WS_CTL = 0, CTL_ZERO_BYTES = 64 * 1024;
constexpr size_t WS_SSPA = 2 * MiB, WS_SSPB = 3 * MiB;
constexpr size_t WS_TAB = 4 * MiB;
constexpr size_t WS_WI = 5 * MiB;
constexpr size_t WS_MASK = 6 * MiB;
constexpr size_t WS_WGU1 = 10 * MiB, WS_WD1 = 21 * MiB, WS_WIN = 27 * MiB, WS_WOUT = 32 * MiB, WS_WGU2 = 34 * MiB, WS_WD2 = 45 * MiB;
constexpr size_t WS_XB = 52 * MiB;
constexpr size_t WS_MIX = 84 * MiB;
constexpr size_t WS_H = 116 * MiB;
constexpr size_t WS_Q = 116 * MiB, WS_K = 132 * MiB, WS_V = 148 * MiB, WS_U = 164 * MiB, WS_QI = 180 * MiB, WS_KI = 188 * MiB;
constexpr size_t WS_END = 204 * MiB;
constexpr int CW_BAR = 4096;
constexpr int RING_OFF = 0, RING_BYTES = 131072;
constexpr int LDS_BYTES = 163840;
constexpr int LDSCTL_OFF = LDS_BYTES - 1024, MISC_OFF = LDSCTL_OFF + 320;
constexpr float C2 = 0.125f * 1.4426950408889634f;

#define GAS __attribute__((address_space(1)))
#define LAS __attribute__((address_space(3)))
typedef unsigned short bf16;
typedef unsigned v4u __attribute__((ext_vector_type(4)));
typedef float f32x4 __attribute__((ext_vector_type(4)));
typedef short bf16x8 __attribute__((ext_vector_type(8)));
typedef GAS unsigned gu32;
typedef GAS unsigned long long gu64;
#define RLX_AGENT __ATOMIC_RELAXED, __HIP_MEMORY_SCOPE_AGENT
#define LDS_WAIT() asm volatile("s_waitcnt lgkmcnt(0)" ::: "memory")
#define VM_WAIT() asm volatile("s_waitcnt vmcnt(0)" ::: "memory")
__device__ __forceinline__ unsigned long long rt() { return __builtin_amdgcn_s_memrealtime(); }
__device__ __forceinline__ unsigned f2bf(float f) { unsigned u = __builtin_bit_cast(unsigned, f); return (u + 0x7fffu + ((u >> 16) & 1u)) >> 16; }
__device__ __forceinline__ unsigned pk2(float lo, float hi) { return f2bf(lo) | (f2bf(hi) << 16); }

#define XB_TMO      128
#define XB_XCNT(j)  (256  + 64 * (j))
#define XB_XSUB(j)  (1280 + 64 * (j))
#define XB_XGEN(j)  (2304 + 64 * (j))
#define XB_TOP      3328
#define XB_TOPGEN   3392
#define XCD_BAR_WORDS 3456
#define XB_SPIN_CAP (1u << 18)

__device__ __forceinline__ unsigned xb_ld(unsigned* p)              { return __hip_atomic_load(p, __ATOMIC_RELAXED, __HIP_MEMORY_SCOPE_AGENT); }
__device__ __forceinline__ unsigned xb_add(unsigned* p, unsigned v) { return __hip_atomic_fetch_add(p, v, __ATOMIC_RELAXED, __HIP_MEMORY_SCOPE_AGENT); }
__device__ __forceinline__ unsigned xb_xcc_id() { return (unsigned)__builtin_amdgcn_s_getreg((3 << 11) | 20) & 0xFu; }
#define XB_SPIN(cond, bar) do { unsigned _sp = 0; while (cond) { __builtin_amdgcn_s_sleep(1); \
    if ((++_sp & 255u) == 0u) { if (xb_ld(&(bar)[XB_TMO])) break; if (_sp > XB_SPIN_CAP) { atomicAdd(&(bar)[XB_TMO], 1u); break; } } } } while (0)

struct XcdBarrier {
    unsigned* bar; unsigned x; int leader;
    volatile LAS unsigned* st;
};

__device__ __forceinline__ bool xb_is_thread0(int leader) { return leader && __builtin_amdgcn_mbcnt_hi(~0u, __builtin_amdgcn_mbcnt_lo(~0u, 0u)) == 0u; }
__device__ __forceinline__ XcdBarrier xcd_barrier_post(unsigned* bar, volatile LAS unsigned* st, int wave_id) {
    XcdBarrier b; b.bar = bar; b.x = xb_xcc_id(); b.st = st; b.leader = (wave_id == 0) ? 1 : 0;
    if (xb_is_thread0(b.leader)) (void)xb_add(&bar[XB_XCNT(b.x)], 1u);
    return b;
}
__device__ __forceinline__ void xcd_barrier_complete(unsigned* bar, unsigned x, unsigned& nloc, unsigned& nx) {
    const unsigned G = gridDim.x * gridDim.y * gridDim.z;
    unsigned sum, cnt, mine, sp = 0u;
    for (;;) {
        sum = 0u; cnt = 0u; mine = 0u;
#pragma unroll
        for (unsigned j = 0; j < 16; ++j) { const unsigned c = xb_ld(&bar[XB_XCNT(j)]); sum += c; cnt += (c > 0u) ? 1u : 0u; mine = (j == x) ? c : mine; }
        if (sum == G) break;
        __builtin_amdgcn_s_sleep(1);
        if ((++sp & 255u) == 0u) { if (xb_ld(&bar[XB_TMO])) break; if (sp > XB_SPIN_CAP) { atomicAdd(&bar[XB_TMO], 1u); break; } }
    }
    nloc = mine > 0u ? mine : 1u; nx = cnt > 0u ? cnt : 1u;
}

__device__ __forceinline__ void xcd_barrier(const XcdBarrier& b) {
    asm volatile("s_waitcnt vmcnt(0)" ::: "memory");
    __syncthreads();
    if (xb_is_thread0(b.leader)) {
        unsigned* bar = b.bar;
        __builtin_amdgcn_s_waitcnt(0);
        unsigned nloc = b.st[0], nx = b.st[1];
        if (nloc == 0u) { xcd_barrier_complete(bar, b.x, nloc, nx); b.st[0] = nloc; b.st[1] = nx; }
        const unsigned old = xb_add(&bar[XB_XSUB(b.x)], 1u);
        const unsigned gen = old / nloc;
        if (old + 1u == (gen + 1u) * nloc) {
            __builtin_amdgcn_fence(__ATOMIC_RELEASE, "agent");
            asm volatile("s_waitcnt vmcnt(0)" ::: "memory");
            const unsigned og = xb_add(&bar[XB_TOP], 1u);
            const unsigned tg = og / nx;
            if (og + 1u == (tg + 1u) * nx) xb_add(&bar[XB_TOPGEN], 1u);
            else XB_SPIN(xb_ld(&bar[XB_TOPGEN]) == tg, bar);
            __builtin_amdgcn_fence(__ATOMIC_ACQUIRE, "agent");
            xb_add(&bar[XB_XGEN(b.x)], 1u);
            asm volatile("s_waitcnt vmcnt(0)" ::: "memory");
        } else {
            XB_SPIN(xb_ld(&bar[XB_XGEN(b.x)]) == gen, bar);
            __builtin_amdgcn_fence(__ATOMIC_ACQUIRE, "agent");
            asm volatile("s_waitcnt vmcnt(0)" ::: "memory");
        }
    }
    __syncthreads();
}


struct Frame {
    LAS unsigned char* lds;
    volatile LAS unsigned* MISC;
    gu32* ctl;
    int tid, lane, wave;
    int vcu, G;
};
__device__ __forceinline__ float wave_sum(float v) {
#pragma unroll
    for (int o = 1; o < 64; o <<= 1) v += __shfl_xor(v, o);
    return v;
}
template <class Map>
__device__ __forceinline__ void transpose_item(const float* W, int K, int N, const float* gk, bf16* WT, int ldk, Map map, LAS float* scr, int item, int lane) {
    const int nblk = (N + 31) / 32, kb = item / nblk, nb = item % nblk, k0 = 64 * kb, n0 = 32 * nb;
    (void)K;
    float tv[32];
    { const int n = n0 + (lane & 31); const bool ok = n < N; const float* wp = W + (size_t)(k0 + (lane >> 5)) * N + (ok ? n : 0);
#pragma unroll
      for (int i = 0; i < 32; ++i) tv[i] = wp[(size_t)(2 * i) * N];
      if (gk) {
#pragma unroll
          for (int i = 0; i < 32; ++i) tv[i] *= gk[k0 + 2 * i + (lane >> 5)];
      }
#pragma unroll
      for (int i = 0; i < 32; ++i) scr[(2 * i + (lane >> 5)) * 33 + (lane & 31)] = ok ? tv[i] : 0.f; }
    LDS_WAIT(); asm volatile("" ::: "memory");
    const int c = lane & 7;
#pragma unroll
    for (int j = 0; j < 4; ++j) { const int nn = (lane >> 3) + 8 * j, n = n0 + nn; const LAS float* s = scr + (8 * c) * 33 + nn;
        if (n < N) { const int dst = map(n);
            v4u o; o.x = pk2(s[0 * 33], s[1 * 33]); o.y = pk2(s[2 * 33], s[3 * 33]); o.z = pk2(s[4 * 33], s[5 * 33]); o.w = pk2(s[6 * 33], s[7 * 33]);
            *(GAS v4u*)(WT + (size_t)dst * ldk + k0 + 8 * c) = o; } }
    LDS_WAIT(); asm volatile("" ::: "memory");
}
struct MapPlain { __device__ __forceinline__ int operator()(int n) const { return n; } };
struct MapGate { int add; __device__ __forceinline__ int operator()(int n) const { return 256 * (n >> 7) + (n & 127) + add; } };
__device__ __forceinline__ int idx_slot(int d) { return (d < 16) ? d : (d < 32) ? 128 + (d - 16) : (d < 48) ? 16 + (d - 32) : 128 + 16 + (d - 48); }
struct MapIn {
    __device__ __forceinline__ int operator()(int n) const {
        if (n < 1024) { const int kq = n >> 9, nn = n & 511, head = nn >> 6, d = nn & 63; return kq * 512 + 256 * (head >> 2) + 128 * (d >> 5) + 32 * (head & 3) + (d & 31); }
        if (n < 1536) return n;
        if (n < 1792) { const int nn = n - 1536, h = nn >> 6, d = nn & 63; return 2048 + 32 * h + idx_slot(d); }
        if (n < 1856) return 2304 + idx_slot(n - 1792);
        if (n < 1860) return 2304 + 32 + (n - 1856);
        return 1536 + (n - 1860);
    }
};

struct Args { const float* in[16]; float* out; unsigned char* ws; int ph_lo, ph_hi, li, pad; };

__device__ __forceinline__ void weight_items(Frame& F, const Args& a, int set, int gw, int NGW) {
    unsigned char* ws = a.ws;
    LAS float* scr = (LAS float*)(F.lds + RING_OFF + F.wave * 16384);
    const int lane = F.lane;
    const float *f1n = a.in[1], *f1g = a.in[2], *f1u = a.in[3], *f1d = a.in[4], *mixn = a.in[5], *win = a.in[6], *poolw = a.in[9], *pools = a.in[10], *wout = a.in[11],
                *f2n = a.in[12], *f2g = a.in[13], *f2u = a.in[14], *f2d = a.in[15];
    bf16* WGU1 = (bf16*)(ws + WS_WGU1); bf16* WD1 = (bf16*)(ws + WS_WD1); bf16* WIN = (bf16*)(ws + WS_WIN); bf16* WOUT = (bf16*)(ws + WS_WOUT); bf16* WGU2 = (bf16*)(ws + WS_WGU2); bf16* WD2 = (bf16*)(ws + WS_WD2);
    constexpr int I_G = (D / 64) * (DFF / 32), I_D = (DFF / 64) * (D / 32), I_IN = (D / 64) * ((INC + 31) / 32), I_O = (512 / 64) * (D / 32);
    if (set == 0) {
        for (int it = gw; it < 2 * I_G; it += NGW) {
            if (it < I_G) transpose_item(f1g, D, DFF, f1n, WGU1, D, MapGate{0}, scr, it, lane);
            else transpose_item(f1u, D, DFF, f1n, WGU1, D, MapGate{128}, scr, it - I_G, lane);
        }
    } else if (set == 2) {
        for (int it = gw; it < 2 * I_G; it += NGW) {
            if (it < I_G) transpose_item(f2g, D, DFF, f2n, WGU2, D, MapGate{0}, scr, it, lane);
            else transpose_item(f2u, D, DFF, f2n, WGU2, D, MapGate{128}, scr, it - I_G, lane);
        }
    } else if (set == 3) {
        for (int it = gw; it < I_D; it += NGW) transpose_item(f2d, DFF, D, nullptr, WD2, DFF, MapPlain{}, scr, it, lane);
    } else {
        for (int it = gw; it < I_D + I_IN + I_O; it += NGW) {
            int r = it;
            if (r < I_D) { transpose_item(f1d, DFF, D, nullptr, WD1, DFF, MapPlain{}, scr, r, lane); continue; } r -= I_D;
            if (r < I_IN) { transpose_item(win, D, INC, mixn, WIN, D, MapIn{}, scr, r, lane); continue; } r -= I_IN;
            transpose_item(wout, 512, D, nullptr, WOUT, D, MapPlain{}, scr, r, lane);
        }
    }
    if (set == 1) {
        for (int j = gw; j < 256; j += NGW) {
            const int bj = j >> 7, wc = (j >> 5) & 3, i = j & 31;
            const bool covered = (wc == 0) || (wc == 1 && bj == 0 && i < 4);
            if (!covered) { GAS v4u* o = (GAS v4u*)(WIN + (size_t)(2304 + j) * D) + lane; o[0] = (v4u){0u, 0u, 0u, 0u}; o[64] = (v4u){0u, 0u, 0u, 0u}; }
        }
    }
}
__device__ __forceinline__ void wpo_items(Frame& F, const Args& a, int gw, int NGW, int it_lo, int it_hi) {
    unsigned char* ws = a.ws; bf16* WOUT = (bf16*)(ws + WS_WOUT);
    LAS float* scr = (LAS float*)(F.lds + RING_OFF + F.wave * 16384);
    const int lane = F.lane; const float *poolw = a.in[9], *pools = a.in[10], *wout = a.in[11];
#pragma unroll 1
    for (int it = it_lo + gw; it < it_hi; it += NGW) {
        const int g = it >> 9, nb = (it >> 5) & 15, cb = it & 31, n = nb * 64 + lane;
        float ac[4] = {0.f, 0.f, 0.f, 0.f};
        const float* pw = poolw + ((size_t)g * 128 + cb * 4) * 128;
        const float* wsrc = wout + (size_t)(512 + g * 128) * D + nb * 64; const float* psrc = pools + g * 128;
#pragma unroll 1
        for (int half = 0; half < 2; ++half) {
#pragma unroll
            for (int dd = 0; dd < 64; ++dd)
                __builtin_amdgcn_global_load_lds((const unsigned*)(wsrc + (size_t)(half * 64 + dd) * D) + lane, (LAS unsigned*)(scr + dd * 64), 4, 0, 0);
            asm volatile("s_waitcnt vmcnt(0)" ::: "memory");
#pragma unroll 8
            for (int dd = 0; dd < 64; ++dd) { const float w = scr[dd * 64 + lane] * psrc[half * 64 + dd];
#pragma unroll
                for (int cc = 0; cc < 4; ++cc) ac[cc] = fmaf(pw[cc * 128 + half * 64 + dd], w, ac[cc]); }
            LDS_WAIT(); asm volatile("" ::: "memory");
        }
        *(GAS unsigned long long*)(WOUT + (size_t)n * D + 512 + g * 128 + cb * 4) = (unsigned long long)pk2(ac[0], ac[1]) | ((unsigned long long)pk2(ac[2], ac[3]) << 32);
    }
}
__device__ __forceinline__ void p0_prologue(Frame& F, const Args& a) {
    unsigned char* ws = a.ws;
    const int gw = F.vcu * NWAVES + F.wave, NGW = F.G * NWAVES, lane = F.lane;
    const float* x = a.in[0];
    weight_items(F, a, 0, gw, NGW);
    if (F.G != 256) wpo_items(F, a, gw, NGW, 0, 2048);
    if (F.G != 256) { weight_items(F, a, 1, gw, NGW); weight_items(F, a, 2, gw, NGW); weight_items(F, a, 3, gw, NGW); }
    float* cosH = (float*)(ws + WS_TAB); float* sinH = cosH + SEQ * 32; float* cosI = sinH + SEQ * 32; float* sinI = cosI + SEQ * 16;
    for (int idx = gw * 64 + lane; idx < SEQ * 48; idx += NGW * 64) {
        if (idx < SEQ * 32) { const int p = idx >> 5, i = idx & 31; const float inv = (float)pow(10000.0, -(double)i / 32.0); const float ang = __fmul_rn((float)p, inv); cosH[idx] = (float)cos((double)ang); sinH[idx] = (float)sin((double)ang); }
        else { const int j = idx - SEQ * 32, p = j >> 4, i = j & 15; const float inv = (float)pow(10000.0, -(double)i / 16.0); const float ang = __fmul_rn((float)p, inv); cosI[j] = (float)cos((double)ang); sinI[j] = (float)sin((double)ang); }
    }
    bf16* XB = (bf16*)(ws + WS_XB); float* sspA = (float*)(ws + WS_SSPA);
    for (int m0 = gw; m0 < M; m0 += 4 * NGW) {
        f32x4 v[4][4]; float s[4];
#pragma unroll
        for (int q = 0; q < 4; ++q) { const GAS f32x4* xr = (const GAS f32x4*)(x + (size_t)(m0 + q * NGW) * D) + lane;
#pragma unroll
            for (int j = 0; j < 4; ++j) v[q][j] = xr[64 * j]; }
#pragma unroll
        for (int q = 0; q < 4; ++q) { float a = 0.f;
#pragma unroll
            for (int j = 0; j < 4; ++j) a += (v[q][j].x * v[q][j].x + v[q][j].y * v[q][j].y) + (v[q][j].z * v[q][j].z + v[q][j].w * v[q][j].w);
            s[q] = wave_sum(a); }
#pragma unroll
        for (int q = 0; q < 4; ++q) { const int m = m0 + q * NGW;
            GAS unsigned long long* o8 = (GAS unsigned long long*)(XB + (size_t)m * D) + lane;
#pragma unroll
            for (int j = 0; j < 4; ++j) o8[64 * j] = (unsigned long long)pk2(v[q][j].x, v[q][j].y) | ((unsigned long long)pk2(v[q][j].z, v[q][j].w) << 32);
            if (lane < 16) sspA[(size_t)m * 16 + lane] = (lane == 0) ? s[q] : 0.f; }
    }
}

#ifndef SEL_REP
#define SEL_REP 1
#endif
#ifndef SEL_ABL
#define SEL_ABL 1
#endif
#ifndef POOL_REP
#define POOL_REP 1
#endif
__device__ __forceinline__ int wave_sum_dpp(int v) {
    v += __builtin_amdgcn_update_dpp(0, v, 0x111, 0xf, 0xf, false);
    v += __builtin_amdgcn_update_dpp(0, v, 0x112, 0xf, 0xf, false);
    v += __builtin_amdgcn_update_dpp(0, v, 0x114, 0xf, 0xf, false);
    v += __builtin_amdgcn_update_dpp(0, v, 0x118, 0xf, 0xf, false);
    v += __builtin_amdgcn_update_dpp(0, v, 0x142, 0xa, 0xf, false);
    v += __builtin_amdgcn_update_dpp(0, v, 0x143, 0xc, 0xf, false);
    return __builtin_amdgcn_readlane(v, 63);
}
__device__ __forceinline__ void cnt4(int& na, int& nb, unsigned ka0, unsigned kb0, unsigned ka1, unsigned kb1, unsigned ca, unsigned cb) {
    unsigned long long s0, s1, s2;
    asm volatile("v_cmp_le_u32_e32 vcc, %9, %5\n\t"
                 "v_cmp_le_u32_e64 %2, %10, %6\n\t"
                 "v_cmp_le_u32_e64 %3, %9, %7\n\t"
                 "v_cmp_le_u32_e64 %4, %10, %8\n\t"
                 "v_addc_co_u32_e32 %0, vcc, 0, %0, vcc\n\t"
                 "v_addc_co_u32_e64 %1, %2, 0, %1, %2\n\t"
                 "v_addc_co_u32_e64 %0, %3, 0, %0, %3\n\t"
                 "v_addc_co_u32_e64 %1, %4, 0, %1, %4"
                 : "+v"(na), "+v"(nb), "=&s"(s0), "=&s"(s1), "=&s"(s2) : "v"(ka0), "v"(kb0), "v"(ka1), "v"(kb1), "s"(ca), "s"(cb) : "vcc");
}
template <int NC>
__device__ __forceinline__ void build_mask(const unsigned (&kv)[NC], unsigned thr, int need, int lane, GAS unsigned long long* mrow) {
    unsigned mlo = 0u, mhi = 0u; int tbase = 0;
#pragma unroll
    for (int c = 0; c < NC; ++c) {
        unsigned long long m = __ballot(kv[c] > thr);
        if (need > 0 && tbase < need) {
            const unsigned long long em = __ballot(kv[c] == thr);
            const int ce = __popcll(em);
            if (tbase + ce <= need) m |= em;
            else { const int pre = __builtin_amdgcn_mbcnt_hi((unsigned)(em >> 32), __builtin_amdgcn_mbcnt_lo((unsigned)em, 0u)); m |= __ballot(kv[c] == thr && pre < need - tbase); }
            tbase += ce;
        }
        asm volatile("s_nop 1\n\tv_writelane_b32 %0, %2, %4\n\tv_writelane_b32 %1, %3, %4" : "+v"(mlo), "+v"(mhi) : "s"((unsigned)m), "s"((unsigned)(m >> 32)), "i"(c));
    }
    if (lane < 32) mrow[(size_t)lane * SEQ] = ((unsigned long long)mhi << 32) | mlo;
}
__device__ __forceinline__ unsigned wave_max_dpp(unsigned v) {
    unsigned t;
    t = (unsigned)__builtin_amdgcn_update_dpp(0, (int)v, 0x111, 0xf, 0xf, false); v = v > t ? v : t;
    t = (unsigned)__builtin_amdgcn_update_dpp(0, (int)v, 0x112, 0xf, 0xf, false); v = v > t ? v : t;
    t = (unsigned)__builtin_amdgcn_update_dpp(0, (int)v, 0x114, 0xf, 0xf, false); v = v > t ? v : t;
    t = (unsigned)__builtin_amdgcn_update_dpp(0, (int)v, 0x118, 0xf, 0xf, false); v = v > t ? v : t;
    t = (unsigned)__builtin_amdgcn_update_dpp(0, (int)v, 0x142, 0xa, 0xf, false); v = v > t ? v : t;
    t = (unsigned)__builtin_amdgcn_update_dpp(0, (int)v, 0x143, 0xc, 0xf, false); v = v > t ? v : t;
    return (unsigned)__builtin_amdgcn_readlane((int)v, 63);
}
__device__ __forceinline__ unsigned f2key(float f) { const unsigned u = __float_as_uint(f); return (u & 0x80000000u) ? ~u : (u | 0x80000000u); }
__device__ __forceinline__ float key2f(unsigned k) { return __uint_as_float((k & 0x80000000u) ? (k & 0x7fffffffu) : ~k); }
struct RowSearch {
    unsigned lo, hi, thr; int cl, ch, need, last; float wl, wh; bool act;
    __device__ __forceinline__ void init(bool wanted, int ncausal, int cz0, int cz1, unsigned kmax, unsigned kmin) {
        act = false; thr = 0u; need = 0; lo = 0u; hi = 0u; cl = 0; ch = 0; last = 0; wl = 1.f; wh = 1.f;
        if (!wanted) return;
        if (cz1 <= 256 && cz0 >= 256) { thr = 0x80000000u; need = 256 - cz1; return; }
        act = true;
        if (cz1 > 256) { lo = 0x80000001u; cl = cz1; hi = kmax + 1u; ch = 0; }
        else { lo = kmin; cl = ncausal; hi = 0x80000000u; ch = cz0; }
        wl = (float)(cl - 256); wh = (float)(256 - ch);
    }
    __device__ __forceinline__ unsigned next_cand(int it) {
        if (!act) return 0xffffffffu;
        if (hi - lo <= 1u) { thr = lo; need = 256 - ch; act = false; return 0xffffffffu; }
        const float fl = key2f(lo), fh = key2f(hi);
        unsigned c = f2key((fl * wh + fh * wl) * __builtin_amdgcn_rcpf(wl + wh));
        if (it >= 24) c = lo + ((hi - lo) >> 1);
        if (c <= lo) c = lo + 1u;
        if (c >= hi) c = hi - 1u;
        return c;
    }
    __device__ __forceinline__ void update(unsigned c, int cnt) {
        if (!act) return;
        if (cnt == 256) { thr = c - 1u; need = 0; act = false; }
        else if (cnt > 256) { lo = c; cl = cnt; wl = (float)(cnt - 256); if (last == 1) wh *= 0.5f; last = 1; }
        else { hi = c; ch = cnt; wh = (float)(256 - cnt); if (last == -1) wl *= 0.5f; last = -1; }
    }
};
template <int NC>
__device__ __forceinline__ void select_rows2(const LAS unsigned* sa, int nchunks, int ta, int lane, GAS unsigned long long* ma) {
    unsigned ka[NC], kb[NC];
#pragma unroll
    for (int c = 0; c < NC; ++c) { ka[c] = (c < nchunks) ? sa[64 * c + lane] : 0u; kb[c] = (c < nchunks) ? sa[2048 + 64 * c + lane] : 0u; }
    LDS_WAIT(); __builtin_amdgcn_s_barrier(); asm volatile("" ::: "memory");
    RowSearch A, B;
    if (ta + 2 > 256) {
        int a0 = 0, b0 = 0, a1 = 0, b1 = 0;
#pragma unroll
        for (int c = 0; c < NC; c += 2) cnt4(a0, b0, ka[c], kb[c], ka[c + 1], kb[c + 1], 0x80000000u, 0x80000000u);
#pragma unroll
        for (int c = 0; c < NC; c += 2) cnt4(a1, b1, ka[c], kb[c], ka[c + 1], kb[c + 1], 0x80000001u, 0x80000001u);
        unsigned mxa = 0u, mxb = 0u, mna = 0u, mnb = 0u;
#pragma unroll
        for (int c = 0; c < NC; ++c) { mxa = ka[c] > mxa ? ka[c] : mxa; mxb = kb[c] > mxb ? kb[c] : mxb;
            const unsigned ia = ~(ka[c] - 1u), ib = ~(kb[c] - 1u); mna = ia > mna ? ia : mna; mnb = ib > mnb ? ib : mnb; }
        const int t0s = wave_sum_dpp(a0 | (b0 << 16)), t1s = wave_sum_dpp(a1 | (b1 << 16));
        const unsigned kmxa = wave_max_dpp(mxa), kmxb = wave_max_dpp(mxb), kmna = ~wave_max_dpp(mna) + 1u, kmnb = ~wave_max_dpp(mnb) + 1u;
        A.init(ta + 1 > 256, ta + 1, t0s & 0xffff, t1s & 0xffff, kmxa, kmna);
        B.init(true, ta + 2, t0s >> 16, t1s >> 16, kmxb, kmnb);
        for (int it = 0; it < 64; ++it) {
            const unsigned ca = A.next_cand(it), cb = B.next_cand(it);
            if (!(A.act || B.act)) break;
            int na = 0, nb = 0;
#pragma unroll
            for (int c = 0; c < NC; c += 2) cnt4(na, nb, ka[c], kb[c], ka[c + 1], kb[c + 1], ca, cb);
            const int tot = wave_sum_dpp(na | (nb << 16));
            A.update(ca, tot & 0xffff); B.update(cb, tot >> 16);
        }
    } else { A.init(false, 0, 0, 0, 0u, 0u); B.init(false, 0, 0, 0, 0u, 0u); }
    build_mask<NC>(ka, A.thr, A.need, lane, ma);
    build_mask<NC>(kb, B.thr, B.need, lane, ma + 1);
}
__device__ __forceinline__ void select_phase(Frame& F, const bf16* QI, const bf16* KI, const float* WI, unsigned long long* MASK, const bf16* U, bf16* MIX) {
    LAS unsigned* SC = (LAS unsigned*)(F.lds + RING_OFF);
    const int lane = F.lane, wave = F.wave, fr = lane & 15, fq = lane >> 4;
    LAS unsigned* jobctr = (LAS unsigned*)(F.lds + LDSCTL_OFF + 512);
    if (F.tid < 16) jobctr[F.tid] = 0u;
    LDS_WAIT(); __builtin_amdgcn_s_barrier(); asm volatile("" ::: "memory");
    pg8::bf16x8 afr[4][2]; f32x4 w[4];
#pragma unroll 1
    for (int uu_ = 0; uu_ < 4 * SEL_REP; ++uu_) {
        const int ui = uu_ & 3, b = F.vcu >> 5, j = F.vcu & 31;
        const int g = (ui == 0) ? 127 - j : (ui == 1) ? 64 + j : (ui == 2) ? 63 - j : j;
        const int t0 = 16 * g; const size_t rowbase = (size_t)b * SEQ;
        const int nchunks = (t0 + 16 + 63) >> 6, ntiles = nchunks * 4;
        if (uu_ == 0) {
#pragma unroll
            for (int h = 0; h < 4; ++h)
#pragma unroll
                for (int ks = 0; ks < 2; ++ks) afr[h][ks] = *(const pg8::bf16x8*)(QI + (rowbase + t0 + fr) * 256 + 64 * h + 32 * ks + 8 * fq);
#pragma unroll
            for (int r = 0; r < 4; ++r) w[r] = *(const f32x4*)(WI + (rowbase + t0 + 4 * fq + r) * 4);
        }
        if (uu_ < 4 || SEL_ABL != 3) {
        LAS unsigned* ctr = jobctr + uu_;
        int job; { unsigned j_ = 0u; if (lane == 0) j_ = __hip_atomic_fetch_add(ctr, 1u, __ATOMIC_RELAXED, __HIP_MEMORY_SCOPE_WORKGROUP); job = __builtin_amdgcn_readfirstlane((int)j_); }
        pg8::bf16x8 bfr[4][2];
        if (job < nchunks) {
#pragma unroll
            for (int i = 0; i < 4; ++i) { const bf16* kp = KI + ((rowbase >> 4) + 4 * job + i) * 1024 + (fq * 16 + fr) * 8; bfr[i][0] = *(const pg8::bf16x8*)kp; bfr[i][1] = *(const pg8::bf16x8*)(kp + 512); }
        }
#pragma unroll 1
        while (job < nchunks) {
            int nxt; { unsigned j_ = 0u; if (lane == 0) j_ = __hip_atomic_fetch_add(ctr, 1u, __ATOMIC_RELAXED, __HIP_MEMORY_SCOPE_WORKGROUP); nxt = __builtin_amdgcn_readfirstlane((int)j_); }
            pg8::bf16x8 bnx[4][2];
            { const int jn = (nxt < nchunks) ? nxt : job;
#pragma unroll
              for (int i = 0; i < 4; ++i) { const bf16* kp = KI + ((rowbase >> 4) + 4 * jn + i) * 1024 + (fq * 16 + fr) * 8; bnx[i][0] = *(const pg8::bf16x8*)kp; bnx[i][1] = *(const pg8::bf16x8*)(kp + 512); } }
#pragma unroll
            for (int i = 0; i < 4; ++i) {
                const int tile = 4 * job + i;
                {
                    const int key = 16 * tile + fr;
                    f32x4 acc[4];
#pragma unroll
                    for (int h = 0; h < 4; ++h) {
                        acc[h] = __builtin_amdgcn_mfma_f32_16x16x32_bf16(afr[h][0], bfr[i][0], (f32x4){0.f, 0.f, 0.f, 0.f}, 0, 0, 0);
                        acc[h] = __builtin_amdgcn_mfma_f32_16x16x32_bf16(afr[h][1], bfr[i][1], acc[h], 0, 0, 0);
                    }
                    const bool edge = 16 * tile + 15 > t0;
#pragma unroll
                    for (int r = 0; r < 4; ++r) {
                        float sc = 0.f;
#pragma unroll
                        for (int h = 0; h < 4; ++h) { const int ri = __float_as_int(acc[h][r]); sc = fmaf(w[r][h], __int_as_float(ri > 0 ? ri : 0), sc); }
                        const int u = __float_as_int(sc);
                        unsigned sk = (unsigned)u ^ ((unsigned)(u >> 31) | 0x80000000u);
                        if (edge) sk = (key <= t0 + 4 * fq + r) ? sk : 0u;
                        SC[(4 * fq + r) * 2048 + key] = sk;
                    }
                }
            }
#pragma unroll
            for (int i = 0; i < 4; ++i) { bfr[i][0] = bnx[i][0]; bfr[i][1] = bnx[i][1]; }
            job = nxt;
        }
        }
        if (uu_ + 1 < 4 * SEL_REP) {
            const int ui2 = (uu_ + 1) & 3, g2 = (ui2 == 0) ? 127 - j : (ui2 == 1) ? 64 + j : (ui2 == 2) ? 63 - j : j, t02 = 16 * g2;
#pragma unroll
            for (int h = 0; h < 4; ++h)
#pragma unroll
                for (int ks = 0; ks < 2; ++ks) afr[h][ks] = *(const pg8::bf16x8*)(QI + (rowbase + t02 + fr) * 256 + 64 * h + 32 * ks + 8 * fq);
#pragma unroll
            for (int r = 0; r < 4; ++r) w[r] = *(const f32x4*)(WI + (rowbase + t02 + 4 * fq + r) * 4);
        }
        LDS_WAIT(); __builtin_amdgcn_s_barrier(); asm volatile("" ::: "memory");
        {
            const int ncr = (nchunks + 3) >> 2;
            const int rl = 2 * wave, t = t0 + rl;
            const LAS unsigned* srow = SC + rl * 2048;
            GAS unsigned long long* mrow = (GAS unsigned long long*)MASK + (uu_ >= 4 ? (size_t)202 * 1024 * 1024 / 8 : (size_t)0) + (size_t)b * 32 * SEQ + t;
            if (uu_ < 4 || SEL_ABL == 1 || SEL_ABL == 3) switch (ncr) {
                case 1: select_rows2<4>(srow, nchunks, t, lane, mrow); break;
                case 2: select_rows2<8>(srow, nchunks, t, lane, mrow); break;
                case 3: select_rows2<12>(srow, nchunks, t, lane, mrow); break;
                case 4: select_rows2<16>(srow, nchunks, t, lane, mrow); break;
                case 5: select_rows2<20>(srow, nchunks, t, lane, mrow); break;
                case 6: select_rows2<24>(srow, nchunks, t, lane, mrow); break;
                case 7: select_rows2<28>(srow, nchunks, t, lane, mrow); break;
                default: select_rows2<32>(srow, nchunks, t, lane, mrow); break;
            }
            else { LDS_WAIT(); __builtin_amdgcn_s_barrier(); asm volatile("" ::: "memory"); }
        }
    }
    const int gw = F.vcu * NWAVES + F.wave, NGW = F.G * NWAVES;
#pragma unroll 1
    for (int task = gw; task < POOL_REP * (M / 4); task += NGW) {
        const int row0 = (task & (M / 4 - 1)) * 4, tq = row0 & (SEQ - 1);
        v4u uu[19];
#pragma unroll
        for (int i = 0; i < 19; ++i) { const int dt = i - 15; uu[i] = (tq + dt >= 0) ? *(const GAS v4u*)(U + (size_t)(row0 + dt) * 512 + 8 * lane) : (v4u){0u, 0u, 0u, 0u}; }
        const int gsel = lane >> 4;
#pragma unroll
        for (int i = 0; i < 4; ++i) {
            const int t = tq + i, wl = 2 << gsel, n = (t + 1 < wl) ? (t + 1) : wl; const float inv = 1.0f / (float)n;
            unsigned ow[4];
#pragma unroll
            for (int q = 0; q < 4; ++q) {
                float lo[16], hi[16];
#pragma unroll
                for (int jj = 0; jj < 16; ++jj) { const unsigned x = uu[15 + i - jj][q]; lo[jj] = __uint_as_float(x << 16); hi[jj] = __uint_as_float(x & 0xffff0000u); }
                const float l2 = lo[0] + lo[1], h2 = hi[0] + hi[1];
                const float l4 = l2 + (lo[2] + lo[3]), h4 = h2 + (hi[2] + hi[3]);
                const float l8 = l4 + ((lo[4] + lo[5]) + (lo[6] + lo[7])), h8 = h4 + ((hi[4] + hi[5]) + (hi[6] + hi[7]));
                const float l16 = l8 + (((lo[8] + lo[9]) + (lo[10] + lo[11])) + ((lo[12] + lo[13]) + (lo[14] + lo[15]))), h16 = h8 + (((hi[8] + hi[9]) + (hi[10] + hi[11])) + ((hi[12] + hi[13]) + (hi[14] + hi[15])));
                const float sl = (gsel == 0) ? l2 : (gsel == 1) ? l4 : (gsel == 2) ? l8 : l16, sh = (gsel == 0) ? h2 : (gsel == 1) ? h4 : (gsel == 2) ? h8 : h16;
                ow[q] = pk2(sl * inv - lo[0], sh * inv - hi[0]);
            }
            *(GAS v4u*)(MIX + (size_t)(row0 + i) * 1024 + 512 + 8 * lane) = (v4u){ow[0], ow[1], ow[2], ow[3]};
        }
    }
}

#include <hip/hip_bf16.h>
namespace attn_body {
using bf16=__hip_bfloat16;
using bf16x8=__attribute__((ext_vector_type(8)))short;
using s16x4=__attribute__((ext_vector_type(4)))short;
using f32x16=__attribute__((ext_vector_type(16)))float;
using u32x4=__attribute__((ext_vector_type(4)))unsigned;
constexpr int BATCH=8,NHEAD=8,SEQ=2048,D=64,KP=512,OP=1024;
constexpr int NW=8,QBLK=32,QB=QBLK*NW,KVBLK=64,NQB=SEQ/QB;
constexpr int ATTN_UNIT_ROWS=QB;
__device__ __forceinline__ int crow(int r,int hi){return (r&3)+8*(r>>2)+4*hi;}
#define SBAR() __builtin_amdgcn_sched_barrier(0)
__device__ __forceinline__ void cmask(f32x16&p0,f32x16&p1,int jb,int qrel,int hi){
  const float NEG=-INFINITY; int kb=64*jb+4*hi;
  #pragma unroll
  for(int r=0;r<16;++r){int kv=kb+(r&3)+8*(r>>2); if(kv>qrel)p0[r]=NEG; if(kv+32>qrel)p1[r]=NEG;}
}

constexpr int NSLOT=3, SLOTB=8192;
constexpr int LDS_K=0, LDS_V=NSLOT*SLOTB, LDS_WS=2*NSLOT*SLOTB, LDS_OST=LDS_WS+NW*64*4, LDS_BYTES=LDS_OST+NW*4096, LDS_MASK=LDS_BYTES, LDS_TOTAL=LDS_MASK+32*2048;
constexpr float C2=0.125f*1.4426950408889634f;
__device__ __forceinline__ void glds16(const void*sbase,unsigned voff,unsigned lds_dst){unsigned keep;
  asm volatile("s_mov_b32 %0, m0\n\ts_mov_b32 m0, %2\n\ts_nop 4\n\tglobal_load_lds_dwordx4 %1, %3\n\ts_mov_b32 m0, %0":"=&s"(keep):"v"(voff),"s"(lds_dst),"s"(sbase):"memory");}
__device__ __forceinline__ float max3f(float a,float b,float c){float r;asm("v_max3_f32 %0, %1, %2, %3":"=v"(r):"v"(a),"v"(b),"v"(c));return r;}
__device__ __forceinline__ float max2f(float a,float b){float r;asm("v_max_f32_e32 %0, %1, %2":"=v"(r):"v"(a),"v"(b));return r;}
__device__ __forceinline__ float fadd_s(float a,float b){float r;asm("v_add_f32_e32 %0, %1, %2":"=v"(r):"v"(a),"v"(b));return r;}
__device__ __forceinline__ float fsub_s(float a,float b){float r;asm("v_sub_f32_e32 %0, %1, %2":"=v"(r):"v"(a),"v"(b));return r;}
typedef float f32x2_t __attribute__((ext_vector_type(2))); typedef __bf16 bf16x2_t __attribute__((ext_vector_type(2)));
__device__ __forceinline__ unsigned cvtpk_s(float lo,float hi){f32x2_t v={lo,hi};bf16x2_t b=__builtin_convertvector(v,bf16x2_t);return __builtin_bit_cast(unsigned,b);}
#define WAIT_BAR(N) asm volatile("s_waitcnt vmcnt(" #N ") lgkmcnt(0)\n\ts_barrier":::"memory")

__device__ __forceinline__ void qkt(f32x16&p0,f32x16&p1,const char*Kslot,const bf16x8*qr,const f32x16&negm,int r32,int hi){
  const char*kb=Kslot+hi*1024+r32*16;
  #pragma unroll
  for(int d0=0;d0<4;++d0){
    const bf16x8 b0=*reinterpret_cast<const bf16x8*>(kb+d0*2048);
    const bf16x8 b1=*reinterpret_cast<const bf16x8*>(kb+d0*2048+512);
    if(d0==0){p0=__builtin_amdgcn_mfma_f32_32x32x16_bf16(b0,qr[0],negm,0,0,0);p1=__builtin_amdgcn_mfma_f32_32x32x16_bf16(b1,qr[0],negm,0,0,0);}
    else{p0=__builtin_amdgcn_mfma_f32_32x32x16_bf16(b0,qr[d0],p0,0,0,0);p1=__builtin_amdgcn_mfma_f32_32x32x16_bf16(b1,qr[d0],p1,0,0,0);}}
}
typedef __attribute__((address_space(3))) const char* lds_cptr;
typedef short v4i16_t __attribute__((ext_vector_type(4)));
__device__ __forceinline__ void kload8(bf16x8*kf,lds_cptr kp){
  kf[0]=*(const __attribute__((address_space(3))) bf16x8*)(kp);      kf[1]=*(const __attribute__((address_space(3))) bf16x8*)(kp+512);
  kf[2]=*(const __attribute__((address_space(3))) bf16x8*)(kp+2048); kf[3]=*(const __attribute__((address_space(3))) bf16x8*)(kp+2560);
  kf[4]=*(const __attribute__((address_space(3))) bf16x8*)(kp+4096); kf[5]=*(const __attribute__((address_space(3))) bf16x8*)(kp+4608);
  kf[6]=*(const __attribute__((address_space(3))) bf16x8*)(kp+6144); kf[7]=*(const __attribute__((address_space(3))) bf16x8*)(kp+6656);
}
__device__ __forceinline__ void kload2(bf16x8*kf,lds_cptr kp,int j){ kf[2*j]=*(const __attribute__((address_space(3))) bf16x8*)(kp+j*2048); kf[2*j+1]=*(const __attribute__((address_space(3))) bf16x8*)(kp+j*2048+512); }
__device__ __forceinline__ s16x4 vtr(lds_cptr p){ return __builtin_bit_cast(s16x4,__builtin_amdgcn_ds_read_tr16_b64_v4i16((__attribute__((address_space(3))) v4i16_t*)p)); }
__device__ __forceinline__ float rowmax(const f32x16&p0,const f32x16&p1){
  float a=max3f(p0[0],p0[1],p1[0]),b=max3f(p0[2],p0[3],p1[1]);a=max3f(a,p1[2],p1[3]);
  #pragma unroll
  for(int r=4;r<16;r+=4){a=max3f(a,p0[r],p0[r+1]);b=max3f(b,p0[r+2],p0[r+3]);a=max3f(a,p1[r],p1[r+1]);b=max3f(b,p1[r+2],p1[r+3]);}
  const float m=max2f(a,b);
  auto rr=__builtin_amdgcn_permlane32_swap(__float_as_uint(m),__float_as_uint(m),false,false);
  return max2f(__uint_as_float(rr[0]),__uint_as_float(rr[1]));
}
__device__ __forceinline__ void pv(f32x16*o,int vb,bf16x8 pa0,bf16x8 pa1,bf16x8 pa2,bf16x8 pa3){
  #pragma unroll
  for(int d0=0;d0<2;++d0){s16x4 lo[4],hi[4];
    #pragma unroll
    for(int ks=0;ks<4;++ks){
      asm volatile("ds_read_b64_tr_b16 %0,%1 offset:%c2":"=&v"(lo[ks]):"v"(vb),"i"(d0*4096+ks*1024):"memory");
      asm volatile("ds_read_b64_tr_b16 %0,%1 offset:%c2":"=&v"(hi[ks]):"v"(vb),"i"(d0*4096+ks*1024+512):"memory");}
    asm volatile("s_waitcnt lgkmcnt(0)":::"memory");SBAR();
    #define PK(k) (bf16x8){lo[k][0],lo[k][1],lo[k][2],lo[k][3],hi[k][0],hi[k][1],hi[k][2],hi[k][3]}
    o[d0]=__builtin_amdgcn_mfma_f32_32x32x16_bf16(pa0,PK(0),o[d0],0,0,0);
    o[d0]=__builtin_amdgcn_mfma_f32_32x32x16_bf16(pa1,PK(1),o[d0],0,0,0);
    o[d0]=__builtin_amdgcn_mfma_f32_32x32x16_bf16(pa2,PK(2),o[d0],0,0,0);
    o[d0]=__builtin_amdgcn_mfma_f32_32x32x16_bf16(pa3,PK(3),o[d0],0,0,0);
    #undef PK
  }
}

#ifndef ATTN_STORE16
#define ATTN_STORE16(p,v) (*(u32x4*)(p)=(v))
#endif
template<int THRL> __device__ __forceinline__ void attn_unit(int b,int h,int qb,const bf16*Q,const bf16*__restrict__ K,const bf16*__restrict__ V,bf16*O,const unsigned long long*MASKT,char*shm,const int wave_id){
  const int wid=wave_id,lane=(int)__builtin_amdgcn_mbcnt_hi(~0u,__builtin_amdgcn_mbcnt_lo(~0u,0u)),tid=wid*64+lane,r32=lane&31,hi=lane>>5;
  const long rowbase=(long)b*SEQ; const int q0=qb*QB; const int NT=(q0+QB)/KVBLK;
  const bf16*Qw=Q+(rowbase+q0+wid*QBLK)*KP+h*D;
  const bf16*Kh=K+((long)(b*NHEAD+h)*(SEQ/KVBLK))*4096,*Vh=V+((long)(b*NHEAD+h)*(SEQ/KVBLK))*4096;
  const unsigned lds0=(unsigned)(uintptr_t)shm;
  float*wsf=(float*)(shm+LDS_WS)+wid*64;
  const bf16*ksrc=Kh+wid*512,*vsrc=Vh+wid*512; const unsigned dmaoff=(unsigned)lane*16u;
  const unsigned kdst=lds0+LDS_K+wid*1024, vdst=lds0+LDS_V+wid*1024;
  #define DMA_K(t,slot) glds16(ksrc+(long)(t)*4096,dmaoff,(unsigned)__builtin_amdgcn_readfirstlane(kdst+(slot)))
  #define DMA_V(t,slot) glds16(vsrc+(long)(t)*4096,dmaoff,(unsigned)__builtin_amdgcn_readfirstlane(vdst+(slot)))
  const char*Kbase=shm+LDS_K; bf16x8 kf[8];
  const lds_cptr shm3=(lds_cptr)shm; const lds_cptr kp0=shm3+LDS_K+hi*1024+r32*16; const lds_cptr vp0=shm3+LDS_V+((lane>>4)&1)*32+(lane&3)*8+(4*hi+((lane&15)>>2))*64;
  { int tl=tid; asm volatile("":"+v"(tl));
    const int npc=NT*128; const unsigned long long*msrc=MASKT+((long)b*32)*SEQ+q0; u32x4 mv[8];
    #pragma unroll
    for(int i=0;i<8;++i){ const int p=tl+i*NW*64; if(p<npc)mv[i]=*reinterpret_cast<const u32x4*>(msrc+(long)(p>>7)*SEQ+(p&127)*2); }
    #pragma unroll
    for(int i=0;i<8;++i){ const int p=tl+i*NW*64; if(p<npc)*reinterpret_cast<__attribute__((address_space(3))) u32x4*>((__attribute__((address_space(3))) char*)(lds_cptr)shm+LDS_MASK+(p>>7)*2048+(p&127)*16)=mv[i]; } }
  asm volatile("s_waitcnt vmcnt(0) lgkmcnt(0)":::"memory");
  DMA_K(0,0);DMA_V(0,0);DMA_K(1,SLOTB);
  bf16x8 qr[4];
  #pragma unroll
  for(int d0=0;d0<4;++d0)qr[d0]=*reinterpret_cast<const bf16x8*>(&Qw[(long)r32*KP+d0*16+hi*8]);
  #define BP(r) (((r)&3)+8*((r)>>2))
  #define EXM(x,w,r) __uint_as_float(__float_as_uint(__builtin_amdgcn_exp2f(x))&(unsigned)__builtin_amdgcn_sbfe((int)(w),BP(r),1))
  #define MASKLD(tt,m0,m1) int ro_=r32; asm volatile("":"+v"(ro_)); const unsigned long long mw_=*(const __attribute__((address_space(3))) unsigned long long*)((lds_cptr)shm+LDS_MASK+wid*(QBLK*8)+ro_*8+(tt)*2048); const unsigned m0=((unsigned)mw_)>>(4*hi),m1=((unsigned)(mw_>>32))>>(4*hi)
  float mhat=0.f,l_reg=0.f;f32x16 o[2];o[0]=f32x16{};o[1]=f32x16{};f32x16 negm=f32x16{};asm volatile("":"+v"(negm));
  const int qrel=wid*QBLK+r32;
  #define CMASK(P0,P1,t) do{}while(0)
  bool resc=false;
  #define START(P0,P1) do{ const float rm=rowmax(P0,P1); resc=false; \
    { const float dl=rm; mhat=fadd_s(mhat,dl); \
      _Pragma("unroll") for(int r=0;r<16;++r){P0[r]=fsub_s(P0[r],dl);P1[r]=fsub_s(P1[r],dl);} \
      _Pragma("unroll") for(int r=0;r<16;++r)negm[r]=-mhat; asm volatile("":"+v"(negm)); } \
    _Pragma("unroll") for(int r=0;r<16;++r)P0[r]=EXM(P0[r],mS0,r); }while(0)
  #define RESC() do{ if(resc){ asm volatile("s_waitcnt lgkmcnt(0)":::"memory"); \
      _Pragma("unroll") for(int d_=0;d_<2;++d_) _Pragma("unroll") for(int r=0;r<16;++r)o[d_][r]*=wsf[crow(r,hi)]; } }while(0)
  f32x16 pA0,pA1,pB0,pB1;
  int sl_prev=0,sl_cur=0,sl_next=SLOTB;
  #define ROT() do{sl_prev=sl_cur;sl_cur=sl_next;sl_next=(sl_next==(NSLOT-1)*SLOTB)?0:sl_next+SLOTB;}while(0)
  DMA_K(2,2*SLOTB);
  WAIT_BAR(3);
  qkt(pA0,pA1,Kbase,qr,negm,r32,hi);asm volatile("s_nop 15\n\ts_nop 7":"+v"(pA0),"+v"(pA1));CMASK(pA0,pA1,0);
  { MASKLD(0,mS0,mS1);
  START(pA0,pA1);
  _Pragma("unroll") for(int r=0;r<16;++r)pA1[r]=EXM(pA1[r],mS1,r); }
  WAIT_BAR(0);
  DMA_K(3,0);DMA_V(1,SLOTB);
  ROT();
  kload8(kf,kp0+sl_cur);
  WAIT_BAR(2);
  s16x4 vlo[8],vhi[8]; u32x4 pw0,pw1,pw2,pw3;
  #define PKW(P,B) cvtpk_s(P[B],P[B+1])
  #define PAF(k) __builtin_bit_cast(bf16x8,pw##k)
  #define VFR(i) (bf16x8){vlo[i][0],vlo[i][1],vlo[i][2],vlo[i][3],vhi[i][0],vhi[i][1],vhi[i][2],vhi[i][3]}
  #define PIN(x) asm volatile("":"+v"(x))
  #define MX3(a,b,c) __builtin_fmaxf(__builtin_fmaxf((a),(b)),(c))
  #define GAPA(MF,A0,A1,A2,A3,W0,W1,PW) do{ MF; sacc+=A0; sacc+=A1; sacc+=A2; sacc+=A3; PIN(sacc); W0; W1; PIN(PW); SBAR(); }while(0)
  #define EX(v) __builtin_amdgcn_exp2f(v)
  #define GAPB(MF,X,B,W) do{ MF; X[B]=EXM(X[B],W,B); X[B+1]=EXM(X[B+1],W,B+1); X[B+2]=EXM(X[B+2],W,B+2); X[B+3]=EXM(X[B+3],W,B+3); PIN(X); SBAR(); }while(0)
  #define VRD(i) do{ vlo[i]=vtr(vp_+(((i)>>2)*4096+((i)&3)*1024)); vhi[i]=vtr(vp_+(((i)>>2)*4096+((i)&3)*1024+512)); }while(0)
  #define KRD(G,j) do{ if(G){ kload2(kf,kp0+sl_next,j); SBAR(); } }while(0)
  #define STEP(C0,C1,P0,P1,t,GK,GV,GL) do{ SBAR(); \
    const lds_cptr vp_=vp0+sl_prev; \
    VRD(0); SBAR(); float sacc=(P0[0]+P0[1]); \
    GAPA(C0=__builtin_amdgcn_mfma_f32_32x32x16_bf16(kf[0],qr[0],negm,0,0,0), P0[2],P0[3],P0[4],P0[5],     pw0[0]=PKW(P0,0), pw0[1]=PKW(P0,2), pw0); \
    VRD(4); SBAR(); GAPA(C1=__builtin_amdgcn_mfma_f32_32x32x16_bf16(kf[1],qr[0],negm,0,0,0), P0[6],P0[7],P0[8],P0[9],     pw0[2]=PKW(P0,4), pw0[3]=PKW(P0,6), pw0); \
    VRD(1); SBAR(); GAPA(C0=__builtin_amdgcn_mfma_f32_32x32x16_bf16(kf[2],qr[1],C0,0,0,0),   P0[10],P0[11],P0[12],P0[13], pw1[0]=PKW(P0,8), pw1[1]=PKW(P0,10), pw1); \
    VRD(5); SBAR(); GAPA(C1=__builtin_amdgcn_mfma_f32_32x32x16_bf16(kf[3],qr[1],C1,0,0,0),   P0[14],P0[15],P1[0],P1[1],   pw1[2]=PKW(P0,12),pw1[3]=PKW(P0,14), pw1); \
    VRD(2); SBAR(); GAPA(C0=__builtin_amdgcn_mfma_f32_32x32x16_bf16(kf[4],qr[2],C0,0,0,0),   P1[2],P1[3],P1[4],P1[5],     pw2[0]=PKW(P1,0), pw2[1]=PKW(P1,2), pw2); \
    VRD(6); SBAR(); GAPA(C1=__builtin_amdgcn_mfma_f32_32x32x16_bf16(kf[5],qr[2],C1,0,0,0),   P1[6],P1[7],P1[8],P1[9],     pw2[2]=PKW(P1,4), pw2[3]=PKW(P1,6), pw2); \
    VRD(3); SBAR(); GAPA(C0=__builtin_amdgcn_mfma_f32_32x32x16_bf16(kf[6],qr[3],C0,0,0,0),   P1[10],P1[11],P1[12],P1[13], pw3[0]=PKW(P1,8), pw3[1]=PKW(P1,10), pw3); \
    VRD(7); SBAR(); GAPA(C1=__builtin_amdgcn_mfma_f32_32x32x16_bf16(kf[7],qr[3],C1,0,0,0),   P1[14],P1[15],0.f,0.f,       pw3[2]=PKW(P1,12),pw3[3]=PKW(P1,14), pw3); \
    l_reg+=sacc; \
    if(GK){DMA_K((t)+3,sl_cur);} if(GV){DMA_V((t)+1,sl_next);} \
    MASKLD(t,mA_,mB_); \
    { float a=MX3(C0[0],C0[1],C1[0]),b=MX3(C0[2],C0[3],C1[1]); a=MX3(a,C1[2],C1[3]); \
      _Pragma("unroll") for(int r=4;r<16;r+=4){a=MX3(a,C0[r],C0[r+1]);b=MX3(b,C0[r+2],C0[r+3]);a=MX3(a,C1[r],C1[r+1]);b=MX3(b,C1[r+2],C1[r+3]);} \
      float rm=__builtin_fmaxf(a,b); { auto rr=__builtin_amdgcn_permlane32_swap(__float_as_uint(rm),__float_as_uint(rm),false,false); rm=__builtin_fmaxf(__uint_as_float(rr[0]),__uint_as_float(rr[1])); } \
      resc=false; \
      if(__builtin_expect(__any(rm>(float)THRL),0)){ const float dl=__builtin_fmaxf(rm,0.f); mhat+=dl; \
        _Pragma("unroll") for(int r=0;r<16;++r){C0[r]-=dl;C1[r]-=dl;} \
        _Pragma("unroll") for(int r=0;r<16;++r)negm[r]=-mhat; asm volatile("":"+v"(negm)); \
        const float f=__builtin_amdgcn_exp2f(-dl); l_reg*=f; { int rq_=r32; asm volatile("":"+v"(rq_)); if(hi==0)wsf[rq_]=f; } resc=true; } } \
    SBAR(); \
    GAPB(o[0]=__builtin_amdgcn_mfma_f32_32x32x16_bf16(PAF(0),VFR(0),o[0],0,0,0), C0,0,mA_); \
    GAPB(o[1]=__builtin_amdgcn_mfma_f32_32x32x16_bf16(PAF(0),VFR(4),o[1],0,0,0), C0,4,mA_); \
    KRD(GL,0); GAPB(o[0]=__builtin_amdgcn_mfma_f32_32x32x16_bf16(PAF(1),VFR(1),o[0],0,0,0), C0,8,mA_); \
    KRD(GL,1); GAPB(o[1]=__builtin_amdgcn_mfma_f32_32x32x16_bf16(PAF(1),VFR(5),o[1],0,0,0), C0,12,mA_); \
    KRD(GL,2); GAPB(o[0]=__builtin_amdgcn_mfma_f32_32x32x16_bf16(PAF(2),VFR(2),o[0],0,0,0), C1,0,mB_); \
    KRD(GL,3); GAPB(o[1]=__builtin_amdgcn_mfma_f32_32x32x16_bf16(PAF(2),VFR(6),o[1],0,0,0), C1,4,mB_); \
    GAPB(o[0]=__builtin_amdgcn_mfma_f32_32x32x16_bf16(PAF(3),VFR(3),o[0],0,0,0), C1,8,mB_); \
    GAPB(o[1]=__builtin_amdgcn_mfma_f32_32x32x16_bf16(PAF(3),VFR(7),o[1],0,0,0), C1,12,mB_); \
    }while(0)
  int t=1;
  #undef CMASK
  #define CMASK(P0,P1,t) do{}while(0)
  for(;t+5<NT;t+=2){
    STEP(pB0,pB1,pA0,pA1,t,true,true,true);     WAIT_BAR(2); RESC(); ROT();
    STEP(pA0,pA1,pB0,pB1,t+1,true,true,true);   WAIT_BAR(2); RESC(); ROT();
  }
  #undef CMASK
  #define CMASK(P0,P1,t) do{}while(0)
  #define ENDW(tt) do{ if((tt)+3<NT){WAIT_BAR(2);} else if((tt)+2<NT){WAIT_BAR(1);} else {WAIT_BAR(0);} }while(0)
  for(;t+1<NT;t+=2){
    STEP(pB0,pB1,pA0,pA1,t,(t+3<NT),(t+1<NT),(t+1<NT));       ENDW(t);   RESC(); ROT();
    STEP(pA0,pA1,pB0,pB1,t+1,(t+4<NT),(t+2<NT),(t+2<NT));     ENDW(t+1); RESC(); ROT();
  }
  STEP(pB0,pB1,pA0,pA1,NT-1,false,false,false); RESC();
  { float sacc=pB0[0]+pB0[1]; _Pragma("unroll") for(int r=2;r<16;++r)sacc+=pB0[r]; _Pragma("unroll") for(int r=0;r<16;++r)sacc+=pB1[r]; l_reg+=sacc;
    pw0=(u32x4){PKW(pB0,0),PKW(pB0,2),PKW(pB0,4),PKW(pB0,6)};pw1=(u32x4){PKW(pB0,8),PKW(pB0,10),PKW(pB0,12),PKW(pB0,14)};pw2=(u32x4){PKW(pB1,0),PKW(pB1,2),PKW(pB1,4),PKW(pB1,6)};pw3=(u32x4){PKW(pB1,8),PKW(pB1,10),PKW(pB1,12),PKW(pB1,14)};
    SBAR(); { int lq_=lane; asm volatile("":"+v"(lq_)); const int vb0=(int)(lds0+LDS_V)+((lq_>>4)&1)*32+(lq_&3)*8+(4*(lq_>>5)+((lq_&15)>>2))*64; pv(o,vb0+sl_cur,PAF(0),PAF(1),PAF(2),PAF(3)); } }
  #undef PKW
  #undef PAF
  #undef VFR
  #undef PIN
  #undef MX3
  #undef GAPA
  #undef GAPB
  #undef EX
  #undef VRD
  #undef KRD
  #undef STEP
  #undef ENDW
  {auto rr=__builtin_amdgcn_permlane32_swap(__float_as_uint(l_reg),__float_as_uint(l_reg),false,false);l_reg=__uint_as_float(rr[0])+__uint_as_float(rr[1]);}
  if(hi==0)wsf[32+r32]=l_reg;asm volatile("s_waitcnt lgkmcnt(0)":::"memory");
  float rli[16];
  #pragma unroll
  for(int r=0;r<16;++r)rli[r]=__builtin_amdgcn_rcpf(wsf[32+crow(r,hi)]);
  bf16*Ow=O+(rowbase+q0+wid*QBLK)*OP+h*D;
  { bf16*stg=(bf16*)(shm+LDS_OST)+wid*2048;
    #pragma unroll
    for(int r=0;r<16;++r){const int orow=crow(r,hi);
      #pragma unroll
      for(int d0=0;d0<2;++d0)stg[orow*64+d0*32+r32]=__float2bfloat16(o[d0][r]*rli[r]);}
    asm volatile("s_waitcnt lgkmcnt(0)":::"memory");
    #pragma unroll
    for(int i=0;i<4;++i){const int row=i*8+(lane>>3),ch=lane&7; const u32x4 v=*(const u32x4*)(stg+row*64+ch*8); ATTN_STORE16(Ow+(long)row*OP+ch*8,v);} }
  asm volatile("s_waitcnt lgkmcnt(0)\n\ts_barrier":::"memory");
  #undef DMA_K
  #undef DMA_V
  #undef CMASK
  #undef START
  #undef RESC
  #undef ROT
  #undef BP
  #undef EXM
  #undef MASKLD
}
constexpr int ATTN_LDS_BYTES=LDS_BYTES;
struct AttnTensors { const bf16* Q; const bf16* K; const bf16* V; bf16* O; const unsigned long long* MASKT; };
struct AttnUnit { int bh; int qb; };
struct StaticOrder {
  int vcu;
  __device__ __forceinline__ explicit StaticOrder(int grid,int block):vcu((block%8)*(grid/8)+block/8){}
  __device__ __forceinline__ bool next(int i,AttnUnit&u)const{ if(i>=2)return false; const int s=vcu&3; u.bh=vcu>>2; u.qb=(i==0)?7-s:s; return true; }
  __device__ __forceinline__ void a_ready(const AttnUnit&)const{}
  __device__ __forceinline__ void done(const AttnUnit&)const{}
};
template<class Sched,int THRL=8> __device__ __forceinline__ void attn_phase(char*lds,const AttnTensors&T,const Sched&S,const int wave_id){
  AttnUnit u;
  for(int i=0;S.next(i,u);++i){ S.a_ready(u); attn_unit<THRL>(u.bh/NHEAD,u.bh%NHEAD,u.qb,T.Q,T.K,T.V,T.O,T.MASKT,lds,wave_id); S.done(u); }
}
#undef SBAR
#undef WAIT_BAR
}


__global__ void __launch_bounds__(NWAVES * 64, 2) mk_fwd(Args args) {
    extern __shared__ __attribute__((aligned(16))) unsigned char lds[];
    Frame F;
    F.lds = (LAS unsigned char*)lds;
    F.MISC = (volatile LAS unsigned*)(F.lds + MISC_OFF);
    F.wave = __builtin_amdgcn_readfirstlane((int)threadIdx.x >> 6); F.lane = (int)__builtin_amdgcn_mbcnt_hi(~0u, __builtin_amdgcn_mbcnt_lo(~0u, 0u)); F.tid = F.wave * 64 + F.lane;
    F.G = gridDim.x; { const int bx = blockIdx.x; F.vcu = (F.G % 8 == 0) ? (bx % 8) * (F.G / 8) + bx / 8 : bx; }
    unsigned char* ws = args.ws;
    F.ctl = (gu32*)(ws + WS_CTL);
    for (int u = F.tid; u < (LDS_BYTES - LDSCTL_OFF) / 4; u += NWAVES * 64) ((LAS unsigned*)(F.lds + LDSCTL_OFF))[u] = 0u;
    __syncthreads();
    XcdBarrier bar = xcd_barrier_post((unsigned*)(F.ctl + CW_BAR) + args.li * XCD_BAR_WORDS, F.MISC + 8, F.wave);
    const int lo = args.ph_lo, hi = args.ph_hi;
#define IN(k) (lo <= (k) && (k) < hi)
#define BOTH(k) (IN(k) && IN((k) + 1))
#ifdef TS_SEL
    const unsigned long long ts0_ = rt();
#define GRID_BAR() do { xcd_barrier(bar); if (blockIdx.x == 0 && F.tid == 0) F.MISC[16 + (ts_n_++)] = (unsigned)(rt() - ts0_); } while (0)
    int ts_n_ = 0;
#else
#define GRID_BAR() xcd_barrier(bar)
#endif
    bf16* XB = (bf16*)(ws + WS_XB); bf16* MIX = (bf16*)(ws + WS_MIX); bf16* H = (bf16*)(ws + WS_H);
    float* sspA = (float*)(ws + WS_SSPA); float* sspB = (float*)(ws + WS_SSPB);
    float* cosH = (float*)(ws + WS_TAB); float* sinH = cosH + SEQ * 32; float* cosI = sinH + SEQ * 32; float* sinI = cosI + SEQ * 16;
    const float* x = args.in[0]; float* out = args.out;

    if (IN(0)) { p0_prologue(F, args);
#if PROBE_REP & 1
        GRID_BAR(); p0_prologue(F, args);
#endif
        if (BOTH(0)) GRID_BAR();
#ifdef PROBE_BARS
        for (int i_ = 0; i_ < PROBE_BARS; ++i_) GRID_BAR();
#endif
        }
    if (IN(1)) {
        {
        pg8::Gemm g{XB, (bf16*)(ws + WS_WGU1), M, NGU, D}; pg8::StaticOrder S; S.init(M, NGU, F.G, (int)blockIdx.x);
        pg8::EpiSwiGLU E{H, sspA, F.lds + RING_OFF + pg8::STAGE_BYTES};
        pg8::gemm_phase<pg8::EpiSwiGLU, pg8::StaticOrder, PG8_ALIGN, PG8_SP2>(F.lds + RING_OFF, g, S, E, F.wave);
#ifdef TS_SEL
        if (F.tid == 0 && blockIdx.x == 0) F.MISC[40] = (unsigned)(rt() - ts0_);
        if (F.tid == 0 && blockIdx.x == 200) ((gu32*)(ws + WS_CTL))[8192 + 0] = (unsigned)(rt() - ts0_);
#endif
        if (F.G == 256 && blockIdx.x >= 128) { weight_items(F, args, 1, ((int)blockIdx.x - 128) * NWAVES + F.wave, 128 * NWAVES); wpo_items(F, args, ((int)blockIdx.x - 128) * NWAVES + F.wave, 128 * NWAVES, 0, 1024); }
#ifdef TS_SEL
        asm volatile("s_waitcnt vmcnt(0)" ::: "memory");
        if (F.tid == 0 && blockIdx.x == 200) ((gu32*)(ws + WS_CTL))[8192 + 64] = (unsigned)(rt() - ts0_);
#endif
        }
#if PROBE_REP & (1 << 1)
        GRID_BAR();
        {
        pg8::Gemm g{XB, (bf16*)(ws + WS_WGU1), M, NGU, D}; pg8::StaticOrder S; S.init(M, NGU, F.G, (int)blockIdx.x);
        pg8::EpiSwiGLU E{H, sspA, F.lds + RING_OFF + pg8::STAGE_BYTES};
        pg8::gemm_phase<pg8::EpiSwiGLU, pg8::StaticOrder, PG8_ALIGN, PG8_SP2>(F.lds + RING_OFF, g, S, E, F.wave);
        }
#endif
        if (BOTH(1)) GRID_BAR();
    }
    if (IN(2)) {
        {
        pg8::Gemm g{H, (bf16*)(ws + WS_WD1), M, D, DFF}; pg8::StaticOrder S; S.init(M, D, F.G, (int)blockIdx.x);
        pg8::EpiResid<true, false, true> E{nullptr, nullptr, XB, sspA, 0.5f};
        pg8::gemm_phase<pg8::EpiResid<true, false, true>, pg8::StaticOrder, PG8_ALIGN, PG8_SP2>(F.lds + RING_OFF, g, S, E, F.wave);
#ifdef TS_SEL
        if (F.tid == 0) { const unsigned t_ = (unsigned)(rt() - ts0_); __hip_atomic_fetch_max((gu32*)(ws + WS_CTL) + 9216 + 128 * 1, 0x40000000u - t_, RLX_AGENT); __hip_atomic_fetch_max((gu32*)(ws + WS_CTL) + 9216 + 128 * 1 + 64, t_, RLX_AGENT); }
#endif

        }
#if PROBE_REP & (1 << 2)
        GRID_BAR();
        {
        pg8::Gemm g{H, (bf16*)(ws + WS_WD1), M, D, DFF}; pg8::StaticOrder S; S.init(M, D, F.G, (int)blockIdx.x);
        pg8::EpiResid<true, false, true> E{nullptr, nullptr, XB, sspA, 0.5f};
        pg8::gemm_phase<pg8::EpiResid<true, false, true>, pg8::StaticOrder, PG8_ALIGN, PG8_SP2>(F.lds + RING_OFF, g, S, E, F.wave);
        }
#endif
        if (BOTH(2)) GRID_BAR();
    }
    if (IN(3)) {
        {
        pg8::Gemm g{XB, (bf16*)(ws + WS_WIN), M, NIN, D}; pg8::StaticOrder S; S.init(M, NIN, F.G, (int)blockIdx.x);
        pg8::EpiInProj E{sspA, (bf16*)(ws + WS_Q), (bf16*)(ws + WS_K), (bf16*)(ws + WS_V), (bf16*)(ws + WS_U), (bf16*)(ws + WS_QI), (bf16*)(ws + WS_KI), (float*)(ws + WS_WI),
                         args.in[7], args.in[8], cosH, sinH, cosI, sinI, C2, F.lds + RING_OFF + pg8::STAGE_BYTES};
        pg8::gemm_phase<pg8::EpiInProj, pg8::StaticOrder, PG8_ALIGN, PG8_SP2>(F.lds + RING_OFF, g, S, E, F.wave);
#ifdef TS_SEL
        if (F.tid == 0 && blockIdx.x == 0) F.MISC[41] = (unsigned)(rt() - ts0_);
        if (F.tid == 0 && blockIdx.x == 200) ((gu32*)(ws + WS_CTL))[8192 + 128] = (unsigned)(rt() - ts0_);
#endif
        if (F.G == 256 && blockIdx.x >= 128) { weight_items(F, args, 2, ((int)blockIdx.x - 128) * NWAVES + F.wave, 128 * NWAVES); wpo_items(F, args, ((int)blockIdx.x - 128) * NWAVES + F.wave, 128 * NWAVES, 1024, 2048); }
#ifdef TS_SEL
        asm volatile("s_waitcnt vmcnt(0)" ::: "memory");
        if (F.tid == 0 && blockIdx.x == 200) ((gu32*)(ws + WS_CTL))[8192 + 192] = (unsigned)(rt() - ts0_);
#endif
        }
#if PROBE_REP & (1 << 3)
        GRID_BAR();
        {
        pg8::Gemm g{XB, (bf16*)(ws + WS_WIN), M, NIN, D}; pg8::StaticOrder S; S.init(M, NIN, F.G, (int)blockIdx.x);
        pg8::EpiInProj E{sspA, (bf16*)(ws + WS_Q), (bf16*)(ws + WS_K), (bf16*)(ws + WS_V), (bf16*)(ws + WS_U), (bf16*)(ws + WS_QI), (bf16*)(ws + WS_KI), (float*)(ws + WS_WI),
                         args.in[7], args.in[8], cosH, sinH, cosI, sinI, C2, F.lds + RING_OFF + pg8::STAGE_BYTES};
        pg8::gemm_phase<pg8::EpiInProj, pg8::StaticOrder, PG8_ALIGN, PG8_SP2>(F.lds + RING_OFF, g, S, E, F.wave);
        }
#endif
        if (BOTH(3)) GRID_BAR();
    }
    if (IN(4)) {
        {
        select_phase(F, (const bf16*)(ws + WS_QI), (const bf16*)(ws + WS_KI), (const float*)(ws + WS_WI), (unsigned long long*)(ws + WS_MASK), (const bf16*)(ws + WS_U), MIX);
        }
#if PROBE_REP & (1 << 4)
        GRID_BAR();
        {
        select_phase(F, (const bf16*)(ws + WS_QI), (const bf16*)(ws + WS_KI), (const float*)(ws + WS_WI), (unsigned long long*)(ws + WS_MASK), (const bf16*)(ws + WS_U), MIX);
        }
#endif
        if (BOTH(4)) GRID_BAR();
    }
    if (IN(5)) {
        {
        static_assert(attn_body::LDS_TOTAL <= LDSCTL_OFF, "attention LDS");
        const attn_body::AttnTensors AT{(const attn_body::bf16*)(ws + WS_Q), (const attn_body::bf16*)(ws + WS_K), (const attn_body::bf16*)(ws + WS_V), (attn_body::bf16*)MIX, (const unsigned long long*)(ws + WS_MASK)};
        const attn_body::StaticOrder S((int)F.G, (int)blockIdx.x);
        attn_body::attn_phase<attn_body::StaticOrder>((char*)lds + RING_OFF, AT, S, F.wave);
        }
#if PROBE_REP & (1 << 5)
        GRID_BAR();
        {
        static_assert(attn_body::LDS_TOTAL <= LDSCTL_OFF, "attention LDS");
        const attn_body::AttnTensors AT{(const attn_body::bf16*)(ws + WS_Q), (const attn_body::bf16*)(ws + WS_K), (const attn_body::bf16*)(ws + WS_V), (attn_body::bf16*)MIX, (const unsigned long long*)(ws + WS_MASK)};
        const attn_body::StaticOrder S((int)F.G, (int)blockIdx.x);
        attn_body::attn_phase<attn_body::StaticOrder>((char*)lds + RING_OFF, AT, S, F.wave);
        }
#endif
        if (BOTH(5)) GRID_BAR();
    }
    if (IN(6)) {
        pg8::Gemm g{MIX, (bf16*)(ws + WS_WOUT), M, D, D}; pg8::StaticOrder S; S.init(M, D, F.G, (int)blockIdx.x);
        pg8::EpiResid<true, false, true> E{nullptr, nullptr, XB, sspB, 1.0f};
        pg8::gemm_phase<pg8::EpiResid<true, false, true>, pg8::StaticOrder, PG8_ALIGN, PG8_SP2>(F.lds + RING_OFF, g, S, E, F.wave);
#if PROBE_REP & (1 << 6)
        GRID_BAR();
        { pg8::EpiResid<true, false, true> E2{nullptr, nullptr, (bf16*)(ws + 208 * MiB), (float*)(ws + 244 * MiB), 1.0f};
          pg8::gemm_phase<pg8::EpiResid<true, false, true>, pg8::StaticOrder, PG8_ALIGN, PG8_SP2>(F.lds + RING_OFF, g, S, E2, F.wave); }
#endif
        if (BOTH(6)) GRID_BAR();
    }
    if (IN(7)) {
        {
        pg8::Gemm g{XB, (bf16*)(ws + WS_WGU2), M, NGU, D}; pg8::StaticOrder S; S.init(M, NGU, F.G, (int)blockIdx.x);
        pg8::EpiSwiGLU E{H, sspB, F.lds + RING_OFF + pg8::STAGE_BYTES};
        pg8::gemm_phase<pg8::EpiSwiGLU, pg8::StaticOrder, PG8_ALIGN, PG8_SP2>(F.lds + RING_OFF, g, S, E, F.wave);
        if (F.G == 256 && blockIdx.x >= 128) weight_items(F, args, 3, ((int)blockIdx.x - 128) * NWAVES + F.wave, 128 * NWAVES);
        }
#if PROBE_REP & (1 << 7)
        GRID_BAR();
        {
        pg8::Gemm g{XB, (bf16*)(ws + WS_WGU2), M, NGU, D}; pg8::StaticOrder S; S.init(M, NGU, F.G, (int)blockIdx.x);
        pg8::EpiSwiGLU E{H, sspB, F.lds + RING_OFF + pg8::STAGE_BYTES};
        pg8::gemm_phase<pg8::EpiSwiGLU, pg8::StaticOrder, PG8_ALIGN, PG8_SP2>(F.lds + RING_OFF, g, S, E, F.wave);
        }
#endif
        if (BOTH(7)) GRID_BAR();
    }
    if (IN(8)) {
        {
        pg8::Gemm g{H, (bf16*)(ws + WS_WD2), M, D, DFF}; pg8::StaticOrder S; S.init(M, D, F.G, (int)blockIdx.x);
        pg8::EpiResid<true, true, false> E{nullptr, out, XB, nullptr, 0.5f};
        pg8::gemm_phase<pg8::EpiResid<true, true, false>, pg8::StaticOrder, PG8_ALIGN, PG8_SP2>(F.lds + RING_OFF, g, S, E, F.wave);
        }
#if PROBE_REP & (1 << 8)
        GRID_BAR();
        {
        pg8::Gemm g{H, (bf16*)(ws + WS_WD2), M, D, DFF}; pg8::StaticOrder S; S.init(M, D, F.G, (int)blockIdx.x);
        pg8::EpiResid<true, true, false> E{nullptr, out, XB, nullptr, 0.5f};
        pg8::gemm_phase<pg8::EpiResid<true, true, false>, pg8::StaticOrder, PG8_ALIGN, PG8_SP2>(F.lds + RING_OFF, g, S, E, F.wave);
        }
#endif
    }
#ifdef TS_SEL
    if (blockIdx.x == 0 && F.tid == 0) {
        const unsigned now = (unsigned)(rt() - ts0_);
        const unsigned v = (TS_SEL == 41) ? (__hip_atomic_load((gu32*)(ws + WS_CTL) + 9216 + 128 + 64, RLX_AGENT) - (0x40000000u - __hip_atomic_load((gu32*)(ws + WS_CTL) + 9216 + 128, RLX_AGENT))) : (TS_SEL == 30) ? F.MISC[41] : (TS_SEL == 31) ? __hip_atomic_load((gu32*)(ws + WS_CTL) + 8192 + 128, RLX_AGENT) : (TS_SEL == 32) ? __hip_atomic_load((gu32*)(ws + WS_CTL) + 8192 + 192, RLX_AGENT) : (TS_SEL == 20) ? F.MISC[40] : (TS_SEL == 21) ? __hip_atomic_load((gu32*)(ws + WS_CTL) + 8192, RLX_AGENT) : (TS_SEL == 22) ? __hip_atomic_load((gu32*)(ws + WS_CTL) + 8192 + 64, RLX_AGENT) : (TS_SEL >= 8) ? now : F.MISC[16 + TS_SEL];
        asm volatile("s_waitcnt vmcnt(0)" ::: "memory");
        out[0] += (float)v * 0.01f * TS_SCALE;
    }
#endif
#undef IN
#undef BOTH
}

extern "C" void kernel_launch(void* const* d_in, const int* in_sizes, int n_in, void* d_out, int out_size, void* d_ws, size_t ws_size, hipStream_t stream) {
    static int grid = 0;
    if (grid == 0) {
        if (n_in != 16 || out_size != M * D || ws_size < WS_END) { fprintf(stderr, "kernel_launch: unexpected shapes (n_in %d out %d ws %zu)\n", n_in, out_size, ws_size); grid = -1; return; }
        int dev = 0, cus = 0, per_cu = 0;
        if (hipGetDevice(&dev) != hipSuccess || hipDeviceGetAttribute(&cus, hipDeviceAttributeMultiprocessorCount, dev) != hipSuccess) { grid = -1; return; }
        if (hipFuncSetAttribute((const void*)mk_fwd, hipFuncAttributeMaxDynamicSharedMemorySize, LDS_BYTES) != hipSuccess) { fprintf(stderr, "kernel_launch: hipFuncSetAttribute failed\n"); grid = -1; return; }
        if (hipOccupancyMaxActiveBlocksPerMultiprocessor(&per_cu, (const void*)mk_fwd, NWAVES * 64, LDS_BYTES) != hipSuccess || per_cu < 1) fprintf(stderr, "kernel_launch: occupancy query reports %d\n", per_cu);
        (void)hipGetLastError();
        grid = cus;
        if (cus != 256) { fprintf(stderr, "kernel_launch: this kernel is laid out for 256 CUs (MI355X); found %d; nothing launched\n", cus); grid = -1; return; }
    }
    if (grid < 0) return;
    (void)hipMemsetAsync((char*)d_ws + WS_CTL, 0, CTL_ZERO_BYTES, stream);
    Args a{};
    for (int i = 0; i < 16; ++i) a.in[i] = (const float*)d_in[i];
    a.out = (float*)d_out; a.ws = (unsigned char*)d_ws;
    a.ph_lo = 0; a.ph_hi = 9; a.li = 0;
    void* kargs[] = {(void*)&a};
    hipError_t le = hipLaunchCooperativeKernel((const void*)mk_fwd, dim3(grid), dim3(NWAVES * 64), kargs, LDS_BYTES, stream);
    if (le != hipSuccess) { fprintf(stderr, "kernel_launch: cooperative launch failed: %s (grid %d); falling back to a plain launch\n", hipGetErrorString(le), grid); (void)hipGetLastError();
        hipLaunchKernelGGL(mk_fwd, dim3(grid), dim3(NWAVES * 64), LDS_BYTES, stream, a); }
}
```

```cpp
#include <hip/hip_runtime.h>
#include <cstdio>
#include <cstdint>
#include <math.h>
namespace pg8 {
#define PG8_LAS __attribute__((address_space(3)))
typedef unsigned short bf16_t;
typedef short bf16x8 __attribute__((ext_vector_type(8)));
typedef float f32x4 __attribute__((ext_vector_type(4)));
typedef unsigned u32x4 __attribute__((ext_vector_type(4)));
constexpr int BM = 256, BK = 64, HALF = 128, HTB = HALF * BK * 2  , STAGE_BYTES = 8 * HTB, NXCD = 8, WGM = 8;

__host__ __device__ __forceinline__ int lds_byte(int r, int c) { const int st = (r >> 4) * 2 + (c >> 5), rr = r & 15, cc = c & 31, ob = rr * 64 + cc * 2; return st * 1024 + (ob ^ (((ob >> 9) & 1) << 5)); }
__host__ __device__ __forceinline__ void stage_rc(int b, int& R, int& C) { const int st = b / 1024, sb = b % 1024, swz = sb ^ (((sb >> 9) & 1) << 5); R = (st >> 1) * 16 + swz / 64; C = (st & 1) * 32 + (swz % 64) / 2; }
__host__ __device__ __forceinline__ int perm32(int rho) { const int n = rho >> 4, i = rho & 15; return 8 * (i >> 2) + 4 * n + (i & 3); }

__device__ __forceinline__ int lane_id_now() { int l; asm volatile("v_mbcnt_lo_u32_b32 %0, -1, 0\n\tv_mbcnt_hi_u32_b32 %0, -1, %0" : "=v"(l)); return l; }
struct Unit { int pm, pn; };
struct Gemm { const bf16_t* A; const bf16_t* Bt; int M, N, K; };

struct StaticOrder {
    int nM, nN, nwg, G, c;
    __host__ __device__ void init(int M, int N, int G_, int c_) { nM = M / BM; nN = N / BM; nwg = nM * nN; G = G_; c = c_; }
    __host__ __device__ bool next(int i, Unit& u) const {
        const long L = (long)i * G + c; if (L >= nwg) return false;
        int wgid = (int)L; { const int q = nwg / NXCD, r = nwg % NXCD, xcd = wgid % NXCD, off = wgid / NXCD; wgid = (xcd < r ? xcd * (q + 1) : r * (q + 1) + (xcd - r) * q) + off; }
        const int nig = WGM * nN, gid = wgid / nig, fm = gid * WGM, gsz = (nM - fm) < WGM ? (nM - fm) : WGM;
        u.pm = fm + ((wgid % nig) % gsz); u.pn = (wgid % nig) / gsz; return true;
    }
    __device__ __forceinline__ void a_ready(const Unit&) const {}
    __device__ __forceinline__ void done(const Unit&) const {}
};


__device__ __forceinline__ unsigned cvt_pk_bf16(float lo, float hi) { unsigned r; asm volatile("v_cvt_pk_bf16_f32 %0, %1, %2" : "=v"(r) : "v"(lo), "v"(hi)); return r; }
typedef float f32x2 __attribute__((ext_vector_type(2)));

typedef float f32x2 __attribute__((ext_vector_type(2)));
__device__ __forceinline__ float fq_sum(float s) {
    { auto r = __builtin_amdgcn_permlane16_swap(__float_as_uint(s), __float_as_uint(s), false, false); s = __uint_as_float(r[0]) + __uint_as_float(r[1]); }
    { auto r = __builtin_amdgcn_permlane32_swap(__float_as_uint(s), __float_as_uint(s), false, false); s = __uint_as_float(r[0]) + __uint_as_float(r[1]); }
    return s;
}
__device__ __forceinline__ float rrow(const float* ssp, int row, int fq) {
    const f32x4 p = *(const f32x4*)(ssp + (size_t)row * 16 + 4 * fq);
    float s = (p[0] + p[1]) + (p[2] + p[3]);
    s = fq_sum(s);
    return __builtin_amdgcn_rsqf(s * (1.0f / 1024.0f) + 1e-6f);
}
__device__ __forceinline__ float msrow_lds(const PG8_LAS unsigned char* pf, int lrow, int fq) {
    const f32x4 p = *(const PG8_LAS f32x4*)(pf + lrow * 64 + fq * 16);
    float s = (p[0] + p[1]) + (p[2] + p[3]);
    s = fq_sum(s);
    return s * (1.0f / 1024.0f) + 1e-6f;
}
__device__ __forceinline__ float rrow_lds(const PG8_LAS unsigned char* pf, int lrow, int fq) { return __builtin_amdgcn_rsqf(msrow_lds(pf, lrow, fq)); }
__device__ __forceinline__ void ssp_prefetch(const float* ssp, int pm, PG8_LAS unsigned char* pf, int wid, int kp) {
    const char* sbase = (const char*)(ssp + (size_t)pm * (BM * 16)) + wid * 2048 + (kp & 7) * 256;
    const unsigned dst = (unsigned)(unsigned long)pf + (unsigned)wid * 2048u + (unsigned)(kp & 7) * 256u;
    unsigned keep, off;
    asm volatile("s_mov_b32 %0, m0\n\tv_mbcnt_lo_u32_b32 %1, -1, 0\n\tv_mbcnt_hi_u32_b32 %1, -1, %1\n\tv_lshlrev_b32_e32 %1, 2, %1\n\ts_mov_b32 m0, %2\n\ts_nop 4\n\t"
                 "global_load_lds_dword %1, %3\n\ts_mov_b32 m0, %0"
                 : "=&s"(keep), "=&v"(off) : "s"(dst), "s"(sbase) : "memory");
}
__device__ __forceinline__ f32x4 silu_mul(f32x4 g, f32x4 u, float c1, float ir2) {
    f32x4 o;
#pragma unroll
    for (int e = 0; e < 4; ++e) { const float t = __builtin_amdgcn_exp2f(g[e] * c1); o[e] = (g[e] * u[e]) * __builtin_amdgcn_rcpf(__builtin_fmaf(t, ir2, ir2)); }
    return o;
}
__device__ __forceinline__ u32x4 pack8(f32x4 a, f32x4 b) { u32x4 w; w.x = cvt_pk_bf16(a[0], a[1]); w.y = cvt_pk_bf16(a[2], a[3]); w.z = cvt_pk_bf16(b[0], b[1]); w.w = cvt_pk_bf16(b[2], b[3]); return w; }
__device__ __forceinline__ float dot4(f32x4 a) { return (a[0] * a[0] + a[1] * a[1]) + (a[2] * a[2] + a[3] * a[3]); }

struct EpiSwiGLU {
    static constexpr bool PERM = true, AFTER_DRAIN = false; static constexpr int NPF = 1;
    bf16_t* H; const float* ssp; PG8_LAS unsigned char* pf;
    __device__ __forceinline__ void prefetch(const Unit& u, int wid, int kp) const { ssp_prefetch(ssp, u.pm, pf, wid, kp); }
    __device__ __forceinline__ void operator()(const f32x4 (&acc)[2][2][4][2], const Unit& u, int wr, int wc, int fr, int fq) const {
        const int row0 = u.pm * BM + wr * 64 + fr, hc0 = u.pn * 128 + wc * 32 + 8 * fq;
        float rs[2][4];
#pragma unroll
        for (int ai = 0; ai < 2; ++ai)
#pragma unroll
            for (int m = 0; m < 4; ++m) rs[ai][m] = msrow_lds(pf, wr * 64 + fr + ai * HALF + m * 16, fq);
#pragma unroll
        for (int ai = 0; ai < 2; ++ai)
#pragma unroll
            for (int m = 0; m < 4; ++m) {
                const int row = row0 + ai * HALF + m * 16; const float ir2 = rs[ai][m], c1 = __builtin_amdgcn_rsqf(ir2) * -1.4426950408889634f;
                const f32x4 h0 = silu_mul(acc[ai][0][m][0], acc[ai][1][m][0], c1, ir2), h1 = silu_mul(acc[ai][0][m][1], acc[ai][1][m][1], c1, ir2);
                *(u32x4*)(H + (size_t)row * 2816 + hc0) = pack8(h0, h1);
            }
    }
};
template <bool RB, bool OF, bool WB>
struct EpiResid {
    static constexpr bool PERM = true, AFTER_DRAIN = false; static constexpr int NPF = 0;
    const float* R; float* OUT; bf16_t* XB; float* ssp; float alpha;
    __device__ __forceinline__ void operator()(const f32x4 (&acc)[2][2][4][2], const Unit& u, int wr, int wc, int fr, int fq) const {
        const int row0 = u.pm * BM + wr * 64 + fr, c0 = u.pn * BM + wc * 32 + 8 * fq;
#pragma unroll
        for (int ai = 0; ai < 2; ++ai) {
            f32x4 rv[4][2][2];
#pragma unroll
            for (int m = 0; m < 4; ++m)
#pragma unroll
                for (int bj = 0; bj < 2; ++bj) {
                    const size_t off = (size_t)(row0 + ai * HALF + m * 16) * 1024 + c0 + bj * HALF;
                    if (RB) { const u32x4 w = *(const u32x4*)(XB + off);
                        rv[m][bj][0] = (f32x4){__uint_as_float(w.x << 16), __uint_as_float(w.x & 0xffff0000u), __uint_as_float(w.y << 16), __uint_as_float(w.y & 0xffff0000u)};
                        rv[m][bj][1] = (f32x4){__uint_as_float(w.z << 16), __uint_as_float(w.z & 0xffff0000u), __uint_as_float(w.w << 16), __uint_as_float(w.w & 0xffff0000u)}; }
                    else { rv[m][bj][0] = *(const f32x4*)(R + off); rv[m][bj][1] = *(const f32x4*)(R + off + 4); }
                }
            asm volatile("" ::: "memory");
#pragma unroll
            for (int m = 0; m < 4; ++m) {
                const int row = row0 + ai * HALF + m * 16; float ss = 0.f;
#pragma unroll
                for (int bj = 0; bj < 2; ++bj) {
                    const size_t off = (size_t)row * 1024 + c0 + bj * HALF;
                    const f32x4 o0 = rv[m][bj][0] + acc[ai][bj][m][0] * alpha, o1 = rv[m][bj][1] + acc[ai][bj][m][1] * alpha;
                    if (OF) { *(f32x4*)(OUT + off) = o0; *(f32x4*)(OUT + off + 4) = o1; }
                    if (WB) { *(u32x4*)(XB + off) = pack8(o0, o1); ss += dot4(o0) + dot4(o1); }
                }
                if (WB) { ss = fq_sum(ss); if (fq == 0) ssp[(size_t)row * 16 + u.pn * 4 + wc] = ss; }
            }
            asm volatile("" ::: "memory");
        }
    }
};
struct EpiInProj {
    static constexpr bool PERM = true, AFTER_DRAIN = false; static constexpr int NPF = 1;
    const float* ssp; bf16_t *Q, *K, *V, *U, *QI, *KI; float* WI; const float *qn, *kn, *cosH, *sinH, *cosI, *sinI; float qscale; PG8_LAS unsigned char* pf;
    __device__ __forceinline__ void prefetch(const Unit& u, int wid, int kp) const { ssp_prefetch(ssp, u.pm, pf, wid, kp); }
    __device__ __forceinline__ void operator()(const f32x4 (&acc)[2][2][4][2], const Unit& u, int wr, int wc, int fr, int fq) const {
        const int row0 = u.pm * BM + wr * 64 + fr, pn = u.pn;
#define PG8_SEP(t) __builtin_assume_separate_storage(t, Q); __builtin_assume_separate_storage(t, K); __builtin_assume_separate_storage(t, V); __builtin_assume_separate_storage(t, U); \
        __builtin_assume_separate_storage(t, QI); __builtin_assume_separate_storage(t, KI); __builtin_assume_separate_storage(t, WI);
        PG8_SEP(ssp) PG8_SEP(qn) PG8_SEP(kn) PG8_SEP(cosH) PG8_SEP(sinH) PG8_SEP(cosI) PG8_SEP(sinI)
#undef PG8_SEP
        float rs[2][4];
#pragma unroll
        for (int ai = 0; ai < 2; ++ai)
#pragma unroll
            for (int m = 0; m < 4; ++m) rs[ai][m] = rrow_lds(pf, wr * 64 + fr + ai * HALF + m * 16, fq);
#pragma unroll
        for (int ai = 0; ai < 2; ++ai)
#pragma unroll
            for (int m = 0; m < 4; ++m) {
                const int row = row0 + ai * HALF + m * 16, pos = row & 2047; const float r = rs[ai][m];
                const f32x4 a00 = acc[ai][0][m][0] * r, a01 = acc[ai][0][m][1] * r, a10 = acc[ai][1][m][0] * r, a11 = acc[ai][1][m][1] * r;
                if (pn < 4) {
                    float ss = (dot4(a00) + dot4(a01)) + (dot4(a10) + dot4(a11));
                    ss = fq_sum(ss);
                    const float rh = __builtin_amdgcn_rsqf(ss * (1.0f / 64.0f) + 1e-6f);
                    const float* gp = (pn < 2) ? qn : kn;
                    const f32x4 g00 = *(const f32x4*)(gp + 8 * fq), g01 = *(const f32x4*)(gp + 8 * fq + 4), g10 = *(const f32x4*)(gp + 32 + 8 * fq), g11 = *(const f32x4*)(gp + 36 + 8 * fq);
                    const f32x4 x1a = a00 * rh * g00, x1b = a01 * rh * g01, x2a = a10 * rh * g10, x2b = a11 * rh * g11;
                    const f32x4 ca = *(const f32x4*)(cosH + pos * 32 + 8 * fq), cb = *(const f32x4*)(cosH + pos * 32 + 8 * fq + 4);
                    const f32x4 sa = *(const f32x4*)(sinH + pos * 32 + 8 * fq), sb = *(const f32x4*)(sinH + pos * 32 + 8 * fq + 4);
                    const float sc = (pn < 2) ? qscale : 1.0f;
                    const f32x4 o1a = (x1a * ca - x2a * sa) * sc, o1b = (x1b * cb - x2b * sb) * sc, o2a = (x2a * ca + x1a * sa) * sc, o2b = (x2b * cb + x1b * sb) * sc;
                    if (pn < 2) { bf16_t* dst = Q + (size_t)row * 512 + ((pn & 1) * 4 + wc) * 64 + 8 * fq; *(u32x4*)dst = pack8(o1a, o1b); *(u32x4*)(dst + 32) = pack8(o2a, o2b); }
                    else {
                        bf16_t* dst = K + ((size_t)((row >> 11) * 8 + (pn & 1) * 4 + wc) * 32 + (pos >> 6)) * 4096 + (pos & 63) * 8 + fq * 512;
                        *(u32x4*)dst = pack8(o1a, o1b); *(u32x4*)(dst + 4 * 512) = pack8(o2a, o2b); }
                } else if (pn < 8) {
                    if (pn >= 6) { bf16_t* dst = U + (size_t)row * 512 + (pn & 1) * 256 + wc * 32 + 8 * fq; *(u32x4*)dst = pack8(a00, a01); *(u32x4*)(dst + 128) = pack8(a10, a11); }
                    else {
                        const int col = (pn & 1) * 256 + wc * 32, hd = col >> 6, ch = (col >> 5) & 1;
                        bf16_t* dst = V + ((size_t)((row >> 11) * 8 + hd) * 32 + (pos >> 6)) * 4096 + (ch * 4 + ((pos & 63) >> 4)) * 512 + ((pos & 15) * 4 + fq) * 8;
                        *(u32x4*)dst = pack8(a00, a01); *(u32x4*)(dst + (size_t)2 * 32 * 4096) = pack8(a10, a11); }
                } else if (pn == 8 || wc == 0) {
                    const int tq = (fq & 1) * 8;
                    f32x4 ca = *(const f32x4*)(cosI + pos * 16 + tq), cb = *(const f32x4*)(cosI + pos * 16 + tq + 4);
                    f32x4 sa = *(const f32x4*)(sinI + pos * 16 + tq), sb = *(const f32x4*)(sinI + pos * 16 + tq + 4);
                    if (fq >= 2) { ca = (f32x4){1.f, 1.f, 1.f, 1.f}; cb = ca; sa = (f32x4){0.f, 0.f, 0.f, 0.f}; sb = sa; }
                    const f32x4 o1a = a00 * ca - a10 * sa, o1b = a01 * cb - a11 * sb, o2a = a10 * ca + a00 * sa, o2b = a11 * cb + a01 * sb;
                    const int d1 = 8 * fq + ((fq >= 2) ? 16 : 0);
                    if (pn == 8) { bf16_t* dst = QI + (size_t)row * 256 + wc * 64 + d1; *(u32x4*)dst = pack8(o1a, o1b); *(u32x4*)(dst + 16) = pack8(o2a, o2b); }
                    else {
                        const int d2 = d1 + 16; bf16_t* tb = KI + (size_t)(row >> 4) * 1024 + (row & 15) * 8;
                        *(u32x4*)(tb + ((d1 >> 5) * 4 + ((d1 & 31) >> 3)) * 128) = pack8(o1a, o1b); *(u32x4*)(tb + ((d2 >> 5) * 4 + ((d2 & 31) >> 3)) * 128) = pack8(o2a, o2b); }
                } else if (wc == 1) {
                    if (fq == 0) *(f32x4*)(WI + (size_t)row * 4) = a00 * 0.0625f;
                }
            }
    }
};
template <class Epi, class Sched, bool ALIGN_EPI = false, bool SP2 = false>
__device__ __forceinline__ void gemm_phase(PG8_LAS unsigned char* lds, const Gemm g, const Sched& S, const Epi& E, const int wave_id) {
    const int lane_ = lane_id_now();
    const int wid = wave_id, lane = lane_, tid = wid * 64 + lane,     wr = wid >> 2, wc = wid & 3, fr = lane & 15, fq = lane >> 4;
    const int K = g.K, nt = K / BK;
    unsigned voffA[2], voffB[2];
#pragma unroll
    for (int i = 0; i < 2; ++i) { int R, C; stage_rc(tid * 16 + i * 8192, R, C); const int Rb = Epi::PERM ? ((R & ~31) + perm32(R & 31)) : R;
        voffA[i] = (unsigned)(R * K + C) * 2u; voffB[i] = (unsigned)(Rb * K + C) * 2u; }
    const size_t kstep = (size_t)(BK * 2);
    const size_t hstep = (size_t)HALF * K * 2;
    const size_t tstep = 2 * hstep;
    const unsigned ldsw = (unsigned)wid * 1024u;
    const int aoff = lds_byte(wr * 64 + fr, fq * 8), boff = lds_byte(wc * 32 + fr, fq * 8);
#define PG8_SA(b, h) (((b) * 2 + (h)) * HTB)
#define PG8_SB(b, h) ((4 + (b) * 2 + (h)) * HTB)
#define PG8_STAGE(bufoff, gbase, voff) do { _Pragma("unroll") for (int _i = 0; _i < 2; ++_i) \
        __builtin_amdgcn_global_load_lds((const unsigned*)((const char*)(gbase) + (voff)[_i]), (PG8_LAS unsigned*)(lds + (bufoff) + ldsw + _i * 8192), 16, 0, 0); } while (0)
#define PG8_LDA(dst, b, h) do { _Pragma("unroll") for (int m = 0; m < 4; ++m) _Pragma("unroll") for (int k = 0; k < 2; ++k) dst[m][k] = *(const PG8_LAS bf16x8*)(lds + PG8_SA(b, h) + aoff + m * 2048 + k * 1024); } while (0)
#define PG8_LDB(dst, b, h) do { _Pragma("unroll") for (int n = 0; n < 2; ++n) _Pragma("unroll") for (int k = 0; k < 2; ++k) dst[n][k] = *(const PG8_LAS bf16x8*)(lds + PG8_SB(b, h) + boff + n * 2048 + k * 1024); } while (0)
#define PG8_MMA(ai, bj, At, Bt) do { __builtin_amdgcn_s_setprio(1); _Pragma("unroll") for (int m = 0; m < 4; ++m) _Pragma("unroll") for (int n = 0; n < 2; ++n) _Pragma("unroll") for (int k = 0; k < 2; ++k) \
        acc[ai][bj][m][n] = __builtin_amdgcn_mfma_f32_16x16x32_bf16(Bt[n][k], At[m][k], acc[ai][bj][m][n], 0, 0, 0); __builtin_amdgcn_s_setprio(0); } while (0)
#define PG8_MMA0(ai, bj, At, Bt) do { __builtin_amdgcn_s_setprio(1); _Pragma("unroll") for (int m = 0; m < 4; ++m) _Pragma("unroll") for (int n = 0; n < 2; ++n) { \
        acc[ai][bj][m][n] = __builtin_amdgcn_mfma_f32_16x16x32_bf16(Bt[n][0], At[m][0], (f32x4){0.f, 0.f, 0.f, 0.f}, 0, 0, 0); \
        acc[ai][bj][m][n] = __builtin_amdgcn_mfma_f32_16x16x32_bf16(Bt[n][1], At[m][1], acc[ai][bj][m][n], 0, 0, 0); } __builtin_amdgcn_s_setprio(0); } while (0)
#define PG8_WAIT_V(n) asm volatile("s_waitcnt vmcnt(" #n ")" ::: "memory")
#define PG8_WAIT_L(n) asm volatile("s_waitcnt lgkmcnt(" #n ")" ::: "memory")
#define PG8_BAR __builtin_amdgcn_s_barrier()
#define PG8_SCHED __builtin_amdgcn_sched_barrier(0)
    Unit cur, nxt; int ui = 0;
    if (!S.next(0, cur)) return;
    static_assert(SP2, "only the two-super-phase K-loop is kept here");
    f32x4 acc[2][2][4][2];
    bf16x8 At[4][2], B0[2][2], B1[2][2];
    const char* cA = (const char*)g.A + (size_t)cur.pm * tstep; const char* cB = (const char*)g.Bt + (size_t)cur.pn * tstep;
    S.a_ready(cur);
    if constexpr (SP2) {
        PG8_STAGE(PG8_SB(0, 0), cB, voffB); PG8_STAGE(PG8_SB(0, 1), cB + hstep, voffB); PG8_STAGE(PG8_SA(0, 0), cA, voffA); PG8_STAGE(PG8_SA(0, 1), cA + hstep, voffA);
        if (wr == 1) PG8_BAR;
        PG8_WAIT_V(2); PG8_BAR;
        PG8_STAGE(PG8_SB(1, 0), cB + kstep, voffB); PG8_STAGE(PG8_SA(1, 0), cA + kstep, voffA); PG8_STAGE(PG8_SB(1, 1), cB + hstep + kstep, voffB);
        PG8_WAIT_V(6); PG8_BAR;
    } else {
        PG8_STAGE(PG8_SB(0, 0), cB, voffB); PG8_STAGE(PG8_SA(0, 0), cA, voffA); PG8_STAGE(PG8_SB(0, 1), cB + hstep, voffB); PG8_STAGE(PG8_SA(0, 1), cA + hstep, voffA);
        if (wr == 1) PG8_BAR;
        PG8_WAIT_V(4); PG8_BAR;
        PG8_STAGE(PG8_SB(1, 0), cB + kstep, voffB); PG8_STAGE(PG8_SA(1, 0), cA + kstep, voffA); PG8_STAGE(PG8_SB(1, 1), cB + hstep + kstep, voffB);
        PG8_WAIT_V(6); PG8_BAR;
    }
    for (;;) {
        const bool has_next = S.next(ui + 1, nxt);
        const char* nA = has_next ? (const char*)g.A + (size_t)nxt.pm * tstep : cA; const char* nB = has_next ? (const char*)g.Bt + (size_t)nxt.pn * tstep : cB;
#define PG8_KPAIR(MMAF) do { \
            const bool last = (t == nt - 2); \
            const char* a1 = cA + (size_t)(t + 1) * kstep; \
            const char* a2 = last ? nA : cA + (size_t)(t + 2) * kstep; const char* b2 = last ? nB : cB + (size_t)(t + 2) * kstep; \
            const char* a3 = a2 + kstep; const char* b3 = b2 + kstep; \
            if (last && has_next) S.a_ready(nxt); \
            PG8_LDB(B0, 0, 0); PG8_LDB(B1, 0, 1); PG8_SCHED; PG8_LDA(At, 0, 0); PG8_STAGE(PG8_SA(1, 1), a1 + hstep, voffA); \
            PG8_WAIT_V(8); PG8_WAIT_L(0); PG8_BAR; MMAF(0, 0, At, B0); MMAF(0, 1, At, B1); PG8_BAR; PG8_SCHED; \
            PG8_LDA(At, 0, 1); \
            if constexpr (Epi::NPF > 0) { static_assert(Epi::NPF == 1, "wait counts below"); E.prefetch(cur, wid, t >> 1); } \
            PG8_STAGE(PG8_SB(0, 0), b2, voffB); PG8_STAGE(PG8_SB(0, 1), b2 + hstep, voffB); PG8_STAGE(PG8_SA(0, 0), a2, voffA); \
            if constexpr (Epi::NPF > 0) PG8_WAIT_V(9); else PG8_WAIT_V(8); \
            PG8_WAIT_L(0); PG8_BAR; MMAF(1, 0, At, B0); MMAF(1, 1, At, B1); PG8_BAR; PG8_SCHED; \
            PG8_LDB(B0, 1, 0); PG8_LDB(B1, 1, 1); PG8_SCHED; PG8_LDA(At, 1, 0); PG8_STAGE(PG8_SA(0, 1), a2 + hstep, voffA); \
            if constexpr (Epi::NPF > 0) PG8_WAIT_V(9); else PG8_WAIT_V(8); \
            PG8_WAIT_L(0); PG8_BAR; PG8_MMA(0, 0, At, B0); PG8_MMA(0, 1, At, B1); PG8_BAR; PG8_SCHED; \
            PG8_LDA(At, 1, 1); PG8_STAGE(PG8_SB(1, 0), b3, voffB); PG8_STAGE(PG8_SB(1, 1), b3 + hstep, voffB); PG8_STAGE(PG8_SA(1, 0), a3, voffA); \
            PG8_WAIT_V(8); PG8_WAIT_L(0); PG8_BAR; PG8_MMA(1, 0, At, B0); PG8_MMA(1, 1, At, B1); PG8_BAR; PG8_SCHED; } while (0)
        { const int t = 0; PG8_KPAIR(PG8_MMA0); }
#pragma unroll 1
        for (int t = 2; t < nt; t += 2) PG8_KPAIR(PG8_MMA);
#undef PG8_KPAIR
        if constexpr (ALIGN_EPI) { if (wr == 0) PG8_BAR; }
        if constexpr (!Epi::AFTER_DRAIN) { int fr_ = fr, fq_ = fq; asm volatile("" : "+v"(fr_), "+v"(fq_));
            E(acc, cur, wr, wc, fr_, fq_); S.done(cur); }
        if (!has_next) break;
        cur = nxt; cA = nA; cB = nB; ++ui;
        if constexpr (ALIGN_EPI) { if (wr == 1) PG8_BAR; }
    }
    PG8_WAIT_V(0);
    if constexpr (!ALIGN_EPI) { if (wr == 0) PG8_BAR; }
    PG8_BAR;
    if constexpr (Epi::AFTER_DRAIN) { E.fused(acc, cur, wr, wc, fr, fq, lds, wid, lane); S.done(cur); }
#undef PG8_SA
#undef PG8_SB
#undef PG8_STAGE
#undef PG8_LDA
#undef PG8_LDB
#undef PG8_MMA
#undef PG8_MMA0
#undef PG8_WAIT_V
#undef PG8_WAIT_L
#undef PG8_BAR
#undef PG8_SCHED
}
}


#ifndef PG8_SP2
#define PG8_SP2 true
#endif
#ifndef PG8_ALIGN
#define PG8_ALIGN true
#endif

#ifndef PROBE_REP
#define PROBE_REP 0
#endif
#define TS_SCALE 0.01f
constexpr int NWAVES = 8;
constexpr int BATCH = 8, SEQ = 2048, D = 1024, M = BATCH * SEQ, DFF = 2816, NGU = 2 * DFF, NIN = 2560, INC = 2372;
constexpr size_t MiB = 1u << 20;
constexpr size_t WS_CTL = 0, CTL_ZERO_BYTES = 64 * 1024;
constexpr size_t WS_SSPA = 2 * MiB, WS_SSPB = 3 * MiB;
constexpr size_t WS_TAB = 4 * MiB;
constexpr size_t WS_WI = 5 * MiB;
constexpr size_t WS_MASK = 6 * MiB;
constexpr size_t WS_WGU1 = 10 * MiB, WS_WD1 = 21 * MiB, WS_WIN = 27 * MiB, WS_WOUT = 32 * MiB, WS_WGU2 = 34 * MiB, WS_WD2 = 45 * MiB;
constexpr size_t WS_XB = 52 * MiB;
constexpr size_t WS_MIX = 84 * MiB;
constexpr size_t WS_H = 116 * MiB;
constexpr size_t WS_Q = 116 * MiB, WS_K = 132 * MiB, WS_V = 148 * MiB, WS_U = 164 * MiB, WS_QI = 180 * MiB, WS_KI = 188 * MiB;
constexpr size_t WS_END = 204 * MiB;
constexpr int CW_BAR = 4096;
constexpr int RING_OFF = 0, RING_BYTES = 131072;
constexpr int LDS_BYTES = 163840;
constexpr int LDSCTL_OFF = LDS_BYTES - 1024, MISC_OFF = LDSCTL_OFF + 320;
constexpr float C2 = 0.125f * 1.4426950408889634f;

#define GAS __attribute__((address_space(1)))
#define LAS __attribute__((address_space(3)))
typedef unsigned short bf16;
typedef unsigned v4u __attribute__((ext_vector_type(4)));
typedef float f32x4 __attribute__((ext_vector_type(4)));
typedef short bf16x8 __attribute__((ext_vector_type(8)));
typedef GAS unsigned gu32;
typedef GAS unsigned long long gu64;
#define RLX_AGENT __ATOMIC_RELAXED, __HIP_MEMORY_SCOPE_AGENT
#define LDS_WAIT() asm volatile("s_waitcnt lgkmcnt(0)" ::: "memory")
#define VM_WAIT() asm volatile("s_waitcnt vmcnt(0)" ::: "memory")
__device__ __forceinline__ unsigned long long rt() { return __builtin_amdgcn_s_memrealtime(); }
__device__ __forceinline__ unsigned f2bf(float f) { unsigned u = __builtin_bit_cast(unsigned, f); return (u + 0x7fffu + ((u >> 16) & 1u)) >> 16; }
__device__ __forceinline__ unsigned pk2(float lo, float hi) { return f2bf(lo) | (f2bf(hi) << 16); }

#define XB_TMO      128
#define XB_XCNT(j)  (256  + 64 * (j))
#define XB_XSUB(j)  (1280 + 64 * (j))
#define XB_XGEN(j)  (2304 + 64 * (j))
#define XB_TOP      3328
#define XB_TOPGEN   3392
#define XCD_BAR_WORDS 3456
#define XB_SPIN_CAP (1u << 18)

__device__ __forceinline__ unsigned xb_ld(unsigned* p)              { return __hip_atomic_load(p, __ATOMIC_RELAXED, __HIP_MEMORY_SCOPE_AGENT); }
__device__ __forceinline__ unsigned xb_add(unsigned* p, unsigned v) { return __hip_atomic_fetch_add(p, v, __ATOMIC_RELAXED, __HIP_MEMORY_SCOPE_AGENT); }
__device__ __forceinline__ unsigned xb_xcc_id() { return (unsigned)__builtin_amdgcn_s_getreg((3 << 11) | 20) & 0xFu; }
#define XB_SPIN(cond, bar) do { unsigned _sp = 0; while (cond) { __builtin_amdgcn_s_sleep(1); \
    if ((++_sp & 255u) == 0u) { if (xb_ld(&(bar)[XB_TMO])) break; if (_sp > XB_SPIN_CAP) { atomicAdd(&(bar)[XB_TMO], 1u); break; } } } } while (0)

struct XcdBarrier {
    unsigned* bar; unsigned x; int leader;
    volatile LAS unsigned* st;
};

__device__ __forceinline__ bool xb_is_thread0(int leader) { return leader && pg8::lane_id_now() == 0; }
__device__ __forceinline__ XcdBarrier xcd_barrier_post(unsigned* bar, volatile LAS unsigned* st, int wave_id) {
    XcdBarrier b; b.bar = bar; b.x = xb_xcc_id(); b.st = st; b.leader = (wave_id == 0) ? 1 : 0;
    if (xb_is_thread0(b.leader)) (void)xb_add(&bar[XB_XCNT(b.x)], 1u);
    return b;
}
__device__ __forceinline__ void xcd_barrier_complete(unsigned* bar, unsigned x, unsigned& nloc, unsigned& nx) {
    const unsigned G = gridDim.x * gridDim.y * gridDim.z;
    unsigned sum, cnt, mine, sp = 0u;
    for (;;) {
        sum = 0u; cnt = 0u; mine = 0u;
#pragma unroll
        for (unsigned j = 0; j < 16; ++j) { const unsigned c = xb_ld(&bar[XB_XCNT(j)]); sum += c; cnt += (c > 0u) ? 1u : 0u; mine = (j == x) ? c : mine; }
        if (sum == G) break;
        __builtin_amdgcn_s_sleep(1);
        if ((++sp & 255u) == 0u) { if (xb_ld(&bar[XB_TMO])) break; if (sp > XB_SPIN_CAP) { atomicAdd(&bar[XB_TMO], 1u); break; } }
    }
    nloc = mine > 0u ? mine : 1u; nx = cnt > 0u ? cnt : 1u;
}

__device__ __forceinline__ void xcd_barrier(const XcdBarrier& b) {
    asm volatile("s_waitcnt vmcnt(0)" ::: "memory");
    __syncthreads();
    if (xb_is_thread0(b.leader)) {
        unsigned* bar = b.bar;
        __builtin_amdgcn_s_waitcnt(0);
        unsigned nloc = b.st[0], nx = b.st[1];
        if (nloc == 0u) { xcd_barrier_complete(bar, b.x, nloc, nx); b.st[0] = nloc; b.st[1] = nx; }
        const unsigned old = xb_add(&bar[XB_XSUB(b.x)], 1u);
        const unsigned gen = old / nloc;
        if (old + 1u == (gen + 1u) * nloc) {
            __builtin_amdgcn_fence(__ATOMIC_RELEASE, "agent");
            asm volatile("s_waitcnt vmcnt(0)" ::: "memory");
            const unsigned og = xb_add(&bar[XB_TOP], 1u);
            const unsigned tg = og / nx;
            if (og + 1u == (tg + 1u) * nx) xb_add(&bar[XB_TOPGEN], 1u);
            else XB_SPIN(xb_ld(&bar[XB_TOPGEN]) == tg, bar);
            __builtin_amdgcn_fence(__ATOMIC_ACQUIRE, "agent");
            xb_add(&bar[XB_XGEN(b.x)], 1u);
            asm volatile("s_waitcnt vmcnt(0)" ::: "memory");
        } else {
            XB_SPIN(xb_ld(&bar[XB_XGEN(b.x)]) == gen, bar);
            __builtin_amdgcn_fence(__ATOMIC_ACQUIRE, "agent");
            asm volatile("s_waitcnt vmcnt(0)" ::: "memory");
        }
    }
    __syncthreads();
}


struct Frame {
    LAS unsigned char* lds;
    volatile LAS unsigned* MISC;
    gu32* ctl;
    int tid, lane, wave;
    int vcu, G;
};
__device__ __forceinline__ float wave_sum(float v) {
#pragma unroll
    for (int o = 1; o < 64; o <<= 1) v += __shfl_xor(v, o);
    return v;
}
template <class Map>
__device__ __forceinline__ void transpose_item(const float* W, int K, int N, const float* gk, bf16* WT, int ldk, Map map, LAS float* scr, int item, int lane) {
    const int nblk = (N + 31) / 32, kb = item / nblk, nb = item % nblk, k0 = 64 * kb, n0 = 32 * nb;
    (void)K;
    float tv[32];
    { const int n = n0 + (lane & 31); const bool ok = n < N; const float* wp = W + (size_t)(k0 + (lane >> 5)) * N + (ok ? n : 0);
#pragma unroll
      for (int i = 0; i < 32; ++i) tv[i] = wp[(size_t)(2 * i) * N];
      if (gk) {
#pragma unroll
          for (int i = 0; i < 32; ++i) tv[i] *= gk[k0 + 2 * i + (lane >> 5)];
      }
#pragma unroll
      for (int i = 0; i < 32; ++i) scr[(2 * i + (lane >> 5)) * 33 + (lane & 31)] = ok ? tv[i] : 0.f; }
    LDS_WAIT(); asm volatile("" ::: "memory");
    const int c = lane & 7;
#pragma unroll
    for (int j = 0; j < 4; ++j) { const int nn = (lane >> 3) + 8 * j, n = n0 + nn; const LAS float* s = scr + (8 * c) * 33 + nn;
        if (n < N) { const int dst = map(n);
            v4u o; o.x = pk2(s[0 * 33], s[1 * 33]); o.y = pk2(s[2 * 33], s[3 * 33]); o.z = pk2(s[4 * 33], s[5 * 33]); o.w = pk2(s[6 * 33], s[7 * 33]);
            *(GAS v4u*)(WT + (size_t)dst * ldk + k0 + 8 * c) = o; } }
    LDS_WAIT(); asm volatile("" ::: "memory");
}
struct MapPlain { __device__ __forceinline__ int operator()(int n) const { return n; } };
struct MapGate { int add; __device__ __forceinline__ int operator()(int n) const { return 256 * (n >> 7) + (n & 127) + add; } };
__device__ __forceinline__ int idx_slot(int d) { return (d < 16) ? d : (d < 32) ? 128 + (d - 16) : (d < 48) ? 16 + (d - 32) : 128 + 16 + (d - 48); }
struct MapIn {
    __device__ __forceinline__ int operator()(int n) const {
        if (n < 1024) { const int kq = n >> 9, nn = n & 511, head = nn >> 6, d = nn & 63; return kq * 512 + 256 * (head >> 2) + 128 * (d >> 5) + 32 * (head & 3) + (d & 31); }
        if (n < 1536) return n;
        if (n < 1792) { const int nn = n - 1536, h = nn >> 6, d = nn & 63; return 2048 + 32 * h + idx_slot(d); }
        if (n < 1856) return 2304 + idx_slot(n - 1792);
        if (n < 1860) return 2304 + 32 + (n - 1856);
        return 1536 + (n - 1860);
    }
};

struct Args { const float* in[16]; float* out; unsigned char* ws; int ph_lo, ph_hi, li, pad; };

__device__ __forceinline__ void weight_items(Frame& F, const Args& a, int set, int gw, int NGW) {
    unsigned char* ws = a.ws;
    LAS float* scr = (LAS float*)(F.lds + RING_OFF + F.wave * 16384);
    const int lane = pg8::lane_id_now();
    const float *f1n = a.in[1], *f1g = a.in[2], *f1u = a.in[3], *f1d = a.in[4], *mixn = a.in[5], *win = a.in[6], *poolw = a.in[9], *pools = a.in[10], *wout = a.in[11],
                *f2n = a.in[12], *f2g = a.in[13], *f2u = a.in[14], *f2d = a.in[15];
    bf16* WGU1 = (bf16*)(ws + WS_WGU1); bf16* WD1 = (bf16*)(ws + WS_WD1); bf16* WIN = (bf16*)(ws + WS_WIN); bf16* WOUT = (bf16*)(ws + WS_WOUT); bf16* WGU2 = (bf16*)(ws + WS_WGU2); bf16* WD2 = (bf16*)(ws + WS_WD2);
    constexpr int I_G = (D / 64) * (DFF / 32), I_D = (DFF / 64) * (D / 32), I_IN = (D / 64) * ((INC + 31) / 32), I_O = (512 / 64) * (D / 32);
    if (set == 0) {
        for (int it = gw; it < 2 * I_G; it += NGW) {
            if (it < I_G) transpose_item(f1g, D, DFF, f1n, WGU1, D, MapGate{0}, scr, it, lane);
            else transpose_item(f1u, D, DFF, f1n, WGU1, D, MapGate{128}, scr, it - I_G, lane);
        }
    } else if (set == 2) {
        for (int it = gw; it < 2 * I_G; it += NGW) {
            if (it < I_G) transpose_item(f2g, D, DFF, f2n, WGU2, D, MapGate{0}, scr, it, lane);
            else transpose_item(f2u, D, DFF, f2n, WGU2, D, MapGate{128}, scr, it - I_G, lane);
        }
    } else if (set == 3) {
        for (int it = gw; it < I_D; it += NGW) transpose_item(f2d, DFF, D, nullptr, WD2, DFF, MapPlain{}, scr, it, lane);
    } else {
        for (int it = gw; it < I_D + I_IN + I_O; it += NGW) {
            int r = it;
            if (r < I_D) { transpose_item(f1d, DFF, D, nullptr, WD1, DFF, MapPlain{}, scr, r, lane); continue; } r -= I_D;
            if (r < I_IN) { transpose_item(win, D, INC, mixn, WIN, D, MapIn{}, scr, r, lane); continue; } r -= I_IN;
            transpose_item(wout, 512, D, nullptr, WOUT, D, MapPlain{}, scr, r, lane);
        }
    }
    if (set == 1) {
        for (int j = gw; j < 256; j += NGW) {
            const int bj = j >> 7, wc = (j >> 5) & 3, i = j & 31;
            const bool covered = (wc == 0) || (wc == 1 && bj == 0 && i < 4);
            if (!covered) { GAS v4u* o = (GAS v4u*)(WIN + (size_t)(2304 + j) * D) + lane; o[0] = (v4u){0u, 0u, 0u, 0u}; o[64] = (v4u){0u, 0u, 0u, 0u}; }
        }
    }
}
__device__ __forceinline__ void wpo_items(Frame& F, const Args& a, int gw, int NGW, int it_lo, int it_hi) {
    unsigned char* ws = a.ws; bf16* WOUT = (bf16*)(ws + WS_WOUT);
    LAS float* scr = (LAS float*)(F.lds + RING_OFF + F.wave * 16384);
    const int lane = pg8::lane_id_now(); const float *poolw = a.in[9], *pools = a.in[10], *wout = a.in[11];
#pragma unroll 1
    for (int it = it_lo + gw; it < it_hi; it += NGW) {
        const int g = it >> 9, nb = (it >> 5) & 15, cb = it & 31, n = nb * 64 + lane;
        float ac[4] = {0.f, 0.f, 0.f, 0.f};
        const float* pw = poolw + ((size_t)g * 128 + cb * 4) * 128;
        const float* wsrc = wout + (size_t)(512 + g * 128) * D + nb * 64; const float* psrc = pools + g * 128;
#pragma unroll 1
        for (int half = 0; half < 2; ++half) {
#pragma unroll
            for (int dd = 0; dd < 64; ++dd)
                __builtin_amdgcn_global_load_lds((const unsigned*)(wsrc + (size_t)(half * 64 + dd) * D) + lane, (LAS unsigned*)(scr + dd * 64), 4, 0, 0);
            asm volatile("s_waitcnt vmcnt(0)" ::: "memory");
#pragma unroll 8
            for (int dd = 0; dd < 64; ++dd) { const float w = scr[dd * 64 + lane] * psrc[half * 64 + dd];
#pragma unroll
                for (int cc = 0; cc < 4; ++cc) ac[cc] = fmaf(pw[cc * 128 + half * 64 + dd], w, ac[cc]); }
            LDS_WAIT(); asm volatile("" ::: "memory");
        }
        *(GAS unsigned long long*)(WOUT + (size_t)n * D + 512 + g * 128 + cb * 4) = (unsigned long long)pk2(ac[0], ac[1]) | ((unsigned long long)pk2(ac[2], ac[3]) << 32);
    }
}
__device__ __forceinline__ void p0_prologue(Frame& F, const Args& a) {
    unsigned char* ws = a.ws;
    const int gw = F.vcu * NWAVES + F.wave, NGW = F.G * NWAVES, lane = pg8::lane_id_now();
    const float* x = a.in[0];
    weight_items(F, a, 0, gw, NGW);
    if (F.G != 256) wpo_items(F, a, gw, NGW, 0, 2048);
    if (F.G != 256) { weight_items(F, a, 1, gw, NGW); weight_items(F, a, 2, gw, NGW); weight_items(F, a, 3, gw, NGW); }
    float* cosH = (float*)(ws + WS_TAB); float* sinH = cosH + SEQ * 32; float* cosI = sinH + SEQ * 32; float* sinI = cosI + SEQ * 16;
    for (int idx = gw * 64 + lane; idx < SEQ * 48; idx += NGW * 64) {
        if (idx < SEQ * 32) { const int p = idx >> 5, i = idx & 31; const float inv = (float)pow(10000.0, -(double)i / 32.0); const float ang = __fmul_rn((float)p, inv); cosH[idx] = (float)cos((double)ang); sinH[idx] = (float)sin((double)ang); }
        else { const int j = idx - SEQ * 32, p = j >> 4, i = j & 15; const float inv = (float)pow(10000.0, -(double)i / 16.0); const float ang = __fmul_rn((float)p, inv); cosI[j] = (float)cos((double)ang); sinI[j] = (float)sin((double)ang); }
    }
    bf16* XB = (bf16*)(ws + WS_XB); float* sspA = (float*)(ws + WS_SSPA);
    for (int m0 = gw; m0 < M; m0 += 4 * NGW) {
        f32x4 v[4][4]; float s[4];
#pragma unroll
        for (int q = 0; q < 4; ++q) { const GAS f32x4* xr = (const GAS f32x4*)(x + (size_t)(m0 + q * NGW) * D) + lane;
#pragma unroll
            for (int j = 0; j < 4; ++j) v[q][j] = xr[64 * j]; }
#pragma unroll
        for (int q = 0; q < 4; ++q) { float a = 0.f;
#pragma unroll
            for (int j = 0; j < 4; ++j) a += (v[q][j].x * v[q][j].x + v[q][j].y * v[q][j].y) + (v[q][j].z * v[q][j].z + v[q][j].w * v[q][j].w);
            s[q] = wave_sum(a); }
#pragma unroll
        for (int q = 0; q < 4; ++q) { const int m = m0 + q * NGW;
            GAS unsigned long long* o8 = (GAS unsigned long long*)(XB + (size_t)m * D) + lane;
#pragma unroll
            for (int j = 0; j < 4; ++j) o8[64 * j] = (unsigned long long)pk2(v[q][j].x, v[q][j].y) | ((unsigned long long)pk2(v[q][j].z, v[q][j].w) << 32);
            if (lane < 16) sspA[(size_t)m * 16 + lane] = (lane == 0) ? s[q] : 0.f; }
    }
}

#ifndef SEL_REP
#define SEL_REP 1
#endif
#ifndef SEL_ABL
#define SEL_ABL 1
#endif
#ifndef POOL_REP
#define POOL_REP 1
#endif
__device__ __forceinline__ int wave_sum_dpp(int v) {
    v += __builtin_amdgcn_update_dpp(0, v, 0x111, 0xf, 0xf, false);
    v += __builtin_amdgcn_update_dpp(0, v, 0x112, 0xf, 0xf, false);
    v += __builtin_amdgcn_update_dpp(0, v, 0x114, 0xf, 0xf, false);
    v += __builtin_amdgcn_update_dpp(0, v, 0x118, 0xf, 0xf, false);
    v += __builtin_amdgcn_update_dpp(0, v, 0x142, 0xa, 0xf, false);
    v += __builtin_amdgcn_update_dpp(0, v, 0x143, 0xc, 0xf, false);
    return __builtin_amdgcn_readlane(v, 63);
}
__device__ __forceinline__ void cnt4(int& na, int& nb, unsigned ka0, unsigned kb0, unsigned ka1, unsigned kb1, unsigned ca, unsigned cb) {
    unsigned long long s0, s1, s2;
    asm volatile("v_cmp_le_u32_e32 vcc, %9, %5\n\t"
                 "v_cmp_le_u32_e64 %2, %10, %6\n\t"
                 "v_cmp_le_u32_e64 %3, %9, %7\n\t"
                 "v_cmp_le_u32_e64 %4, %10, %8\n\t"
                 "v_addc_co_u32_e32 %0, vcc, 0, %0, vcc\n\t"
                 "v_addc_co_u32_e64 %1, %2, 0, %1, %2\n\t"
                 "v_addc_co_u32_e64 %0, %3, 0, %0, %3\n\t"
                 "v_addc_co_u32_e64 %1, %4, 0, %1, %4"
                 : "+v"(na), "+v"(nb), "=&s"(s0), "=&s"(s1), "=&s"(s2) : "v"(ka0), "v"(kb0), "v"(ka1), "v"(kb1), "s"(ca), "s"(cb) : "vcc");
}
template <int NC>
__device__ __forceinline__ void build_mask(const unsigned (&kv)[NC], unsigned thr, int need, int lane, GAS unsigned long long* mrow) {
    unsigned mlo = 0u, mhi = 0u; int tbase = 0;
#pragma unroll
    for (int c = 0; c < NC; ++c) {
        unsigned long long m = __ballot(kv[c] > thr);
        if (need > 0 && tbase < need) {
            const unsigned long long em = __ballot(kv[c] == thr);
            const int ce = __popcll(em);
            if (tbase + ce <= need) m |= em;
            else { const int pre = __builtin_amdgcn_mbcnt_hi((unsigned)(em >> 32), __builtin_amdgcn_mbcnt_lo((unsigned)em, 0u)); m |= __ballot(kv[c] == thr && pre < need - tbase); }
            tbase += ce;
        }
        asm volatile("s_nop 1\n\tv_writelane_b32 %0, %2, %4\n\tv_writelane_b32 %1, %3, %4" : "+v"(mlo), "+v"(mhi) : "s"((unsigned)m), "s"((unsigned)(m >> 32)), "i"(c));
    }
    if (lane < 32) mrow[(size_t)lane * SEQ] = ((unsigned long long)mhi << 32) | mlo;
}
__device__ __forceinline__ unsigned wave_max_dpp(unsigned v) {
    unsigned t;
    t = (unsigned)__builtin_amdgcn_update_dpp(0, (int)v, 0x111, 0xf, 0xf, false); v = v > t ? v : t;
    t = (unsigned)__builtin_amdgcn_update_dpp(0, (int)v, 0x112, 0xf, 0xf, false); v = v > t ? v : t;
    t = (unsigned)__builtin_amdgcn_update_dpp(0, (int)v, 0x114, 0xf, 0xf, false); v = v > t ? v : t;
    t = (unsigned)__builtin_amdgcn_update_dpp(0, (int)v, 0x118, 0xf, 0xf, false); v = v > t ? v : t;
    t = (unsigned)__builtin_amdgcn_update_dpp(0, (int)v, 0x142, 0xa, 0xf, false); v = v > t ? v : t;
    t = (unsigned)__builtin_amdgcn_update_dpp(0, (int)v, 0x143, 0xc, 0xf, false); v = v > t ? v : t;
    return (unsigned)__builtin_amdgcn_readlane((int)v, 63);
}
__device__ __forceinline__ unsigned f2key(float f) { const unsigned u = __float_as_uint(f); return (u & 0x80000000u) ? ~u : (u | 0x80000000u); }
__device__ __forceinline__ float key2f(unsigned k) { return __uint_as_float((k & 0x80000000u) ? (k & 0x7fffffffu) : ~k); }
struct RowSearch {
    unsigned lo, hi, thr; int cl, ch, need, last; float wl, wh; bool act;
    __device__ __forceinline__ void init(bool wanted, int ncausal, int cz0, int cz1, unsigned kmax, unsigned kmin) {
        act = false; thr = 0u; need = 0; lo = 0u; hi = 0u; cl = 0; ch = 0; last = 0; wl = 1.f; wh = 1.f;
        if (!wanted) return;
        if (cz1 <= 256 && cz0 >= 256) { thr = 0x80000000u; need = 256 - cz1; return; }
        act = true;
        if (cz1 > 256) { lo = 0x80000001u; cl = cz1; hi = kmax + 1u; ch = 0; }
        else { lo = kmin; cl = ncausal; hi = 0x80000000u; ch = cz0; }
        wl = (float)(cl - 256); wh = (float)(256 - ch);
    }
    __device__ __forceinline__ unsigned next_cand(int it) {
        if (!act) return 0xffffffffu;
        if (hi - lo <= 1u) { thr = lo; need = 256 - ch; act = false; return 0xffffffffu; }
        const float fl = key2f(lo), fh = key2f(hi);
        unsigned c = f2key((fl * wh + fh * wl) * __builtin_amdgcn_rcpf(wl + wh));
        if (it >= 24) c = lo + ((hi - lo) >> 1);
        if (c <= lo) c = lo + 1u;
        if (c >= hi) c = hi - 1u;
        return c;
    }
    __device__ __forceinline__ void update(unsigned c, int cnt) {
        if (!act) return;
        if (cnt == 256) { thr = c - 1u; need = 0; act = false; }
        else if (cnt > 256) { lo = c; cl = cnt; wl = (float)(cnt - 256); if (last == 1) wh *= 0.5f; last = 1; }
        else { hi = c; ch = cnt; wh = (float)(256 - cnt); if (last == -1) wl *= 0.5f; last = -1; }
    }
};
template <int NC>
__device__ __forceinline__ void select_rows2(const LAS unsigned* sa, int nchunks, int ta, int lane, GAS unsigned long long* ma) {
    unsigned ka[NC], kb[NC];
#pragma unroll
    for (int c = 0; c < NC; ++c) { ka[c] = (c < nchunks) ? sa[64 * c + lane] : 0u; kb[c] = (c < nchunks) ? sa[2048 + 64 * c + lane] : 0u; }
    LDS_WAIT(); __builtin_amdgcn_s_barrier(); asm volatile("" ::: "memory");
    RowSearch A, B;
    if (ta + 2 > 256) {
        int a0 = 0, b0 = 0, a1 = 0, b1 = 0;
#pragma unroll
        for (int c = 0; c < NC; c += 2) cnt4(a0, b0, ka[c], kb[c], ka[c + 1], kb[c + 1], 0x80000000u, 0x80000000u);
#pragma unroll
        for (int c = 0; c < NC; c += 2) cnt4(a1, b1, ka[c], kb[c], ka[c + 1], kb[c + 1], 0x80000001u, 0x80000001u);
        unsigned mxa = 0u, mxb = 0u, mna = 0u, mnb = 0u;
#pragma unroll
        for (int c = 0; c < NC; ++c) { mxa = ka[c] > mxa ? ka[c] : mxa; mxb = kb[c] > mxb ? kb[c] : mxb;
            const unsigned ia = ~(ka[c] - 1u), ib = ~(kb[c] - 1u); mna = ia > mna ? ia : mna; mnb = ib > mnb ? ib : mnb; }
        const int t0s = wave_sum_dpp(a0 | (b0 << 16)), t1s = wave_sum_dpp(a1 | (b1 << 16));
        const unsigned kmxa = wave_max_dpp(mxa), kmxb = wave_max_dpp(mxb), kmna = ~wave_max_dpp(mna) + 1u, kmnb = ~wave_max_dpp(mnb) + 1u;
        A.init(ta + 1 > 256, ta + 1, t0s & 0xffff, t1s & 0xffff, kmxa, kmna);
        B.init(true, ta + 2, t0s >> 16, t1s >> 16, kmxb, kmnb);
        for (int it = 0; it < 64; ++it) {
            const unsigned ca = A.next_cand(it), cb = B.next_cand(it);
            if (!(A.act || B.act)) break;
            int na = 0, nb = 0;
#pragma unroll
            for (int c = 0; c < NC; c += 2) cnt4(na, nb, ka[c], kb[c], ka[c + 1], kb[c + 1], ca, cb);
            const int tot = wave_sum_dpp(na | (nb << 16));
            A.update(ca, tot & 0xffff); B.update(cb, tot >> 16);
        }
    } else { A.init(false, 0, 0, 0, 0u, 0u); B.init(false, 0, 0, 0, 0u, 0u); }
    build_mask<NC>(ka, A.thr, A.need, lane, ma);
    build_mask<NC>(kb, B.thr, B.need, lane, ma + 1);
}
__device__ __forceinline__ void select_phase(Frame& F, const bf16* QI, const bf16* KI, const float* WI, unsigned long long* MASK, const bf16* U, bf16* MIX) {
    LAS unsigned* SC = (LAS unsigned*)(F.lds + RING_OFF);
    const int lane = pg8::lane_id_now(), wave = F.wave, fr = lane & 15, fq = lane >> 4;
    LAS unsigned* jobctr = (LAS unsigned*)(F.lds + LDSCTL_OFF + 512);
    if (wave * 64 + lane < 16) jobctr[wave * 64 + lane] = 0u;
    LDS_WAIT(); __builtin_amdgcn_s_barrier(); asm volatile("" ::: "memory");
    pg8::bf16x8 afr[4][2]; f32x4 w[4];
#pragma unroll 1
    for (int uu_ = 0; uu_ < 4 * SEL_REP; ++uu_) {
        const int ui = uu_ & 3, b = F.vcu >> 5, j = F.vcu & 31;
        const int g = (ui == 0) ? 127 - j : (ui == 1) ? 64 + j : (ui == 2) ? 63 - j : j;
        const int t0 = 16 * g; const size_t rowbase = (size_t)b * SEQ;
        const int nchunks = (t0 + 16 + 63) >> 6, ntiles = nchunks * 4;
        if (uu_ == 0) {
#pragma unroll
            for (int h = 0; h < 4; ++h)
#pragma unroll
                for (int ks = 0; ks < 2; ++ks) afr[h][ks] = *(const pg8::bf16x8*)(QI + (rowbase + t0 + fr) * 256 + 64 * h + 32 * ks + 8 * fq);
#pragma unroll
            for (int r = 0; r < 4; ++r) w[r] = *(const f32x4*)(WI + (rowbase + t0 + 4 * fq + r) * 4);
        }
        if (uu_ < 4 || SEL_ABL != 3) {
        LAS unsigned* ctr = jobctr + uu_;
        int job; { unsigned j_ = 0u; if (lane == 0) j_ = __hip_atomic_fetch_add(ctr, 1u, __ATOMIC_RELAXED, __HIP_MEMORY_SCOPE_WORKGROUP); job = __builtin_amdgcn_readfirstlane((int)j_); }
        pg8::bf16x8 bfr[4][2];
        if (job < nchunks) {
#pragma unroll
            for (int i = 0; i < 4; ++i) { const bf16* kp = KI + ((rowbase >> 4) + 4 * job + i) * 1024 + (fq * 16 + fr) * 8; bfr[i][0] = *(const pg8::bf16x8*)kp; bfr[i][1] = *(const pg8::bf16x8*)(kp + 512); }
        }
#pragma unroll 1
        while (job < nchunks) {
            int nxt; { unsigned j_ = 0u; if (lane == 0) j_ = __hip_atomic_fetch_add(ctr, 1u, __ATOMIC_RELAXED, __HIP_MEMORY_SCOPE_WORKGROUP); nxt = __builtin_amdgcn_readfirstlane((int)j_); }
            pg8::bf16x8 bnx[4][2];
            { const int jn = (nxt < nchunks) ? nxt : job;
#pragma unroll
              for (int i = 0; i < 4; ++i) { const bf16* kp = KI + ((rowbase >> 4) + 4 * jn + i) * 1024 + (fq * 16 + fr) * 8; bnx[i][0] = *(const pg8::bf16x8*)kp; bnx[i][1] = *(const pg8::bf16x8*)(kp + 512); } }
#pragma unroll
            for (int i = 0; i < 4; ++i) {
                const int tile = 4 * job + i;
                {
                    const int key = 16 * tile + fr;
                    f32x4 acc[4];
#pragma unroll
                    for (int h = 0; h < 4; ++h) {
                        acc[h] = __builtin_amdgcn_mfma_f32_16x16x32_bf16(afr[h][0], bfr[i][0], (f32x4){0.f, 0.f, 0.f, 0.f}, 0, 0, 0);
                        acc[h] = __builtin_amdgcn_mfma_f32_16x16x32_bf16(afr[h][1], bfr[i][1], acc[h], 0, 0, 0);
                    }
                    const bool edge = 16 * tile + 15 > t0;
#pragma unroll
                    for (int r = 0; r < 4; ++r) {
                        float sc = 0.f;
#pragma unroll
                        for (int h = 0; h < 4; ++h) { const int ri = __float_as_int(acc[h][r]); sc = fmaf(w[r][h], __int_as_float(ri > 0 ? ri : 0), sc); }
                        const int u = __float_as_int(sc);
                        unsigned sk = (unsigned)u ^ ((unsigned)(u >> 31) | 0x80000000u);
                        if (edge) sk = (key <= t0 + 4 * fq + r) ? sk : 0u;
                        SC[(4 * fq + r) * 2048 + key] = sk;
                    }
                }
            }
#pragma unroll
            for (int i = 0; i < 4; ++i) { bfr[i][0] = bnx[i][0]; bfr[i][1] = bnx[i][1]; }
            job = nxt;
        }
        }
        if (uu_ + 1 < 4 * SEL_REP) {
            const int ui2 = (uu_ + 1) & 3, g2 = (ui2 == 0) ? 127 - j : (ui2 == 1) ? 64 + j : (ui2 == 2) ? 63 - j : j, t02 = 16 * g2;
#pragma unroll
            for (int h = 0; h < 4; ++h)
#pragma unroll
                for (int ks = 0; ks < 2; ++ks) afr[h][ks] = *(const pg8::bf16x8*)(QI + (rowbase + t02 + fr) * 256 + 64 * h + 32 * ks + 8 * fq);
#pragma unroll
            for (int r = 0; r < 4; ++r) w[r] = *(const f32x4*)(WI + (rowbase + t02 + 4 * fq + r) * 4);
        }
        LDS_WAIT(); __builtin_amdgcn_s_barrier(); asm volatile("" ::: "memory");
        {
            const int ncr = (nchunks + 3) >> 2;
            const int rl = 2 * wave, t = t0 + rl;
            const LAS unsigned* srow = SC + rl * 2048;
            GAS unsigned long long* mrow = (GAS unsigned long long*)MASK + (uu_ >= 4 ? (size_t)202 * 1024 * 1024 / 8 : (size_t)0) + (size_t)b * 32 * SEQ + t;
            if (uu_ < 4 || SEL_ABL == 1 || SEL_ABL == 3) switch (ncr) {
                case 1: select_rows2<4>(srow, nchunks, t, lane, mrow); break;
                case 2: select_rows2<8>(srow, nchunks, t, lane, mrow); break;
                case 3: select_rows2<12>(srow, nchunks, t, lane, mrow); break;
                case 4: select_rows2<16>(srow, nchunks, t, lane, mrow); break;
                case 5: select_rows2<20>(srow, nchunks, t, lane, mrow); break;
                case 6: select_rows2<24>(srow, nchunks, t, lane, mrow); break;
                case 7: select_rows2<28>(srow, nchunks, t, lane, mrow); break;
                default: select_rows2<32>(srow, nchunks, t, lane, mrow); break;
            }
            else { LDS_WAIT(); __builtin_amdgcn_s_barrier(); asm volatile("" ::: "memory"); }
        }
    }
    const int gw = F.vcu * NWAVES + F.wave, NGW = F.G * NWAVES;
#pragma unroll 1
    for (int task = gw; task < POOL_REP * (M / 4); task += NGW) {
        const int row0 = (task & (M / 4 - 1)) * 4, tq = row0 & (SEQ - 1);
        v4u uu[19];
#pragma unroll
        for (int i = 0; i < 19; ++i) { const int dt = i - 15; uu[i] = (tq + dt >= 0) ? *(const GAS v4u*)(U + (size_t)(row0 + dt) * 512 + 8 * lane) : (v4u){0u, 0u, 0u, 0u}; }
        const int gsel = lane >> 4;
#pragma unroll
        for (int i = 0; i < 4; ++i) {
            const int t = tq + i, wl = 2 << gsel, n = (t + 1 < wl) ? (t + 1) : wl; const float inv = 1.0f / (float)n;
            unsigned ow[4];
#pragma unroll
            for (int q = 0; q < 4; ++q) {
                float lo[16], hi[16];
#pragma unroll
                for (int jj = 0; jj < 16; ++jj) { const unsigned x = uu[15 + i - jj][q]; lo[jj] = __uint_as_float(x << 16); hi[jj] = __uint_as_float(x & 0xffff0000u); }
                const float l2 = lo[0] + lo[1], h2 = hi[0] + hi[1];
                const float l4 = l2 + (lo[2] + lo[3]), h4 = h2 + (hi[2] + hi[3]);
                const float l8 = l4 + ((lo[4] + lo[5]) + (lo[6] + lo[7])), h8 = h4 + ((hi[4] + hi[5]) + (hi[6] + hi[7]));
                const float l16 = l8 + (((lo[8] + lo[9]) + (lo[10] + lo[11])) + ((lo[12] + lo[13]) + (lo[14] + lo[15]))), h16 = h8 + (((hi[8] + hi[9]) + (hi[10] + hi[11])) + ((hi[12] + hi[13]) + (hi[14] + hi[15])));
                const float sl = (gsel == 0) ? l2 : (gsel == 1) ? l4 : (gsel == 2) ? l8 : l16, sh = (gsel == 0) ? h2 : (gsel == 1) ? h4 : (gsel == 2) ? h8 : h16;
                ow[q] = pk2(sl * inv - lo[0], sh * inv - hi[0]);
            }
            *(GAS v4u*)(MIX + (size_t)(row0 + i) * 1024 + 512 + 8 * lane) = (v4u){ow[0], ow[1], ow[2], ow[3]};
        }
    }
}

#include <hip/hip_bf16.h>
namespace attn_body {
using bf16=__hip_bfloat16;
using bf16x8=__attribute__((ext_vector_type(8)))short;
using s16x4=__attribute__((ext_vector_type(4)))short;
using f32x16=__attribute__((ext_vector_type(16)))float;
using u32x4=__attribute__((ext_vector_type(4)))unsigned;
constexpr int BATCH=8,NHEAD=8,SEQ=2048,D=64,KP=512,OP=1024;
constexpr int NW=8,QBLK=32,QB=QBLK*NW,KVBLK=64,NQB=SEQ/QB;
constexpr int ATTN_UNIT_ROWS=QB;
__device__ __forceinline__ int crow(int r,int hi){return (r&3)+8*(r>>2)+4*hi;}
#define SBAR() __builtin_amdgcn_sched_barrier(0)
__device__ __forceinline__ void cmask(f32x16&p0,f32x16&p1,int jb,int qrel,int hi){
  const float NEG=-INFINITY; int kb=64*jb+4*hi;
  #pragma unroll
  for(int r=0;r<16;++r){int kv=kb+(r&3)+8*(r>>2); if(kv>qrel)p0[r]=NEG; if(kv+32>qrel)p1[r]=NEG;}
}

constexpr int NSLOT=3, SLOTB=8192;
constexpr int LDS_K=0, LDS_V=NSLOT*SLOTB, LDS_WS=2*NSLOT*SLOTB, LDS_OST=LDS_WS+NW*64*4, LDS_BYTES=LDS_OST+NW*4096, LDS_MASK=LDS_BYTES, LDS_TOTAL=LDS_MASK+32*2048;
constexpr float C2=0.125f*1.4426950408889634f;
__device__ __forceinline__ void glds16(const void*sbase,unsigned voff,unsigned lds_dst){unsigned keep;
  asm volatile("s_mov_b32 %0, m0\n\ts_mov_b32 m0, %2\n\ts_nop 4\n\tglobal_load_lds_dwordx4 %1, %3\n\ts_mov_b32 m0, %0":"=&s"(keep):"v"(voff),"s"(lds_dst),"s"(sbase):"memory");}
__device__ __forceinline__ float max3f(float a,float b,float c){float r;asm("v_max3_f32 %0, %1, %2, %3":"=v"(r):"v"(a),"v"(b),"v"(c));return r;}
__device__ __forceinline__ float max2f(float a,float b){float r;asm("v_max_f32_e32 %0, %1, %2":"=v"(r):"v"(a),"v"(b));return r;}
__device__ __forceinline__ float fadd_s(float a,float b){float r;asm("v_add_f32_e32 %0, %1, %2":"=v"(r):"v"(a),"v"(b));return r;}
__device__ __forceinline__ float fsub_s(float a,float b){float r;asm("v_sub_f32_e32 %0, %1, %2":"=v"(r):"v"(a),"v"(b));return r;}
typedef float f32x2_t __attribute__((ext_vector_type(2))); typedef __bf16 bf16x2_t __attribute__((ext_vector_type(2)));
__device__ __forceinline__ unsigned cvtpk_s(float lo,float hi){f32x2_t v={lo,hi};bf16x2_t b=__builtin_convertvector(v,bf16x2_t);return __builtin_bit_cast(unsigned,b);}
#define WAIT_BAR(N) asm volatile("s_waitcnt vmcnt(" #N ") lgkmcnt(0)\n\ts_barrier":::"memory")

__device__ __forceinline__ void qkt(f32x16&p0,f32x16&p1,const char*Kslot,const bf16x8*qr,const f32x16&negm,int r32,int hi){
  const char*kb=Kslot+hi*1024+r32*16;
  #pragma unroll
  for(int d0=0;d0<4;++d0){
    const bf16x8 b0=*reinterpret_cast<const bf16x8*>(kb+d0*2048);
    const bf16x8 b1=*reinterpret_cast<const bf16x8*>(kb+d0*2048+512);
    if(d0==0){p0=__builtin_amdgcn_mfma_f32_32x32x16_bf16(b0,qr[0],negm,0,0,0);p1=__builtin_amdgcn_mfma_f32_32x32x16_bf16(b1,qr[0],negm,0,0,0);}
    else{p0=__builtin_amdgcn_mfma_f32_32x32x16_bf16(b0,qr[d0],p0,0,0,0);p1=__builtin_amdgcn_mfma_f32_32x32x16_bf16(b1,qr[d0],p1,0,0,0);}}
}
typedef __attribute__((address_space(3))) const char* lds_cptr;
typedef short v4i16_t __attribute__((ext_vector_type(4)));
__device__ __forceinline__ void kload8(bf16x8*kf,lds_cptr kp){
  kf[0]=*(const __attribute__((address_space(3))) bf16x8*)(kp);      kf[1]=*(const __attribute__((address_space(3))) bf16x8*)(kp+512);
  kf[2]=*(const __attribute__((address_space(3))) bf16x8*)(kp+2048); kf[3]=*(const __attribute__((address_space(3))) bf16x8*)(kp+2560);
  kf[4]=*(const __attribute__((address_space(3))) bf16x8*)(kp+4096); kf[5]=*(const __attribute__((address_space(3))) bf16x8*)(kp+4608);
  kf[6]=*(const __attribute__((address_space(3))) bf16x8*)(kp+6144); kf[7]=*(const __attribute__((address_space(3))) bf16x8*)(kp+6656);
}
__device__ __forceinline__ void kload2(bf16x8*kf,lds_cptr kp,int j){ kf[2*j]=*(const __attribute__((address_space(3))) bf16x8*)(kp+j*2048); kf[2*j+1]=*(const __attribute__((address_space(3))) bf16x8*)(kp+j*2048+512); }
__device__ __forceinline__ s16x4 vtr(lds_cptr p){ return __builtin_bit_cast(s16x4,__builtin_amdgcn_ds_read_tr16_b64_v4i16((__attribute__((address_space(3))) v4i16_t*)p)); }
__device__ __forceinline__ float rowmax(const f32x16&p0,const f32x16&p1){
  float a=max3f(p0[0],p0[1],p1[0]),b=max3f(p0[2],p0[3],p1[1]);a=max3f(a,p1[2],p1[3]);
  #pragma unroll
  for(int r=4;r<16;r+=4){a=max3f(a,p0[r],p0[r+1]);b=max3f(b,p0[r+2],p0[r+3]);a=max3f(a,p1[r],p1[r+1]);b=max3f(b,p1[r+2],p1[r+3]);}
  const float m=max2f(a,b);
  auto rr=__builtin_amdgcn_permlane32_swap(__float_as_uint(m),__float_as_uint(m),false,false);
  return max2f(__uint_as_float(rr[0]),__uint_as_float(rr[1]));
}
__device__ __forceinline__ void pv(f32x16*o,int vb,bf16x8 pa0,bf16x8 pa1,bf16x8 pa2,bf16x8 pa3){
  #pragma unroll
  for(int d0=0;d0<2;++d0){s16x4 lo[4],hi[4];
    #pragma unroll
    for(int ks=0;ks<4;++ks){
      asm volatile("ds_read_b64_tr_b16 %0,%1 offset:%c2":"=&v"(lo[ks]):"v"(vb),"i"(d0*4096+ks*1024):"memory");
      asm volatile("ds_read_b64_tr_b16 %0,%1 offset:%c2":"=&v"(hi[ks]):"v"(vb),"i"(d0*4096+ks*1024+512):"memory");}
    asm volatile("s_waitcnt lgkmcnt(0)":::"memory");SBAR();
    #define PK(k) (bf16x8){lo[k][0],lo[k][1],lo[k][2],lo[k][3],hi[k][0],hi[k][1],hi[k][2],hi[k][3]}
    o[d0]=__builtin_amdgcn_mfma_f32_32x32x16_bf16(pa0,PK(0),o[d0],0,0,0);
    o[d0]=__builtin_amdgcn_mfma_f32_32x32x16_bf16(pa1,PK(1),o[d0],0,0,0);
    o[d0]=__builtin_amdgcn_mfma_f32_32x32x16_bf16(pa2,PK(2),o[d0],0,0,0);
    o[d0]=__builtin_amdgcn_mfma_f32_32x32x16_bf16(pa3,PK(3),o[d0],0,0,0);
    #undef PK
  }
}

#ifndef ATTN_STORE16
#define ATTN_STORE16(p,v) (*(u32x4*)(p)=(v))
#endif
template<int THRL> __device__ __forceinline__ void attn_unit(int b,int h,int qb,const bf16*Q,const bf16*__restrict__ K,const bf16*__restrict__ V,bf16*O,const unsigned long long*MASKT,char*shm,const int wave_id){
  const int wid=wave_id,lane=pg8::lane_id_now(),tid=wid*64+lane,r32=lane&31,hi=lane>>5;
  const long rowbase=(long)b*SEQ; const int q0=qb*QB; const int NT=(q0+QB)/KVBLK;
  const bf16*Qw=Q+(rowbase+q0+wid*QBLK)*KP+h*D;
  const bf16*Kh=K+((long)(b*NHEAD+h)*(SEQ/KVBLK))*4096,*Vh=V+((long)(b*NHEAD+h)*(SEQ/KVBLK))*4096;
  const unsigned lds0=(unsigned)(uintptr_t)shm;
  float*wsf=(float*)(shm+LDS_WS)+wid*64;
  const bf16*ksrc=Kh+wid*512,*vsrc=Vh+wid*512; const unsigned dmaoff=(unsigned)lane*16u;
  const unsigned kdst=lds0+LDS_K+wid*1024, vdst=lds0+LDS_V+wid*1024;
  #define DMA_K(t,slot) glds16(ksrc+(long)(t)*4096,dmaoff,(unsigned)__builtin_amdgcn_readfirstlane(kdst+(slot)))
  #define DMA_V(t,slot) glds16(vsrc+(long)(t)*4096,dmaoff,(unsigned)__builtin_amdgcn_readfirstlane(vdst+(slot)))
  const char*Kbase=shm+LDS_K; bf16x8 kf[8];
  const lds_cptr shm3=(lds_cptr)shm; const lds_cptr kp0=shm3+LDS_K+hi*1024+r32*16; const lds_cptr vp0=shm3+LDS_V+((lane>>4)&1)*32+(lane&3)*8+(4*hi+((lane&15)>>2))*64;
  { int tl=tid; asm volatile("":"+v"(tl));
    const int npc=NT*128; const unsigned long long*msrc=MASKT+((long)b*32)*SEQ+q0; u32x4 mv[8];
    #pragma unroll
    for(int i=0;i<8;++i){ const int p=tl+i*NW*64; if(p<npc)mv[i]=*reinterpret_cast<const u32x4*>(msrc+(long)(p>>7)*SEQ+(p&127)*2); }
    #pragma unroll
    for(int i=0;i<8;++i){ const int p=tl+i*NW*64; if(p<npc)*reinterpret_cast<__attribute__((address_space(3))) u32x4*>((__attribute__((address_space(3))) char*)(lds_cptr)shm+LDS_MASK+(p>>7)*2048+(p&127)*16)=mv[i]; } }
  asm volatile("s_waitcnt vmcnt(0) lgkmcnt(0)":::"memory");
  DMA_K(0,0);DMA_V(0,0);DMA_K(1,SLOTB);
  bf16x8 qr[4];
  #pragma unroll
  for(int d0=0;d0<4;++d0)qr[d0]=*reinterpret_cast<const bf16x8*>(&Qw[(long)r32*KP+d0*16+hi*8]);
  #define BP(r) (((r)&3)+8*((r)>>2))
  #define EXM(x,w,r) __uint_as_float(__float_as_uint(__builtin_amdgcn_exp2f(x))&(unsigned)__builtin_amdgcn_sbfe((int)(w),BP(r),1))
  #define MASKLD(tt,m0,m1) int ro_=r32; asm volatile("":"+v"(ro_)); const unsigned long long mw_=*(const __attribute__((address_space(3))) unsigned long long*)((lds_cptr)shm+LDS_MASK+wid*(QBLK*8)+ro_*8+(tt)*2048); const unsigned m0=((unsigned)mw_)>>(4*hi),m1=((unsigned)(mw_>>32))>>(4*hi)
  float mhat=0.f,l_reg=0.f;f32x16 o[2];o[0]=f32x16{};o[1]=f32x16{};f32x16 negm=f32x16{};asm volatile("":"+v"(negm));
  const int qrel=wid*QBLK+r32;
  #define CMASK(P0,P1,t) do{}while(0)
  bool resc=false;
  #define START(P0,P1) do{ const float rm=rowmax(P0,P1); resc=false; \
    { const float dl=rm; mhat=fadd_s(mhat,dl); \
      _Pragma("unroll") for(int r=0;r<16;++r){P0[r]=fsub_s(P0[r],dl);P1[r]=fsub_s(P1[r],dl);} \
      _Pragma("unroll") for(int r=0;r<16;++r)negm[r]=-mhat; asm volatile("":"+v"(negm)); } \
    _Pragma("unroll") for(int r=0;r<16;++r)P0[r]=EXM(P0[r],mS0,r); }while(0)
  #define RESC() do{ if(resc){ asm volatile("s_waitcnt lgkmcnt(0)":::"memory"); \
      _Pragma("unroll") for(int d_=0;d_<2;++d_) _Pragma("unroll") for(int r=0;r<16;++r)o[d_][r]*=wsf[crow(r,hi)]; } }while(0)
  f32x16 pA0,pA1,pB0,pB1;
  int sl_prev=0,sl_cur=0,sl_next=SLOTB;
  #define ROT() do{sl_prev=sl_cur;sl_cur=sl_next;sl_next=(sl_next==(NSLOT-1)*SLOTB)?0:sl_next+SLOTB;}while(0)
  DMA_K(2,2*SLOTB);
  WAIT_BAR(3);
  qkt(pA0,pA1,Kbase,qr,negm,r32,hi);asm volatile("s_nop 15\n\ts_nop 7":"+v"(pA0),"+v"(pA1));CMASK(pA0,pA1,0);
  { MASKLD(0,mS0,mS1);
  START(pA0,pA1);
  _Pragma("unroll") for(int r=0;r<16;++r)pA1[r]=EXM(pA1[r],mS1,r); }
  WAIT_BAR(0);
  DMA_K(3,0);DMA_V(1,SLOTB);
  ROT();
  kload8(kf,kp0+sl_cur);
  WAIT_BAR(2);
  s16x4 vlo[8],vhi[8]; u32x4 pw0,pw1,pw2,pw3;
  #define PKW(P,B) cvtpk_s(P[B],P[B+1])
  #define PAF(k) __builtin_bit_cast(bf16x8,pw##k)
  #define VFR(i) (bf16x8){vlo[i][0],vlo[i][1],vlo[i][2],vlo[i][3],vhi[i][0],vhi[i][1],vhi[i][2],vhi[i][3]}
  #define PIN(x) asm volatile("":"+v"(x))
  #define MX3(a,b,c) __builtin_fmaxf(__builtin_fmaxf((a),(b)),(c))
  #define GAPA(MF,A0,A1,A2,A3,W0,W1,PW) do{ MF; sacc+=A0; sacc+=A1; sacc+=A2; sacc+=A3; PIN(sacc); W0; W1; PIN(PW); SBAR(); }while(0)
  #define EX(v) __builtin_amdgcn_exp2f(v)
  #define GAPB(MF,X,B,W) do{ MF; X[B]=EXM(X[B],W,B); X[B+1]=EXM(X[B+1],W,B+1); X[B+2]=EXM(X[B+2],W,B+2); X[B+3]=EXM(X[B+3],W,B+3); PIN(X); SBAR(); }while(0)
  #define VRD(i) do{ vlo[i]=vtr(vp_+(((i)>>2)*4096+((i)&3)*1024)); vhi[i]=vtr(vp_+(((i)>>2)*4096+((i)&3)*1024+512)); }while(0)
  #define KRD(G,j) do{ if(G){ kload2(kf,kp0+sl_next,j); SBAR(); } }while(0)
  #define STEP(C0,C1,P0,P1,t,GK,GV,GL) do{ SBAR(); \
    const lds_cptr vp_=vp0+sl_prev; \
    VRD(0); SBAR(); float sacc=(P0[0]+P0[1]); \
    GAPA(C0=__builtin_amdgcn_mfma_f32_32x32x16_bf16(kf[0],qr[0],negm,0,0,0), P0[2],P0[3],P0[4],P0[5],     pw0[0]=PKW(P0,0), pw0[1]=PKW(P0,2), pw0); \
    VRD(4); SBAR(); GAPA(C1=__builtin_amdgcn_mfma_f32_32x32x16_bf16(kf[1],qr[0],negm,0,0,0), P0[6],P0[7],P0[8],P0[9],     pw0[2]=PKW(P0,4), pw0[3]=PKW(P0,6), pw0); \
    VRD(1); SBAR(); GAPA(C0=__builtin_amdgcn_mfma_f32_32x32x16_bf16(kf[2],qr[1],C0,0,0,0),   P0[10],P0[11],P0[12],P0[13], pw1[0]=PKW(P0,8), pw1[1]=PKW(P0,10), pw1); \
    VRD(5); SBAR(); GAPA(C1=__builtin_amdgcn_mfma_f32_32x32x16_bf16(kf[3],qr[1],C1,0,0,0),   P0[14],P0[15],P1[0],P1[1],   pw1[2]=PKW(P0,12),pw1[3]=PKW(P0,14), pw1); \
    VRD(2); SBAR(); GAPA(C0=__builtin_amdgcn_mfma_f32_32x32x16_bf16(kf[4],qr[2],C0,0,0,0),   P1[2],P1[3],P1[4],P1[5],     pw2[0]=PKW(P1,0), pw2[1]=PKW(P1,2), pw2); \
    VRD(6); SBAR(); GAPA(C1=__builtin_amdgcn_mfma_f32_32x32x16_bf16(kf[5],qr[2],C1,0,0,0),   P1[6],P1[7],P1[8],P1[9],     pw2[2]=PKW(P1,4), pw2[3]=PKW(P1,6), pw2); \
    VRD(3); SBAR(); GAPA(C0=__builtin_amdgcn_mfma_f32_32x32x16_bf16(kf[6],qr[3],C0,0,0,0),   P1[10],P1[11],P1[12],P1[13], pw3[0]=PKW(P1,8), pw3[1]=PKW(P1,10), pw3); \
    VRD(7); SBAR(); GAPA(C1=__builtin_amdgcn_mfma_f32_32x32x16_bf16(kf[7],qr[3],C1,0,0,0),   P1[14],P1[15],0.f,0.f,       pw3[2]=PKW(P1,12),pw3[3]=PKW(P1,14), pw3); \
    l_reg+=sacc; \
    if(GK){DMA_K((t)+3,sl_cur);} if(GV){DMA_V((t)+1,sl_next);} \
    MASKLD(t,mA_,mB_); \
    { float a=MX3(C0[0],C0[1],C1[0]),b=MX3(C0[2],C0[3],C1[1]); a=MX3(a,C1[2],C1[3]); \
      _Pragma("unroll") for(int r=4;r<16;r+=4){a=MX3(a,C0[r],C0[r+1]);b=MX3(b,C0[r+2],C0[r+3]);a=MX3(a,C1[r],C1[r+1]);b=MX3(b,C1[r+2],C1[r+3]);} \
      float rm=__builtin_fmaxf(a,b); { auto rr=__builtin_amdgcn_permlane32_swap(__float_as_uint(rm),__float_as_uint(rm),false,false); rm=__builtin_fmaxf(__uint_as_float(rr[0]),__uint_as_float(rr[1])); } \
      resc=false; \
      if(__builtin_expect(__any(rm>(float)THRL),0)){ const float dl=__builtin_fmaxf(rm,0.f); mhat+=dl; \
        _Pragma("unroll") for(int r=0;r<16;++r){C0[r]-=dl;C1[r]-=dl;} \
        _Pragma("unroll") for(int r=0;r<16;++r)negm[r]=-mhat; asm volatile("":"+v"(negm)); \
        const float f=__builtin_amdgcn_exp2f(-dl); l_reg*=f; { int rq_=r32; asm volatile("":"+v"(rq_)); if(hi==0)wsf[rq_]=f; } resc=true; } } \
    SBAR(); \
    GAPB(o[0]=__builtin_amdgcn_mfma_f32_32x32x16_bf16(PAF(0),VFR(0),o[0],0,0,0), C0,0,mA_); \
    GAPB(o[1]=__builtin_amdgcn_mfma_f32_32x32x16_bf16(PAF(0),VFR(4),o[1],0,0,0), C0,4,mA_); \
    KRD(GL,0); GAPB(o[0]=__builtin_amdgcn_mfma_f32_32x32x16_bf16(PAF(1),VFR(1),o[0],0,0,0), C0,8,mA_); \
    KRD(GL,1); GAPB(o[1]=__builtin_amdgcn_mfma_f32_32x32x16_bf16(PAF(1),VFR(5),o[1],0,0,0), C0,12,mA_); \
    KRD(GL,2); GAPB(o[0]=__builtin_amdgcn_mfma_f32_32x32x16_bf16(PAF(2),VFR(2),o[0],0,0,0), C1,0,mB_); \
    KRD(GL,3); GAPB(o[1]=__builtin_amdgcn_mfma_f32_32x32x16_bf16(PAF(2),VFR(6),o[1],0,0,0), C1,4,mB_); \
    GAPB(o[0]=__builtin_amdgcn_mfma_f32_32x32x16_bf16(PAF(3),VFR(3),o[0],0,0,0), C1,8,mB_); \
    GAPB(o[1]=__builtin_amdgcn_mfma_f32_32x32x16_bf16(PAF(3),VFR(7),o[1],0,0,0), C1,12,mB_); \
    }while(0)
  int t=1;
  #undef CMASK
  #define CMASK(P0,P1,t) do{}while(0)
  for(;t+5<NT;t+=2){
    STEP(pB0,pB1,pA0,pA1,t,true,true,true);     WAIT_BAR(2); RESC(); ROT();
    STEP(pA0,pA1,pB0,pB1,t+1,true,true,true);   WAIT_BAR(2); RESC(); ROT();
  }
  #undef CMASK
  #define CMASK(P0,P1,t) do{}while(0)
  #define ENDW(tt) do{ if((tt)+3<NT){WAIT_BAR(2);} else if((tt)+2<NT){WAIT_BAR(1);} else {WAIT_BAR(0);} }while(0)
  for(;t+1<NT;t+=2){
    STEP(pB0,pB1,pA0,pA1,t,(t+3<NT),(t+1<NT),(t+1<NT));       ENDW(t);   RESC(); ROT();
    STEP(pA0,pA1,pB0,pB1,t+1,(t+4<NT),(t+2<NT),(t+2<NT));     ENDW(t+1); RESC(); ROT();
  }
  STEP(pB0,pB1,pA0,pA1,NT-1,false,false,false); RESC();
  { float sacc=pB0[0]+pB0[1]; _Pragma("unroll") for(int r=2;r<16;++r)sacc+=pB0[r]; _Pragma("unroll") for(int r=0;r<16;++r)sacc+=pB1[r]; l_reg+=sacc;
    pw0=(u32x4){PKW(pB0,0),PKW(pB0,2),PKW(pB0,4),PKW(pB0,6)};pw1=(u32x4){PKW(pB0,8),PKW(pB0,10),PKW(pB0,12),PKW(pB0,14)};pw2=(u32x4){PKW(pB1,0),PKW(pB1,2),PKW(pB1,4),PKW(pB1,6)};pw3=(u32x4){PKW(pB1,8),PKW(pB1,10),PKW(pB1,12),PKW(pB1,14)};
    SBAR(); { int lq_=lane; asm volatile("":"+v"(lq_)); const int vb0=(int)(lds0+LDS_V)+((lq_>>4)&1)*32+(lq_&3)*8+(4*(lq_>>5)+((lq_&15)>>2))*64; pv(o,vb0+sl_cur,PAF(0),PAF(1),PAF(2),PAF(3)); } }
  #undef PKW
  #undef PAF
  #undef VFR
  #undef PIN
  #undef MX3
  #undef GAPA
  #undef GAPB
  #undef EX
  #undef VRD
  #undef KRD
  #undef STEP
  #undef ENDW
  {auto rr=__builtin_amdgcn_permlane32_swap(__float_as_uint(l_reg),__float_as_uint(l_reg),false,false);l_reg=__uint_as_float(rr[0])+__uint_as_float(rr[1]);}
  if(hi==0)wsf[32+r32]=l_reg;asm volatile("s_waitcnt lgkmcnt(0)":::"memory");
  float rli[16];
  #pragma unroll
  for(int r=0;r<16;++r)rli[r]=__builtin_amdgcn_rcpf(wsf[32+crow(r,hi)]);
  bf16*Ow=O+(rowbase+q0+wid*QBLK)*OP+h*D;
  { bf16*stg=(bf16*)(shm+LDS_OST)+wid*2048;
    #pragma unroll
    for(int r=0;r<16;++r){const int orow=crow(r,hi);
      #pragma unroll
      for(int d0=0;d0<2;++d0)stg[orow*64+d0*32+r32]=__float2bfloat16(o[d0][r]*rli[r]);}
    asm volatile("s_waitcnt lgkmcnt(0)":::"memory");
    #pragma unroll
    for(int i=0;i<4;++i){const int row=i*8+(lane>>3),ch=lane&7; const u32x4 v=*(const u32x4*)(stg+row*64+ch*8); ATTN_STORE16(Ow+(long)row*OP+ch*8,v);} }
  asm volatile("s_waitcnt lgkmcnt(0)\n\ts_barrier":::"memory");
  #undef DMA_K
  #undef DMA_V
  #undef CMASK
  #undef START
  #undef RESC
  #undef ROT
  #undef BP
  #undef EXM
  #undef MASKLD
}
constexpr int ATTN_LDS_BYTES=LDS_BYTES;
struct AttnTensors { const bf16* Q; const bf16* K; const bf16* V; bf16* O; const unsigned long long* MASKT; };
struct AttnUnit { int bh; int qb; };
struct StaticOrder {
  int vcu;
  __device__ __forceinline__ explicit StaticOrder(int grid,int block):vcu((block%8)*(grid/8)+block/8){}
  __device__ __forceinline__ bool next(int i,AttnUnit&u)const{ if(i>=2)return false; const int s=vcu&3; u.bh=vcu>>2; u.qb=(i==0)?7-s:s; return true; }
  __device__ __forceinline__ void a_ready(const AttnUnit&)const{}
  __device__ __forceinline__ void done(const AttnUnit&)const{}
};
template<class Sched,int THRL=8> __device__ __forceinline__ void attn_phase(char*lds,const AttnTensors&T,const Sched&S,const int wave_id){
  AttnUnit u;
  for(int i=0;S.next(i,u);++i){ S.a_ready(u); attn_unit<THRL>(u.bh/NHEAD,u.bh%NHEAD,u.qb,T.Q,T.K,T.V,T.O,T.MASKT,lds,wave_id); S.done(u); }
}
#undef SBAR
#undef WAIT_BAR
}


__global__ void __launch_bounds__(NWAVES * 64, 2) mk_fwd(Args args) {
    extern __shared__ __attribute__((aligned(16))) unsigned char lds[];
    Frame F;
    F.lds = (LAS unsigned char*)lds;
    F.MISC = (volatile LAS unsigned*)(F.lds + MISC_OFF);
    F.wave = __builtin_amdgcn_readfirstlane((int)threadIdx.x >> 6); F.lane = (int)__builtin_amdgcn_mbcnt_hi(~0u, __builtin_amdgcn_mbcnt_lo(~0u, 0u)); F.tid = F.wave * 64 + F.lane;
    F.G = gridDim.x; { const int bx = blockIdx.x; F.vcu = (F.G % 8 == 0) ? (bx % 8) * (F.G / 8) + bx / 8 : bx; }
    unsigned char* ws = args.ws;
    F.ctl = (gu32*)(ws + WS_CTL);
    for (int u = F.tid; u < (LDS_BYTES - LDSCTL_OFF) / 4; u += NWAVES * 64) ((LAS unsigned*)(F.lds + LDSCTL_OFF))[u] = 0u;
    __syncthreads();
    XcdBarrier bar = xcd_barrier_post((unsigned*)(F.ctl + CW_BAR) + args.li * XCD_BAR_WORDS, F.MISC + 8, F.wave);
    const int lo = args.ph_lo, hi = args.ph_hi;
#define IN(k) (lo <= (k) && (k) < hi)
#define BOTH(k) (IN(k) && IN((k) + 1))
#ifdef TS_SEL
    const unsigned long long ts0_ = rt();
#define GRID_BAR() do { xcd_barrier(bar); if (blockIdx.x == 0 && F.tid == 0) F.MISC[16 + (ts_n_++)] = (unsigned)(rt() - ts0_); } while (0)
    int ts_n_ = 0;
#else
#define GRID_BAR() xcd_barrier(bar)
#endif
    bf16* XB = (bf16*)(ws + WS_XB); bf16* MIX = (bf16*)(ws + WS_MIX); bf16* H = (bf16*)(ws + WS_H);
    float* sspA = (float*)(ws + WS_SSPA); float* sspB = (float*)(ws + WS_SSPB);
    float* cosH = (float*)(ws + WS_TAB); float* sinH = cosH + SEQ * 32; float* cosI = sinH + SEQ * 32; float* sinI = cosI + SEQ * 16;
    const float* x = args.in[0]; float* out = args.out;

    if (IN(0)) { p0_prologue(F, args);
#if PROBE_REP & 1
        GRID_BAR(); p0_prologue(F, args);
#endif
        if (BOTH(0)) GRID_BAR();
#ifdef PROBE_BARS
        for (int i_ = 0; i_ < PROBE_BARS; ++i_) GRID_BAR();
#endif
        }
    if (IN(1)) {
        {
        pg8::Gemm g{XB, (bf16*)(ws + WS_WGU1), M, NGU, D}; pg8::StaticOrder S; S.init(M, NGU, F.G, (int)blockIdx.x);
        pg8::EpiSwiGLU E{H, sspA, F.lds + RING_OFF + pg8::STAGE_BYTES};
        pg8::gemm_phase<pg8::EpiSwiGLU, pg8::StaticOrder, PG8_ALIGN, PG8_SP2>(F.lds + RING_OFF, g, S, E, F.wave);
#ifdef TS_SEL
        if (F.tid == 0 && blockIdx.x == 0) F.MISC[40] = (unsigned)(rt() - ts0_);
        if (F.tid == 0 && blockIdx.x == 200) ((gu32*)(ws + WS_CTL))[8192 + 0] = (unsigned)(rt() - ts0_);
#endif
        if (F.G == 256 && blockIdx.x >= 128) { weight_items(F, args, 1, ((int)blockIdx.x - 128) * NWAVES + F.wave, 128 * NWAVES); wpo_items(F, args, ((int)blockIdx.x - 128) * NWAVES + F.wave, 128 * NWAVES, 0, 1024); }
#ifdef TS_SEL
        asm volatile("s_waitcnt vmcnt(0)" ::: "memory");
        if (F.tid == 0 && blockIdx.x == 200) ((gu32*)(ws + WS_CTL))[8192 + 64] = (unsigned)(rt() - ts0_);
#endif
        }
#if PROBE_REP & (1 << 1)
        GRID_BAR();
        {
        pg8::Gemm g{XB, (bf16*)(ws + WS_WGU1), M, NGU, D}; pg8::StaticOrder S; S.init(M, NGU, F.G, (int)blockIdx.x);
        pg8::EpiSwiGLU E{H, sspA, F.lds + RING_OFF + pg8::STAGE_BYTES};
        pg8::gemm_phase<pg8::EpiSwiGLU, pg8::StaticOrder, PG8_ALIGN, PG8_SP2>(F.lds + RING_OFF, g, S, E, F.wave);
        }
#endif
        if (BOTH(1)) GRID_BAR();
    }
    if (IN(2)) {
        {
        pg8::Gemm g{H, (bf16*)(ws + WS_WD1), M, D, DFF}; pg8::StaticOrder S; S.init(M, D, F.G, (int)blockIdx.x);
        pg8::EpiResid<true, false, true> E{nullptr, nullptr, XB, sspA, 0.5f};
        pg8::gemm_phase<pg8::EpiResid<true, false, true>, pg8::StaticOrder, PG8_ALIGN, PG8_SP2>(F.lds + RING_OFF, g, S, E, F.wave);
#ifdef TS_SEL
        if (F.tid == 0) { const unsigned t_ = (unsigned)(rt() - ts0_); __hip_atomic_fetch_max((gu32*)(ws + WS_CTL) + 9216 + 128 * 1, 0x40000000u - t_, RLX_AGENT); __hip_atomic_fetch_max((gu32*)(ws + WS_CTL) + 9216 + 128 * 1 + 64, t_, RLX_AGENT); }
#endif

        }
#if PROBE_REP & (1 << 2)
        GRID_BAR();
        {
        pg8::Gemm g{H, (bf16*)(ws + WS_WD1), M, D, DFF}; pg8::StaticOrder S; S.init(M, D, F.G, (int)blockIdx.x);
        pg8::EpiResid<true, false, true> E{nullptr, nullptr, XB, sspA, 0.5f};
        pg8::gemm_phase<pg8::EpiResid<true, false, true>, pg8::StaticOrder, PG8_ALIGN, PG8_SP2>(F.lds + RING_OFF, g, S, E, F.wave);
        }
#endif
        if (BOTH(2)) GRID_BAR();
    }
    if (IN(3)) {
        {
        pg8::Gemm g{XB, (bf16*)(ws + WS_WIN), M, NIN, D}; pg8::StaticOrder S; S.init(M, NIN, F.G, (int)blockIdx.x);
        pg8::EpiInProj E{sspA, (bf16*)(ws + WS_Q), (bf16*)(ws + WS_K), (bf16*)(ws + WS_V), (bf16*)(ws + WS_U), (bf16*)(ws + WS_QI), (bf16*)(ws + WS_KI), (float*)(ws + WS_WI),
                         args.in[7], args.in[8], cosH, sinH, cosI, sinI, C2, F.lds + RING_OFF + pg8::STAGE_BYTES};
        pg8::gemm_phase<pg8::EpiInProj, pg8::StaticOrder, PG8_ALIGN, PG8_SP2>(F.lds + RING_OFF, g, S, E, F.wave);
#ifdef TS_SEL
        if (F.tid == 0 && blockIdx.x == 0) F.MISC[41] = (unsigned)(rt() - ts0_);
        if (F.tid == 0 && blockIdx.x == 200) ((gu32*)(ws + WS_CTL))[8192 + 128] = (unsigned)(rt() - ts0_);
#endif
        if (F.G == 256 && blockIdx.x >= 128) { weight_items(F, args, 2, ((int)blockIdx.x - 128) * NWAVES + F.wave, 128 * NWAVES); wpo_items(F, args, ((int)blockIdx.x - 128) * NWAVES + F.wave, 128 * NWAVES, 1024, 2048); }
#ifdef TS_SEL
        asm volatile("s_waitcnt vmcnt(0)" ::: "memory");
        if (F.tid == 0 && blockIdx.x == 200) ((gu32*)(ws + WS_CTL))[8192 + 192] = (unsigned)(rt() - ts0_);
#endif
        }
#if PROBE_REP & (1 << 3)
        GRID_BAR();
        {
        pg8::Gemm g{XB, (bf16*)(ws + WS_WIN), M, NIN, D}; pg8::StaticOrder S; S.init(M, NIN, F.G, (int)blockIdx.x);
        pg8::EpiInProj E{sspA, (bf16*)(ws + WS_Q), (bf16*)(ws + WS_K), (bf16*)(ws + WS_V), (bf16*)(ws + WS_U), (bf16*)(ws + WS_QI), (bf16*)(ws + WS_KI), (float*)(ws + WS_WI),
                         args.in[7], args.in[8], cosH, sinH, cosI, sinI, C2, F.lds + RING_OFF + pg8::STAGE_BYTES};
        pg8::gemm_phase<pg8::EpiInProj, pg8::StaticOrder, PG8_ALIGN, PG8_SP2>(F.lds + RING_OFF, g, S, E, F.wave);
        }
#endif
        if (BOTH(3)) GRID_BAR();
    }
    if (IN(4)) {
        {
        select_phase(F, (const bf16*)(ws + WS_QI), (const bf16*)(ws + WS_KI), (const float*)(ws + WS_WI), (unsigned long long*)(ws + WS_MASK), (const bf16*)(ws + WS_U), MIX);
        }
#if PROBE_REP & (1 << 4)
        GRID_BAR();
        {
        select_phase(F, (const bf16*)(ws + WS_QI), (const bf16*)(ws + WS_KI), (const float*)(ws + WS_WI), (unsigned long long*)(ws + WS_MASK), (const bf16*)(ws + WS_U), MIX);
        }
#endif
        if (BOTH(4)) GRID_BAR();
    }
    if (IN(5)) {
        {
        static_assert(attn_body::LDS_TOTAL <= LDSCTL_OFF, "attention LDS");
        const attn_body::AttnTensors AT{(const attn_body::bf16*)(ws + WS_Q), (const attn_body::bf16*)(ws + WS_K), (const attn_body::bf16*)(ws + WS_V), (attn_body::bf16*)MIX, (const unsigned long long*)(ws + WS_MASK)};
        const attn_body::StaticOrder S((int)F.G, (int)blockIdx.x);
        attn_body::attn_phase<attn_body::StaticOrder>((char*)lds + RING_OFF, AT, S, F.wave);
        }
#if PROBE_REP & (1 << 5)
        GRID_BAR();
        {
        static_assert(attn_body::LDS_TOTAL <= LDSCTL_OFF, "attention LDS");
        const attn_body::AttnTensors AT{(const attn_body::bf16*)(ws + WS_Q), (const attn_body::bf16*)(ws + WS_K), (const attn_body::bf16*)(ws + WS_V), (attn_body::bf16*)MIX, (const unsigned long long*)(ws + WS_MASK)};
        const attn_body::StaticOrder S((int)F.G, (int)blockIdx.x);
        attn_body::attn_phase<attn_body::StaticOrder>((char*)lds + RING_OFF, AT, S, F.wave);
        }
#endif
        if (BOTH(5)) GRID_BAR();
    }
    if (IN(6)) {
        pg8::Gemm g{MIX, (bf16*)(ws + WS_WOUT), M, D, D}; pg8::StaticOrder S; S.init(M, D, F.G, (int)blockIdx.x);
        pg8::EpiResid<true, false, true> E{nullptr, nullptr, XB, sspB, 1.0f};
        pg8::gemm_phase<pg8::EpiResid<true, false, true>, pg8::StaticOrder, PG8_ALIGN, PG8_SP2>(F.lds + RING_OFF, g, S, E, F.wave);
#if PROBE_REP & (1 << 6)
        GRID_BAR();
        { pg8::EpiResid<true, false, true> E2{nullptr, nullptr, (bf16*)(ws + 208 * MiB), (float*)(ws + 244 * MiB), 1.0f};
          pg8::gemm_phase<pg8::EpiResid<true, false, true>, pg8::StaticOrder, PG8_ALIGN, PG8_SP2>(F.lds + RING_OFF, g, S, E2, F.wave); }
#endif
        if (BOTH(6)) GRID_BAR();
    }
    if (IN(7)) {
        {
        pg8::Gemm g{XB, (bf16*)(ws + WS_WGU2), M, NGU, D}; pg8::StaticOrder S; S.init(M, NGU, F.G, (int)blockIdx.x);
        pg8::EpiSwiGLU E{H, sspB, F.lds + RING_OFF + pg8::STAGE_BYTES};
        pg8::gemm_phase<pg8::EpiSwiGLU, pg8::StaticOrder, PG8_ALIGN, PG8_SP2>(F.lds + RING_OFF, g, S, E, F.wave);
        if (F.G == 256 && blockIdx.x >= 128) weight_items(F, args, 3, ((int)blockIdx.x - 128) * NWAVES + F.wave, 128 * NWAVES);
        }
#if PROBE_REP & (1 << 7)
        GRID_BAR();
        {
        pg8::Gemm g{XB, (bf16*)(ws + WS_WGU2), M, NGU, D}; pg8::StaticOrder S; S.init(M, NGU, F.G, (int)blockIdx.x);
        pg8::EpiSwiGLU E{H, sspB, F.lds + RING_OFF + pg8::STAGE_BYTES};
        pg8::gemm_phase<pg8::EpiSwiGLU, pg8::StaticOrder, PG8_ALIGN, PG8_SP2>(F.lds + RING_OFF, g, S, E, F.wave);
        }
#endif
        if (BOTH(7)) GRID_BAR();
    }
    if (IN(8)) {
        {
        pg8::Gemm g{H, (bf16*)(ws + WS_WD2), M, D, DFF}; pg8::StaticOrder S; S.init(M, D, F.G, (int)blockIdx.x);
        pg8::EpiResid<true, true, false> E{nullptr, out, XB, nullptr, 0.5f};
        pg8::gemm_phase<pg8::EpiResid<true, true, false>, pg8::StaticOrder, PG8_ALIGN, PG8_SP2>(F.lds + RING_OFF, g, S, E, F.wave);
        }
#if PROBE_REP & (1 << 8)
        GRID_BAR();
        {
        pg8::Gemm g{H, (bf16*)(ws + WS_WD2), M, D, DFF}; pg8::StaticOrder S; S.init(M, D, F.G, (int)blockIdx.x);
        pg8::EpiResid<true, true, false> E{nullptr, out, XB, nullptr, 0.5f};
        pg8::gemm_phase<pg8::EpiResid<true, true, false>, pg8::StaticOrder, PG8_ALIGN, PG8_SP2>(F.lds + RING_OFF, g, S, E, F.wave);
        }
#endif
    }
#ifdef TS_SEL
    if (blockIdx.x == 0 && F.tid == 0) {
        const unsigned now = (unsigned)(rt() - ts0_);
        const unsigned v = (TS_SEL == 41) ? (__hip_atomic_load((gu32*)(ws + WS_CTL) + 9216 + 128 + 64, RLX_AGENT) - (0x40000000u - __hip_atomic_load((gu32*)(ws + WS_CTL) + 9216 + 128, RLX_AGENT))) : (TS_SEL == 30) ? F.MISC[41] : (TS_SEL == 31) ? __hip_atomic_load((gu32*)(ws + WS_CTL) + 8192 + 128, RLX_AGENT) : (TS_SEL == 32) ? __hip_atomic_load((gu32*)(ws + WS_CTL) + 8192 + 192, RLX_AGENT) : (TS_SEL == 20) ? F.MISC[40] : (TS_SEL == 21) ? __hip_atomic_load((gu32*)(ws + WS_CTL) + 8192, RLX_AGENT) : (TS_SEL == 22) ? __hip_atomic_load((gu32*)(ws + WS_CTL) + 8192 + 64, RLX_AGENT) : (TS_SEL >= 8) ? now : F.MISC[16 + TS_SEL];
        asm volatile("s_waitcnt vmcnt(0)" ::: "memory");
        out[0] += (float)v * 0.01f * TS_SCALE;
    }
#endif
#undef IN
#undef BOTH
}

extern "C" void kernel_launch(void* const* d_in, const int* in_sizes, int n_in, void* d_out, int out_size, void* d_ws, size_t ws_size, hipStream_t stream) {
    static int grid = 0;
    if (grid == 0) {
        if (n_in != 16 || out_size != M * D || ws_size < WS_END) { fprintf(stderr, "kernel_launch: unexpected shapes (n_in %d out %d ws %zu)\n", n_in, out_size, ws_size); grid = -1; return; }
        int dev = 0, cus = 0, per_cu = 0;
        if (hipGetDevice(&dev) != hipSuccess || hipDeviceGetAttribute(&cus, hipDeviceAttributeMultiprocessorCount, dev) != hipSuccess) { grid = -1; return; }
        if (hipFuncSetAttribute((const void*)mk_fwd, hipFuncAttributeMaxDynamicSharedMemorySize, LDS_BYTES) != hipSuccess) { fprintf(stderr, "kernel_launch: hipFuncSetAttribute failed\n"); grid = -1; return; }
        if (hipOccupancyMaxActiveBlocksPerMultiprocessor(&per_cu, (const void*)mk_fwd, NWAVES * 64, LDS_BYTES) != hipSuccess || per_cu < 1) fprintf(stderr, "kernel_launch: occupancy query reports %d\n", per_cu);
        (void)hipGetLastError();
        grid = cus;
        if (cus != 256) { fprintf(stderr, "kernel_launch: this kernel is laid out for 256 CUs (MI355X); found %d; nothing launched\n", cus); grid = -1; return; }
    }
    if (grid < 0) return;
    (void)hipMemsetAsync((char*)d_ws + WS_CTL, 0, CTL_ZERO_BYTES, stream);
    Args a{};
    for (int i = 0; i < 16; ++i) a.in[i] = (const float*)d_in[i];
    a.out = (float*)d_out; a.ws = (unsigned char*)d_ws;
    a.ph_lo = 0; a.ph_hi = 9; a.li = 0;
    void* kargs[] = {(void*)&a};
    hipError_t le = hipLaunchCooperativeKernel((const void*)mk_fwd, dim3(grid), dim3(NWAVES * 64), kargs, LDS_BYTES, stream);
    if (le != hipSuccess) { fprintf(stderr, "kernel_launch: cooperative launch failed: %s (grid %d); falling back to a plain launch\n", hipGetErrorString(le), grid); (void)hipGetLastError();
        hipLaunchKernelGGL(mk_fwd, dim3(grid), dim3(NWAVES * 64), LDS_BYTES, stream, a); }
}
```

```cpp
#include <hip/hip_runtime.h>
#include <cstdio>
#include <cstdint>
#include <math.h>
namespace pg8 {
#define PG8_LAS __attribute__((address_space(3)))
typedef unsigned short bf16_t;
typedef short bf16x8 __attribute__((ext_vector_type(8)));
typedef float f32x4 __attribute__((ext_vector_type(4)));
typedef unsigned u32x4 __attribute__((ext_vector_type(4)));
constexpr int BM = 256, BK = 64, HALF = 128, HTB = HALF * BK * 2  , STAGE_BYTES = 8 * HTB, NXCD = 8, WGM = 8;

__host__ __device__ __forceinline__ int lds_byte(int r, int c) { const int st = (r >> 4) * 2 + (c >> 5), rr = r & 15, cc = c & 31, ob = rr * 64 + cc * 2; return st * 1024 + (ob ^ (((ob >> 9) & 1) << 5)); }
__host__ __device__ __forceinline__ void stage_rc(int b, int& R, int& C) { const int st = b / 1024, sb = b % 1024, swz = sb ^ (((sb >> 9) & 1) << 5); R = (st >> 1) * 16 + swz / 64; C = (st & 1) * 32 + (swz % 64) / 2; }
__host__ __device__ __forceinline__ int perm32(int rho) { const int n = rho >> 4, i = rho & 15; return 8 * (i >> 2) + 4 * n + (i & 3); }

__device__ __forceinline__ int lane_id_now() { int l; asm volatile("v_mbcnt_lo_u32_b32 %0, -1, 0\n\tv_mbcnt_hi_u32_b32 %0, -1, %0" : "=v"(l)); return l; }
struct Unit { int pm, pn; };
struct Gemm { const bf16_t* A; const bf16_t* Bt; int M, N, K; };

struct StaticOrder {
    int nM, nN, nwg, G, c;
    __host__ __device__ void init(int M, int N, int G_, int c_) { nM = M / BM; nN = N / BM; nwg = nM * nN; G = G_; c = c_; }
    __host__ __device__ bool next(int i, Unit& u) const {
        const long L = (long)i * G + c; if (L >= nwg) return false;
        int wgid = (int)L; { const int q = nwg / NXCD, r = nwg % NXCD, xcd = wgid % NXCD, off = wgid / NXCD; wgid = (xcd < r ? xcd * (q + 1) : r * (q + 1) + (xcd - r) * q) + off; }
        const int nig = WGM * nN, gid = wgid / nig, fm = gid * WGM, gsz = (nM - fm) < WGM ? (nM - fm) : WGM;
        u.pm = fm + ((wgid % nig) % gsz); u.pn = (wgid % nig) / gsz; return true;
    }
    __device__ __forceinline__ void a_ready(const Unit&) const {}
    __device__ __forceinline__ void done(const Unit&) const {}
};


__device__ __forceinline__ unsigned cvt_pk_bf16(float lo, float hi) { unsigned r; asm volatile("v_cvt_pk_bf16_f32 %0, %1, %2" : "=v"(r) : "v"(lo), "v"(hi)); return r; }
typedef float f32x2 __attribute__((ext_vector_type(2)));

typedef float f32x2 __attribute__((ext_vector_type(2)));
__device__ __forceinline__ float fq_sum(float s) {
    { auto r = __builtin_amdgcn_permlane16_swap(__float_as_uint(s), __float_as_uint(s), false, false); s = __uint_as_float(r[0]) + __uint_as_float(r[1]); }
    { auto r = __builtin_amdgcn_permlane32_swap(__float_as_uint(s), __float_as_uint(s), false, false); s = __uint_as_float(r[0]) + __uint_as_float(r[1]); }
    return s;
}
__device__ __forceinline__ float rrow(const float* ssp, int row, int fq) {
    const f32x4 p = *(const f32x4*)(ssp + (size_t)row * 16 + 4 * fq);
    float s = (p[0] + p[1]) + (p[2] + p[3]);
    s = fq_sum(s);
    return __builtin_amdgcn_rsqf(s * (1.0f / 1024.0f) + 1e-6f);
}
__device__ __forceinline__ float msrow_lds(const PG8_LAS unsigned char* pf, int lrow, int fq) {
    const f32x4 p = *(const PG8_LAS f32x4*)(pf + lrow * 64 + fq * 16);
    float s = (p[0] + p[1]) + (p[2] + p[3]);
    s = fq_sum(s);
    return s * (1.0f / 1024.0f) + 1e-6f;
}
__device__ __forceinline__ float rrow_lds(const PG8_LAS unsigned char* pf, int lrow, int fq) { return __builtin_amdgcn_rsqf(msrow_lds(pf, lrow, fq)); }
__device__ __forceinline__ void ssp_prefetch(const float* ssp, int pm, PG8_LAS unsigned char* pf, int wid, int kp) {
    const char* sbase = (const char*)(ssp + (size_t)pm * (BM * 16)) + wid * 2048 + (kp & 7) * 256;
    const unsigned dst = (unsigned)(unsigned long)pf + (unsigned)wid * 2048u + (unsigned)(kp & 7) * 256u;
    unsigned keep, off;
    asm volatile("s_mov_b32 %0, m0\n\tv_mbcnt_lo_u32_b32 %1, -1, 0\n\tv_mbcnt_hi_u32_b32 %1, -1, %1\n\tv_lshlrev_b32_e32 %1, 2, %1\n\ts_mov_b32 m0, %2\n\ts_nop 4\n\t"
                 "global_load_lds_dword %1, %3\n\ts_mov_b32 m0, %0"
                 : "=&s"(keep), "=&v"(off) : "s"(dst), "s"(sbase) : "memory");
}
__device__ __forceinline__ f32x4 silu_mul(f32x4 g, f32x4 u, float c1, float ir2) {
    f32x4 o;
#pragma unroll
    for (int e = 0; e < 4; ++e) { const float t = __builtin_amdgcn_exp2f(g[e] * c1); o[e] = (g[e] * u[e]) * __builtin_amdgcn_rcpf(__builtin_fmaf(t, ir2, ir2)); }
    return o;
}
__device__ __forceinline__ u32x4 pack8(f32x4 a, f32x4 b) { u32x4 w; w.x = cvt_pk_bf16(a[0], a[1]); w.y = cvt_pk_bf16(a[2], a[3]); w.z = cvt_pk_bf16(b[0], b[1]); w.w = cvt_pk_bf16(b[2], b[3]); return w; }
__device__ __forceinline__ float dot4(f32x4 a) { return (a[0] * a[0] + a[1] * a[1]) + (a[2] * a[2] + a[3] * a[3]); }

struct EpiSwiGLU {
    static constexpr bool PERM = true, AFTER_DRAIN = false; static constexpr int NPF = 1;
    bf16_t* H; const float* ssp; PG8_LAS unsigned char* pf;
    __device__ __forceinline__ void prefetch(const Unit& u, int wid, int kp) const { ssp_prefetch(ssp, u.pm, pf, wid, kp); }
    __device__ __forceinline__ void operator()(const f32x4 (&acc)[2][2][4][2], const Unit& u, int wr, int wc, int fr, int fq) const {
        const int row0 = u.pm * BM + wr * 64 + fr, hc0 = u.pn * 128 + wc * 32 + 8 * fq;
        float rs[2][4];
#pragma unroll
        for (int ai = 0; ai < 2; ++ai)
#pragma unroll
            for (int m = 0; m < 4; ++m) rs[ai][m] = msrow_lds(pf, wr * 64 + fr + ai * HALF + m * 16, fq);
#pragma unroll
        for (int ai = 0; ai < 2; ++ai)
#pragma unroll
            for (int m = 0; m < 4; ++m) {
                const int row = row0 + ai * HALF + m * 16; const float ir2 = rs[ai][m], c1 = __builtin_amdgcn_rsqf(ir2) * -1.4426950408889634f;
                const f32x4 h0 = silu_mul(acc[ai][0][m][0], acc[ai][1][m][0], c1, ir2), h1 = silu_mul(acc[ai][0][m][1], acc[ai][1][m][1], c1, ir2);
                *(u32x4*)(H + (size_t)row * 2816 + hc0) = pack8(h0, h1);
            }
    }
};
template <bool RB, bool OF, bool WB>
struct EpiResid {
    static constexpr bool PERM = true, AFTER_DRAIN = false; static constexpr int NPF = 0;
    const float* R; float* OUT; bf16_t* XB; float* ssp; float alpha;
    __device__ __forceinline__ void operator()(const f32x4 (&acc)[2][2][4][2], const Unit& u, int wr, int wc, int fr, int fq) const {
        const int row0 = u.pm * BM + wr * 64 + fr, c0 = u.pn * BM + wc * 32 + 8 * fq;
#pragma unroll
        for (int ai = 0; ai < 2; ++ai) {
            f32x4 rv[4][2][2];
#pragma unroll
            for (int m = 0; m < 4; ++m)
#pragma unroll
                for (int bj = 0; bj < 2; ++bj) {
                    const size_t off = (size_t)(row0 + ai * HALF + m * 16) * 1024 + c0 + bj * HALF;
                    if (RB) { const u32x4 w = *(const u32x4*)(XB + off);
                        rv[m][bj][0] = (f32x4){__uint_as_float(w.x << 16), __uint_as_float(w.x & 0xffff0000u), __uint_as_float(w.y << 16), __uint_as_float(w.y & 0xffff0000u)};
                        rv[m][bj][1] = (f32x4){__uint_as_float(w.z << 16), __uint_as_float(w.z & 0xffff0000u), __uint_as_float(w.w << 16), __uint_as_float(w.w & 0xffff0000u)}; }
                    else { rv[m][bj][0] = *(const f32x4*)(R + off); rv[m][bj][1] = *(const f32x4*)(R + off + 4); }
                }
            asm volatile("" ::: "memory");
#pragma unroll
            for (int m = 0; m < 4; ++m) {
                const int row = row0 + ai * HALF + m * 16; float ss = 0.f;
#pragma unroll
                for (int bj = 0; bj < 2; ++bj) {
                    const size_t off = (size_t)row * 1024 + c0 + bj * HALF;
                    const f32x4 o0 = rv[m][bj][0] + acc[ai][bj][m][0] * alpha, o1 = rv[m][bj][1] + acc[ai][bj][m][1] * alpha;
                    if (OF) { *(f32x4*)(OUT + off) = o0; *(f32x4*)(OUT + off + 4) = o1; }
                    if (WB) { *(u32x4*)(XB + off) = pack8(o0, o1); ss += dot4(o0) + dot4(o1); }
                }
                if (WB) { ss = fq_sum(ss); if (fq == 0) ssp[(size_t)row * 16 + u.pn * 4 + wc] = ss; }
            }
            asm volatile("" ::: "memory");
        }
    }
};
struct EpiInProj {
    static constexpr bool PERM = true, AFTER_DRAIN = false; static constexpr int NPF = 1;
    static constexpr size_t O_SSP = (size_t)2 << 20, O_TAB = (size_t)4 << 20, O_WI = (size_t)5 << 20, O_Q = (size_t)116 << 20, O_K = (size_t)132 << 20, O_V = (size_t)148 << 20, O_U = (size_t)164 << 20, O_QI = (size_t)180 << 20, O_KI = (size_t)188 << 20;
    unsigned char* wsb; const float *qn, *kn; float qscale; PG8_LAS unsigned char* pf;
    __device__ __forceinline__ void prefetch(const Unit& u, int wid, int kp) const { ssp_prefetch((const float*)(wsb + O_SSP), u.pm, pf, wid, kp); }
    __device__ __forceinline__ void operator()(const f32x4 (&acc)[2][2][4][2], const Unit& u, int wr, int wc, int fr, int fq) const {
        const int row0 = u.pm * BM + wr * 64 + fr, pn = u.pn;
        const float* ssp = (const float*)(wsb + O_SSP); const float* cosH = (const float*)(wsb + O_TAB); const float* sinH = cosH + 2048 * 32; const float* cosI = sinH + 2048 * 32; const float* sinI = cosI + 2048 * 16;
        bf16_t* Q = (bf16_t*)(wsb + O_Q); bf16_t* K = (bf16_t*)(wsb + O_K); bf16_t* V = (bf16_t*)(wsb + O_V); bf16_t* U = (bf16_t*)(wsb + O_U); bf16_t* QI = (bf16_t*)(wsb + O_QI); bf16_t* KI = (bf16_t*)(wsb + O_KI);
        float* WI = (float*)(wsb + O_WI);
#define PG8_SEP(t) __builtin_assume_separate_storage(t, Q); __builtin_assume_separate_storage(t, K); __builtin_assume_separate_storage(t, V); __builtin_assume_separate_storage(t, U); \
        __builtin_assume_separate_storage(t, QI); __builtin_assume_separate_storage(t, KI); __builtin_assume_separate_storage(t, WI);
        PG8_SEP(ssp) PG8_SEP(qn) PG8_SEP(kn) PG8_SEP(cosH) PG8_SEP(sinH) PG8_SEP(cosI) PG8_SEP(sinI)
#undef PG8_SEP
        float rs[2][4];
#pragma unroll
        for (int ai = 0; ai < 2; ++ai)
#pragma unroll
            for (int m = 0; m < 4; ++m) rs[ai][m] = rrow_lds(pf, wr * 64 + fr + ai * HALF + m * 16, fq);
        const int pos0 = row0 & 2047;
        if (pn < 4) {
            const float* gp = (pn < 2) ? qn : kn;
            const f32x4 g00 = *(const f32x4*)(gp + 8 * fq), g01 = *(const f32x4*)(gp + 8 * fq + 4), g10 = *(const f32x4*)(gp + 32 + 8 * fq), g11 = *(const f32x4*)(gp + 36 + 8 * fq);
            const float sc = (pn < 2) ? qscale : 1.0f;
            const f32x4 Ca = *(const f32x4*)(cosH + 16 * 32 + 8 * fq), Cb = *(const f32x4*)(cosH + 16 * 32 + 8 * fq + 4), Sa = *(const f32x4*)(sinH + 16 * 32 + 8 * fq), Sb = *(const f32x4*)(sinH + 16 * 32 + 8 * fq + 4);
#pragma unroll
            for (int ai = 0; ai < 2; ++ai) {
                const int o = (pos0 + ai * HALF) * 32 + 8 * fq;
                f32x4 ca = *(const f32x4*)(cosH + o), cb = *(const f32x4*)(cosH + o + 4), sa = *(const f32x4*)(sinH + o), sb = *(const f32x4*)(sinH + o + 4);
#pragma unroll
                for (int m = 0; m < 4; ++m) {
                    const int row = row0 + ai * HALF + m * 16, pos = row & 2047; const float r = rs[ai][m];
                    const f32x4 a00 = acc[ai][0][m][0] * r, a01 = acc[ai][0][m][1] * r, a10 = acc[ai][1][m][0] * r, a11 = acc[ai][1][m][1] * r;
                    float ss = (dot4(a00) + dot4(a01)) + (dot4(a10) + dot4(a11));
                    ss = fq_sum(ss);
                    const float rh = __builtin_amdgcn_rsqf(ss * (1.0f / 64.0f) + 1e-6f);
                    const f32x4 x1a = a00 * rh * g00, x1b = a01 * rh * g01, x2a = a10 * rh * g10, x2b = a11 * rh * g11;
                    const f32x4 o1a = (x1a * ca - x2a * sa) * sc, o1b = (x1b * cb - x2b * sb) * sc, o2a = (x2a * ca + x1a * sa) * sc, o2b = (x2b * cb + x1b * sb) * sc;
                    if (pn < 2) { bf16_t* dst = Q + (size_t)row * 512 + ((pn & 1) * 4 + wc) * 64 + 8 * fq; *(u32x4*)dst = pack8(o1a, o1b); *(u32x4*)(dst + 32) = pack8(o2a, o2b); }
                    else {
                        bf16_t* dst = K + ((size_t)((row >> 11) * 8 + (pn & 1) * 4 + wc) * 32 + (pos >> 6)) * 4096 + (pos & 63) * 8 + fq * 512;
                        *(u32x4*)dst = pack8(o1a, o1b); *(u32x4*)(dst + 4 * 512) = pack8(o2a, o2b); }
                    if (m < 3) { const f32x4 na = ca * Ca - sa * Sa, nb = cb * Cb - sb * Sb; sa = sa * Ca + ca * Sa; sb = sb * Cb + cb * Sb; ca = na; cb = nb; }
                }
            }
        } else if (pn < 8) {
#pragma unroll
            for (int ai = 0; ai < 2; ++ai)
#pragma unroll
                for (int m = 0; m < 4; ++m) {
                    const int row = row0 + ai * HALF + m * 16, pos = row & 2047; const float r = rs[ai][m];
                    const f32x4 a00 = acc[ai][0][m][0] * r, a01 = acc[ai][0][m][1] * r, a10 = acc[ai][1][m][0] * r, a11 = acc[ai][1][m][1] * r;
                    if (pn >= 6) { bf16_t* dst = U + (size_t)row * 512 + (pn & 1) * 256 + wc * 32 + 8 * fq; *(u32x4*)dst = pack8(a00, a01); *(u32x4*)(dst + 128) = pack8(a10, a11); }
                    else {
                        const int col = (pn & 1) * 256 + wc * 32, hd = col >> 6, ch = (col >> 5) & 1;
                        bf16_t* dst = V + ((size_t)((row >> 11) * 8 + hd) * 32 + (pos >> 6)) * 4096 + (ch * 4 + ((pos & 63) >> 4)) * 512 + ((pos & 15) * 4 + fq) * 8;
                        *(u32x4*)dst = pack8(a00, a01); *(u32x4*)(dst + (size_t)2 * 32 * 4096) = pack8(a10, a11); }
                }
        } else if (pn == 8 || wc == 0) {
            const int tq = (fq & 1) * 8;
            f32x4 Ca = *(const f32x4*)(cosI + 16 * 16 + tq), Cb = *(const f32x4*)(cosI + 16 * 16 + tq + 4), Sa = *(const f32x4*)(sinI + 16 * 16 + tq), Sb = *(const f32x4*)(sinI + 16 * 16 + tq + 4);
            const f32x4 one = (f32x4){1.f, 1.f, 1.f, 1.f}, zero = (f32x4){0.f, 0.f, 0.f, 0.f};
            if (fq >= 2) { Ca = one; Cb = one; Sa = zero; Sb = zero; }
            const int d1 = 8 * fq + ((fq >= 2) ? 16 : 0);
#pragma unroll
            for (int ai = 0; ai < 2; ++ai) {
                const int o = (pos0 + ai * HALF) * 16 + tq;
                f32x4 ca = *(const f32x4*)(cosI + o), cb = *(const f32x4*)(cosI + o + 4), sa = *(const f32x4*)(sinI + o), sb = *(const f32x4*)(sinI + o + 4);
                if (fq >= 2) { ca = one; cb = one; sa = zero; sb = zero; }
#pragma unroll
                for (int m = 0; m < 4; ++m) {
                    const int row = row0 + ai * HALF + m * 16; const float r = rs[ai][m];
                    const f32x4 a00 = acc[ai][0][m][0] * r, a01 = acc[ai][0][m][1] * r, a10 = acc[ai][1][m][0] * r, a11 = acc[ai][1][m][1] * r;
                    const f32x4 o1a = a00 * ca - a10 * sa, o1b = a01 * cb - a11 * sb, o2a = a10 * ca + a00 * sa, o2b = a11 * cb + a01 * sb;
                    if (pn == 8) { bf16_t* dst = QI + (size_t)row * 256 + wc * 64 + d1; *(u32x4*)dst = pack8(o1a, o1b); *(u32x4*)(dst + 16) = pack8(o2a, o2b); }
                    else {
                        const int d2 = d1 + 16; bf16_t* tb = KI + (size_t)(row >> 4) * 1024 + (row & 15) * 8;
                        *(u32x4*)(tb + ((d1 >> 5) * 4 + ((d1 & 31) >> 3)) * 128) = pack8(o1a, o1b); *(u32x4*)(tb + ((d2 >> 5) * 4 + ((d2 & 31) >> 3)) * 128) = pack8(o2a, o2b); }
                    if (m < 3) { const f32x4 na = ca * Ca - sa * Sa, nb = cb * Cb - sb * Sb; sa = sa * Ca + ca * Sa; sb = sb * Cb + cb * Sb; ca = na; cb = nb; }
                }
            }
        } else if (wc == 1) {
#pragma unroll
            for (int ai = 0; ai < 2; ++ai)
#pragma unroll
                for (int m = 0; m < 4; ++m) { const int row = row0 + ai * HALF + m * 16; if (fq == 0) *(f32x4*)(WI + (size_t)row * 4) = acc[ai][0][m][0] * (rs[ai][m] * 0.0625f); }
        }
    }
};
template <class Epi, class Sched, bool ALIGN_EPI = false, bool SP2 = false>
__device__ __forceinline__ void gemm_phase(PG8_LAS unsigned char* lds, const Gemm g, const Sched& S, const Epi& E, const int wave_id) {
    const int lane_ = lane_id_now();
    const int wid = wave_id, lane = lane_, tid = wid * 64 + lane,     wr = wid >> 2, wc = wid & 3, fr = lane & 15, fq = lane >> 4;
    const int K = g.K, nt = K / BK;
    unsigned voffA[2], voffB[2];
#pragma unroll
    for (int i = 0; i < 2; ++i) { int R, C; stage_rc(tid * 16 + i * 8192, R, C); const int Rb = Epi::PERM ? ((R & ~31) + perm32(R & 31)) : R;
        voffA[i] = (unsigned)(R * K + C) * 2u; voffB[i] = (unsigned)(Rb * K + C) * 2u; }
    const size_t kstep = (size_t)(BK * 2);
    const size_t hstep = (size_t)HALF * K * 2;
    const size_t tstep = 2 * hstep;
    const unsigned ldsw = (unsigned)wid * 1024u;
    const int aoff = lds_byte(wr * 64 + fr, fq * 8), boff = lds_byte(wc * 32 + fr, fq * 8);
#define PG8_SA(b, h) (((b) * 2 + (h)) * HTB)
#define PG8_SB(b, h) ((4 + (b) * 2 + (h)) * HTB)
#define PG8_STAGE(bufoff, gbase, voff) do { _Pragma("unroll") for (int _i = 0; _i < 2; ++_i) \
        __builtin_amdgcn_global_load_lds((const unsigned*)((const char*)(gbase) + (voff)[_i]), (PG8_LAS unsigned*)(lds + (bufoff) + ldsw + _i * 8192), 16, 0, 0); } while (0)
#define PG8_LDA(dst, b, h) do { _Pragma("unroll") for (int m = 0; m < 4; ++m) _Pragma("unroll") for (int k = 0; k < 2; ++k) dst[m][k] = *(const PG8_LAS bf16x8*)(lds + PG8_SA(b, h) + aoff + m * 2048 + k * 1024); } while (0)
#define PG8_LDB(dst, b, h) do { _Pragma("unroll") for (int n = 0; n < 2; ++n) _Pragma("unroll") for (int k = 0; k < 2; ++k) dst[n][k] = *(const PG8_LAS bf16x8*)(lds + PG8_SB(b, h) + boff + n * 2048 + k * 1024); } while (0)
#define PG8_MMA(ai, bj, At, Bt) do { __builtin_amdgcn_s_setprio(1); _Pragma("unroll") for (int m = 0; m < 4; ++m) _Pragma("unroll") for (int n = 0; n < 2; ++n) _Pragma("unroll") for (int k = 0; k < 2; ++k) \
        acc[ai][bj][m][n] = __builtin_amdgcn_mfma_f32_16x16x32_bf16(Bt[n][k], At[m][k], acc[ai][bj][m][n], 0, 0, 0); __builtin_amdgcn_s_setprio(0); } while (0)
#define PG8_MMA0(ai, bj, At, Bt) do { __builtin_amdgcn_s_setprio(1); _Pragma("unroll") for (int m = 0; m < 4; ++m) _Pragma("unroll") for (int n = 0; n < 2; ++n) { \
        acc[ai][bj][m][n] = __builtin_amdgcn_mfma_f32_16x16x32_bf16(Bt[n][0], At[m][0], (f32x4){0.f, 0.f, 0.f, 0.f}, 0, 0, 0); \
        acc[ai][bj][m][n] = __builtin_amdgcn_mfma_f32_16x16x32_bf16(Bt[n][1], At[m][1], acc[ai][bj][m][n], 0, 0, 0); } __builtin_amdgcn_s_setprio(0); } while (0)
#define PG8_WAIT_V(n) asm volatile("s_waitcnt vmcnt(" #n ")" ::: "memory")
#define PG8_WAIT_L(n) asm volatile("s_waitcnt lgkmcnt(" #n ")" ::: "memory")
#define PG8_BAR __builtin_amdgcn_s_barrier()
#define PG8_SCHED __builtin_amdgcn_sched_barrier(0)
    Unit cur, nxt; int ui = 0;
    if (!S.next(0, cur)) return;
    static_assert(SP2, "only the two-super-phase K-loop is kept here");
    f32x4 acc[2][2][4][2];
    bf16x8 At[4][2], B0[2][2], B1[2][2];
    const char* cA = (const char*)g.A + (size_t)cur.pm * tstep; const char* cB = (const char*)g.Bt + (size_t)cur.pn * tstep;
    S.a_ready(cur);
    if constexpr (SP2) {
        PG8_STAGE(PG8_SB(0, 0), cB, voffB); PG8_STAGE(PG8_SB(0, 1), cB + hstep, voffB); PG8_STAGE(PG8_SA(0, 0), cA, voffA); PG8_STAGE(PG8_SA(0, 1), cA + hstep, voffA);
        if (wr == 1) PG8_BAR;
        PG8_WAIT_V(2); PG8_BAR;
        PG8_STAGE(PG8_SB(1, 0), cB + kstep, voffB); PG8_STAGE(PG8_SA(1, 0), cA + kstep, voffA); PG8_STAGE(PG8_SB(1, 1), cB + hstep + kstep, voffB);
        PG8_WAIT_V(6); PG8_BAR;
    } else {
        PG8_STAGE(PG8_SB(0, 0), cB, voffB); PG8_STAGE(PG8_SA(0, 0), cA, voffA); PG8_STAGE(PG8_SB(0, 1), cB + hstep, voffB); PG8_STAGE(PG8_SA(0, 1), cA + hstep, voffA);
        if (wr == 1) PG8_BAR;
        PG8_WAIT_V(4); PG8_BAR;
        PG8_STAGE(PG8_SB(1, 0), cB + kstep, voffB); PG8_STAGE(PG8_SA(1, 0), cA + kstep, voffA); PG8_STAGE(PG8_SB(1, 1), cB + hstep + kstep, voffB);
        PG8_WAIT_V(6); PG8_BAR;
    }
    for (;;) {
        const bool has_next = S.next(ui + 1, nxt);
        const char* nA = has_next ? (const char*)g.A + (size_t)nxt.pm * tstep : cA; const char* nB = has_next ? (const char*)g.Bt + (size_t)nxt.pn * tstep : cB;
#define PG8_KPAIR(MMAF) do { \
            const bool last = (t == nt - 2); \
            const char* a1 = cA + (size_t)(t + 1) * kstep; \
            const char* a2 = last ? nA : cA + (size_t)(t + 2) * kstep; const char* b2 = last ? nB : cB + (size_t)(t + 2) * kstep; \
            const char* a3 = a2 + kstep; const char* b3 = b2 + kstep; \
            if (last && has_next) S.a_ready(nxt); \
            PG8_LDB(B0, 0, 0); PG8_LDB(B1, 0, 1); PG8_SCHED; PG8_LDA(At, 0, 0); PG8_STAGE(PG8_SA(1, 1), a1 + hstep, voffA); \
            PG8_WAIT_V(8); PG8_WAIT_L(0); PG8_BAR; MMAF(0, 0, At, B0); MMAF(0, 1, At, B1); PG8_BAR; PG8_SCHED; \
            PG8_LDA(At, 0, 1); \
            if constexpr (Epi::NPF > 0) { static_assert(Epi::NPF == 1, "wait counts below"); E.prefetch(cur, wid, t >> 1); } \
            PG8_STAGE(PG8_SB(0, 0), b2, voffB); PG8_STAGE(PG8_SB(0, 1), b2 + hstep, voffB); PG8_STAGE(PG8_SA(0, 0), a2, voffA); \
            if constexpr (Epi::NPF > 0) PG8_WAIT_V(9); else PG8_WAIT_V(8); \
            PG8_WAIT_L(0); PG8_BAR; MMAF(1, 0, At, B0); MMAF(1, 1, At, B1); PG8_BAR; PG8_SCHED; \
            PG8_LDB(B0, 1, 0); PG8_LDB(B1, 1, 1); PG8_SCHED; PG8_LDA(At, 1, 0); PG8_STAGE(PG8_SA(0, 1), a2 + hstep, voffA); \
            if constexpr (Epi::NPF > 0) PG8_WAIT_V(9); else PG8_WAIT_V(8); \
            PG8_WAIT_L(0); PG8_BAR; PG8_MMA(0, 0, At, B0); PG8_MMA(0, 1, At, B1); PG8_BAR; PG8_SCHED; \
            PG8_LDA(At, 1, 1); PG8_STAGE(PG8_SB(1, 0), b3, voffB); PG8_STAGE(PG8_SB(1, 1), b3 + hstep, voffB); PG8_STAGE(PG8_SA(1, 0), a3, voffA); \
            PG8_WAIT_V(8); PG8_WAIT_L(0); PG8_BAR; PG8_MMA(1, 0, At, B0); PG8_MMA(1, 1, At, B1); PG8_BAR; PG8_SCHED; } while (0)
        { const int t = 0; PG8_KPAIR(PG8_MMA0); }
#pragma unroll 1
        for (int t = 2; t < nt; t += 2) PG8_KPAIR(PG8_MMA);
#undef PG8_KPAIR
        if constexpr (ALIGN_EPI) { if (wr == 0) PG8_BAR; }
        if constexpr (!Epi::AFTER_DRAIN) { const int l2_ = lane_id_now(); int fr_ = l2_ & 15, fq_ = l2_ >> 4;
            E(acc, cur, wr, wc, fr_, fq_); S.done(cur); }
        if (!has_next) break;
        cur = nxt; cA = nA; cB = nB; ++ui;
        if constexpr (ALIGN_EPI) { if (wr == 1) PG8_BAR; }
    }
    PG8_WAIT_V(0);
    if constexpr (!ALIGN_EPI) { if (wr == 0) PG8_BAR; }
    PG8_BAR;
    if constexpr (Epi::AFTER_DRAIN) { E.fused(acc, cur, wr, wc, fr, fq, lds, wid, lane); S.done(cur); }
#undef PG8_SA
#undef PG8_SB
#undef PG8_STAGE
#undef PG8_LDA
#undef PG8_LDB
#undef PG8_MMA
#undef PG8_MMA0
#undef PG8_WAIT_V
#undef PG8_WAIT_L
#undef PG8_BAR
#undef PG8_SCHED
}
}


#ifndef PG8_SP2
#define PG8_SP2 true
#endif
#ifndef PG8_ALIGN
#define PG8_ALIGN true
#endif

#ifndef PROBE_REP
#define PROBE_REP 0
#endif
#define TS_SCALE 0.01f
constexpr int NWAVES = 8;
constexpr int BATCH = 8, SEQ = 2048, D = 1024, M = BATCH * SEQ, DFF = 2816, NGU = 2 * DFF, NIN = 2560, INC = 2372;
constexpr size_t MiB = 1u << 20;
constexpr size_t WS_CTL = 0, CTL_ZERO_BYTES = 64 * 1024;
constexpr size_t WS_SSPA = 2 * MiB, WS_SSPB = 3 * MiB;
constexpr size_t WS_TAB = 4 * MiB;
constexpr size_t WS_WI = 5 * MiB;
constexpr size_t WS_MASK = 6 * MiB;
constexpr size_t WS_WGU1 = 10 * MiB, WS_WD1 = 21 * MiB, WS_WIN = 27 * MiB, WS_WOUT = 32 * MiB, WS_WGU2 = 34 * MiB, WS_WD2 = 45 * MiB;
constexpr size_t WS_XB = 52 * MiB;
constexpr size_t WS_MIX = 84 * MiB;
constexpr size_t WS_H = 116 * MiB;
constexpr size_t WS_Q = 116 * MiB, WS_K = 132 * MiB, WS_V = 148 * MiB, WS_U = 164 * MiB, WS_QI = 180 * MiB, WS_KI = 188 * MiB;
constexpr size_t WS_END = 204 * MiB;
constexpr int CW_BAR = 4096;
constexpr int RING_OFF = 0, RING_BYTES = 131072;
constexpr int LDS_BYTES = 163840;
constexpr int LDSCTL_OFF = LDS_BYTES - 1024, MISC_OFF = LDSCTL_OFF + 320;
constexpr float C2 = 0.125f * 1.4426950408889634f;

#define GAS __attribute__((address_space(1)))
#define LAS __attribute__((address_space(3)))
typedef unsigned short bf16;
typedef unsigned v4u __attribute__((ext_vector_type(4)));
typedef float f32x4 __attribute__((ext_vector_type(4)));
typedef short bf16x8 __attribute__((ext_vector_type(8)));
typedef GAS unsigned gu32;
typedef GAS unsigned long long gu64;
#define RLX_AGENT __ATOMIC_RELAXED, __HIP_MEMORY_SCOPE_AGENT
#define LDS_WAIT() asm volatile("s_waitcnt lgkmcnt(0)" ::: "memory")
#define VM_WAIT() asm volatile("s_waitcnt vmcnt(0)" ::: "memory")
__device__ __forceinline__ unsigned long long rt() { return __builtin_amdgcn_s_memrealtime(); }
__device__ __forceinline__ unsigned f2bf(float f) { unsigned u = __builtin_bit_cast(unsigned, f); return (u + 0x7fffu + ((u >> 16) & 1u)) >> 16; }
__device__ __forceinline__ unsigned pk2(float lo, float hi) { return f2bf(lo) | (f2bf(hi) << 16); }

#define XB_TMO      128
#define XB_XCNT(j)  (256  + 64 * (j))
#define XB_XSUB(j)  (1280 + 64 * (j))
#define XB_XGEN(j)  (2304 + 64 * (j))
#define XB_TOP      3328
#define XB_TOPGEN   3392
#define XCD_BAR_WORDS 3456
#define XB_SPIN_CAP (1u << 18)

__device__ __forceinline__ unsigned xb_ld(unsigned* p)              { return __hip_atomic_load(p, __ATOMIC_RELAXED, __HIP_MEMORY_SCOPE_AGENT); }
__device__ __forceinline__ unsigned xb_add(unsigned* p, unsigned v) { return __hip_atomic_fetch_add(p, v, __ATOMIC_RELAXED, __HIP_MEMORY_SCOPE_AGENT); }
__device__ __forceinline__ unsigned xb_xcc_id() { return (unsigned)__builtin_amdgcn_s_getreg((3 << 11) | 20) & 0xFu; }
#define XB_SPIN(cond, bar) do { unsigned _sp = 0; while (cond) { __builtin_amdgcn_s_sleep(1); \
    if ((++_sp & 255u) == 0u) { if (xb_ld(&(bar)[XB_TMO])) break; if (_sp > XB_SPIN_CAP) { atomicAdd(&(bar)[XB_TMO], 1u); break; } } } } while (0)

struct XcdBarrier {
    unsigned* bar; unsigned x; int leader;
    volatile LAS unsigned* st;
};

__device__ __forceinline__ bool xb_is_thread0(int leader) { return leader && pg8::lane_id_now() == 0; }
__device__ __forceinline__ XcdBarrier xcd_barrier_post(unsigned* bar, volatile LAS unsigned* st, int wave_id) {
    XcdBarrier b; b.bar = bar; b.x = xb_xcc_id(); b.st = st; b.leader = (wave_id == 0) ? 1 : 0;
    if (xb_is_thread0(b.leader)) (void)xb_add(&bar[XB_XCNT(b.x)], 1u);
    return b;
}
__device__ __forceinline__ void xcd_barrier_complete(unsigned* bar, unsigned x, unsigned& nloc, unsigned& nx) {
    const unsigned G = gridDim.x * gridDim.y * gridDim.z;
    unsigned sum, cnt, mine, sp = 0u;
    for (;;) {
        sum = 0u; cnt = 0u; mine = 0u;
#pragma unroll
        for (unsigned j = 0; j < 16; ++j) { const unsigned c = xb_ld(&bar[XB_XCNT(j)]); sum += c; cnt += (c > 0u) ? 1u : 0u; mine = (j == x) ? c : mine; }
        if (sum == G) break;
        __builtin_amdgcn_s_sleep(1);
        if ((++sp & 255u) == 0u) { if (xb_ld(&bar[XB_TMO])) break; if (sp > XB_SPIN_CAP) { atomicAdd(&bar[XB_TMO], 1u); break; } }
    }
    nloc = mine > 0u ? mine : 1u; nx = cnt > 0u ? cnt : 1u;
}

__device__ __forceinline__ void xcd_barrier(const XcdBarrier& b) {
    asm volatile("s_waitcnt vmcnt(0)" ::: "memory");
    __syncthreads();
    if (xb_is_thread0(b.leader)) {
        unsigned* bar = b.bar;
        __builtin_amdgcn_s_waitcnt(0);
        unsigned nloc = b.st[0], nx = b.st[1];
        if (nloc == 0u) { xcd_barrier_complete(bar, b.x, nloc, nx); b.st[0] = nloc; b.st[1] = nx; }
        const unsigned old = xb_add(&bar[XB_XSUB(b.x)], 1u);
        const unsigned gen = old / nloc;
        if (old + 1u == (gen + 1u) * nloc) {
            __builtin_amdgcn_fence(__ATOMIC_RELEASE, "agent");
            asm volatile("s_waitcnt vmcnt(0)" ::: "memory");
            const unsigned og = xb_add(&bar[XB_TOP], 1u);
            const unsigned tg = og / nx;
            if (og + 1u == (tg + 1u) * nx) xb_add(&bar[XB_TOPGEN], 1u);
            else XB_SPIN(xb_ld(&bar[XB_TOPGEN]) == tg, bar);
            __builtin_amdgcn_fence(__ATOMIC_ACQUIRE, "agent");
            xb_add(&bar[XB_XGEN(b.x)], 1u);
            asm volatile("s_waitcnt vmcnt(0)" ::: "memory");
        } else {
            XB_SPIN(xb_ld(&bar[XB_XGEN(b.x)]) == gen, bar);
            __builtin_amdgcn_fence(__ATOMIC_ACQUIRE, "agent");
            asm volatile("s_waitcnt vmcnt(0)" ::: "memory");
        }
    }
    __syncthreads();
}


struct Frame {
    LAS unsigned char* lds;
    volatile LAS unsigned* MISC;
    gu32* ctl;
    int tid, lane, wave;
    int vcu, G;
};
__device__ __forceinline__ float wave_sum(float v) {
#pragma unroll
    for (int o = 1; o < 64; o <<= 1) v += __shfl_xor(v, o);
    return v;
}
template <class Map>
__device__ __forceinline__ void transpose_item(const float* W, int K, int N, const float* gk, bf16* WT, int ldk, Map map, LAS float* scr, int item, int lane) {
    const int nblk = (N + 31) / 32, kb = item / nblk, nb = item % nblk, k0 = 64 * kb, n0 = 32 * nb;
    (void)K;
    float tv[32];
    { const int n = n0 + (lane & 31); const bool ok = n < N; const float* wp = W + (size_t)(k0 + (lane >> 5)) * N + (ok ? n : 0);
#pragma unroll
      for (int i = 0; i < 32; ++i) tv[i] = wp[(size_t)(2 * i) * N];
      if (gk) {
#pragma unroll
          for (int i = 0; i < 32; ++i) tv[i] *= gk[k0 + 2 * i + (lane >> 5)];
      }
#pragma unroll
      for (int i = 0; i < 32; ++i) scr[(2 * i + (lane >> 5)) * 33 + (lane & 31)] = ok ? tv[i] : 0.f; }
    LDS_WAIT(); asm volatile("" ::: "memory");
    const int c = lane & 7;
#pragma unroll
    for (int j = 0; j < 4; ++j) { const int nn = (lane >> 3) + 8 * j, n = n0 + nn; const LAS float* s = scr + (8 * c) * 33 + nn;
        if (n < N) { const int dst = map(n);
            v4u o; o.x = pk2(s[0 * 33], s[1 * 33]); o.y = pk2(s[2 * 33], s[3 * 33]); o.z = pk2(s[4 * 33], s[5 * 33]); o.w = pk2(s[6 * 33], s[7 * 33]);
            *(GAS v4u*)(WT + (size_t)dst * ldk + k0 + 8 * c) = o; } }
    LDS_WAIT(); asm volatile("" ::: "memory");
}
struct MapPlain { __device__ __forceinline__ int operator()(int n) const { return n; } };
struct MapGate { int add; __device__ __forceinline__ int operator()(int n) const { return 256 * (n >> 7) + (n & 127) + add; } };
__device__ __forceinline__ int idx_slot(int d) { return (d < 16) ? d : (d < 32) ? 128 + (d - 16) : (d < 48) ? 16 + (d - 32) : 128 + 16 + (d - 48); }
struct MapIn {
    __device__ __forceinline__ int operator()(int n) const {
        if (n < 1024) { const int kq = n >> 9, nn = n & 511, head = nn >> 6, d = nn & 63; return kq * 512 + 256 * (head >> 2) + 128 * (d >> 5) + 32 * (head & 3) + (d & 31); }
        if (n < 1536) return n;
        if (n < 1792) { const int nn = n - 1536, h = nn >> 6, d = nn & 63; return 2048 + 32 * h + idx_slot(d); }
        if (n < 1856) return 2304 + idx_slot(n - 1792);
        if (n < 1860) return 2304 + 32 + (n - 1856);
        return 1536 + (n - 1860);
    }
};

struct Args { const float* in[16]; float* out; unsigned char* ws; int ph_lo, ph_hi, li, pad; };

__device__ __forceinline__ void weight_items(Frame& F, const Args& a, int set, int gw, int NGW) {
    unsigned char* ws = a.ws;
    LAS float* scr = (LAS float*)(F.lds + RING_OFF + F.wave * 16384);
    const int lane = pg8::lane_id_now();
    const float *f1n = a.in[1], *f1g = a.in[2], *f1u = a.in[3], *f1d = a.in[4], *mixn = a.in[5], *win = a.in[6], *poolw = a.in[9], *pools = a.in[10], *wout = a.in[11],
                *f2n = a.in[12], *f2g = a.in[13], *f2u = a.in[14], *f2d = a.in[15];
    bf16* WGU1 = (bf16*)(ws + WS_WGU1); bf16* WD1 = (bf16*)(ws + WS_WD1); bf16* WIN = (bf16*)(ws + WS_WIN); bf16* WOUT = (bf16*)(ws + WS_WOUT); bf16* WGU2 = (bf16*)(ws + WS_WGU2); bf16* WD2 = (bf16*)(ws + WS_WD2);
    constexpr int I_G = (D / 64) * (DFF / 32), I_D = (DFF / 64) * (D / 32), I_IN = (D / 64) * ((INC + 31) / 32), I_O = (512 / 64) * (D / 32);
    if (set == 0) {
        for (int it = gw; it < 2 * I_G; it += NGW) {
            if (it < I_G) transpose_item(f1g, D, DFF, f1n, WGU1, D, MapGate{0}, scr, it, lane);
            else transpose_item(f1u, D, DFF, f1n, WGU1, D, MapGate{128}, scr, it - I_G, lane);
        }
    } else if (set == 2) {
        for (int it = gw; it < 2 * I_G; it += NGW) {
            if (it < I_G) transpose_item(f2g, D, DFF, f2n, WGU2, D, MapGate{0}, scr, it, lane);
            else transpose_item(f2u, D, DFF, f2n, WGU2, D, MapGate{128}, scr, it - I_G, lane);
        }
    } else if (set == 3) {
        for (int it = gw; it < I_D; it += NGW) transpose_item(f2d, DFF, D, nullptr, WD2, DFF, MapPlain{}, scr, it, lane);
    } else {
        for (int it = gw; it < I_D + I_IN + I_O; it += NGW) {
            int r = it;
            if (r < I_D) { transpose_item(f1d, DFF, D, nullptr, WD1, DFF, MapPlain{}, scr, r, lane); continue; } r -= I_D;
            if (r < I_IN) { transpose_item(win, D, INC, mixn, WIN, D, MapIn{}, scr, r, lane); continue; } r -= I_IN;
            transpose_item(wout, 512, D, nullptr, WOUT, D, MapPlain{}, scr, r, lane);
        }
    }
    if (set == 1) {
        for (int j = gw; j < 256; j += NGW) {
            const int bj = j >> 7, wc = (j >> 5) & 3, i = j & 31;
            const bool covered = (wc == 0) || (wc == 1 && bj == 0 && i < 4);
            if (!covered) { GAS v4u* o = (GAS v4u*)(WIN + (size_t)(2304 + j) * D) + lane; o[0] = (v4u){0u, 0u, 0u, 0u}; o[64] = (v4u){0u, 0u, 0u, 0u}; }
        }
    }
}
__device__ __forceinline__ void wpo_items(Frame& F, const Args& a, int gw, int NGW, int it_lo, int it_hi) {
    unsigned char* ws = a.ws; bf16* WOUT = (bf16*)(ws + WS_WOUT);
    LAS float* scr = (LAS float*)(F.lds + RING_OFF + F.wave * 16384);
    const int lane = pg8::lane_id_now(); const float *poolw = a.in[9], *pools = a.in[10], *wout = a.in[11];
#pragma unroll 1
    for (int it = it_lo + gw; it < it_hi; it += NGW) {
        const int g = it >> 9, nb = (it >> 5) & 15, cb = it & 31, n = nb * 64 + lane;
        float ac[4] = {0.f, 0.f, 0.f, 0.f};
        const float* pw = poolw + ((size_t)g * 128 + cb * 4) * 128;
        const float* wsrc = wout + (size_t)(512 + g * 128) * D + nb * 64; const float* psrc = pools + g * 128;
#pragma unroll 1
        for (int half = 0; half < 2; ++half) {
#pragma unroll
            for (int dd = 0; dd < 64; ++dd)
                __builtin_amdgcn_global_load_lds((const unsigned*)(wsrc + (size_t)(half * 64 + dd) * D) + lane, (LAS unsigned*)(scr + dd * 64), 4, 0, 0);
            asm volatile("s_waitcnt vmcnt(0)" ::: "memory");
#pragma unroll 8
            for (int dd = 0; dd < 64; ++dd) { const float w = scr[dd * 64 + lane] * psrc[half * 64 + dd];
#pragma unroll
                for (int cc = 0; cc < 4; ++cc) ac[cc] = fmaf(pw[cc * 128 + half * 64 + dd], w, ac[cc]); }
            LDS_WAIT(); asm volatile("" ::: "memory");
        }
        *(GAS unsigned long long*)(WOUT + (size_t)n * D + 512 + g * 128 + cb * 4) = (unsigned long long)pk2(ac[0], ac[1]) | ((unsigned long long)pk2(ac[2], ac[3]) << 32);
    }
}
__device__ __forceinline__ void p0_prologue(Frame& F, const Args& a) {
    unsigned char* ws = a.ws;
    const int gw = F.vcu * NWAVES + F.wave, NGW = F.G * NWAVES, lane = pg8::lane_id_now();
    const float* x = a.in[0];
    weight_items(F, a, 0, gw, NGW);
    if (F.G != 256) wpo_items(F, a, gw, NGW, 0, 2048);
    if (F.G != 256) { weight_items(F, a, 1, gw, NGW); weight_items(F, a, 2, gw, NGW); weight_items(F, a, 3, gw, NGW); }
    float* cosH = (float*)(ws + WS_TAB); float* sinH = cosH + SEQ * 32; float* cosI = sinH + SEQ * 32; float* sinI = cosI + SEQ * 16;
    for (int idx = gw * 64 + lane; idx < SEQ * 48; idx += NGW * 64) {
        if (idx < SEQ * 32) { const int p = idx >> 5, i = idx & 31; const float inv = (float)pow(10000.0, -(double)i / 32.0); const float ang = __fmul_rn((float)p, inv); cosH[idx] = (float)cos((double)ang); sinH[idx] = (float)sin((double)ang); }
        else { const int j = idx - SEQ * 32, p = j >> 4, i = j & 15; const float inv = (float)pow(10000.0, -(double)i / 16.0); const float ang = __fmul_rn((float)p, inv); cosI[j] = (float)cos((double)ang); sinI[j] = (float)sin((double)ang); }
    }
    bf16* XB = (bf16*)(ws + WS_XB); float* sspA = (float*)(ws + WS_SSPA);
    for (int m0 = gw; m0 < M; m0 += 4 * NGW) {
        f32x4 v[4][4]; float s[4];
#pragma unroll
        for (int q = 0; q < 4; ++q) { const GAS f32x4* xr = (const GAS f32x4*)(x + (size_t)(m0 + q * NGW) * D) + lane;
#pragma unroll
            for (int j = 0; j < 4; ++j) v[q][j] = xr[64 * j]; }
#pragma unroll
        for (int q = 0; q < 4; ++q) { float a = 0.f;
#pragma unroll
            for (int j = 0; j < 4; ++j) a += (v[q][j].x * v[q][j].x + v[q][j].y * v[q][j].y) + (v[q][j].z * v[q][j].z + v[q][j].w * v[q][j].w);
            s[q] = wave_sum(a); }
#pragma unroll
        for (int q = 0; q < 4; ++q) { const int m = m0 + q * NGW;
            GAS unsigned long long* o8 = (GAS unsigned long long*)(XB + (size_t)m * D) + lane;
#pragma unroll
            for (int j = 0; j < 4; ++j) o8[64 * j] = (unsigned long long)pk2(v[q][j].x, v[q][j].y) | ((unsigned long long)pk2(v[q][j].z, v[q][j].w) << 32);
            if (lane < 16) sspA[(size_t)m * 16 + lane] = (lane == 0) ? s[q] : 0.f; }
    }
}

#ifndef SEL_REP
#define SEL_REP 1
#endif
#ifndef SEL_ABL
#define SEL_ABL 1
#endif
#ifndef POOL_REP
#define POOL_REP 1
#endif
__device__ __forceinline__ int wave_sum_dpp(int v) {
    v += __builtin_amdgcn_update_dpp(0, v, 0x111, 0xf, 0xf, false);
    v += __builtin_amdgcn_update_dpp(0, v, 0x112, 0xf, 0xf, false);
    v += __builtin_amdgcn_update_dpp(0, v, 0x114, 0xf, 0xf, false);
    v += __builtin_amdgcn_update_dpp(0, v, 0x118, 0xf, 0xf, false);
    v += __builtin_amdgcn_update_dpp(0, v, 0x142, 0xa, 0xf, false);
    v += __builtin_amdgcn_update_dpp(0, v, 0x143, 0xc, 0xf, false);
    return __builtin_amdgcn_readlane(v, 63);
}
__device__ __forceinline__ void cnt4(int& na, int& nb, unsigned ka0, unsigned kb0, unsigned ka1, unsigned kb1, unsigned ca, unsigned cb) {
    unsigned long long s0, s1, s2;
    asm volatile("v_cmp_le_u32_e32 vcc, %9, %5\n\t"
                 "v_cmp_le_u32_e64 %2, %10, %6\n\t"
                 "v_cmp_le_u32_e64 %3, %9, %7\n\t"
                 "v_cmp_le_u32_e64 %4, %10, %8\n\t"
                 "v_addc_co_u32_e32 %0, vcc, 0, %0, vcc\n\t"
                 "v_addc_co_u32_e64 %1, %2, 0, %1, %2\n\t"
                 "v_addc_co_u32_e64 %0, %3, 0, %0, %3\n\t"
                 "v_addc_co_u32_e64 %1, %4, 0, %1, %4"
                 : "+v"(na), "+v"(nb), "=&s"(s0), "=&s"(s1), "=&s"(s2) : "v"(ka0), "v"(kb0), "v"(ka1), "v"(kb1), "s"(ca), "s"(cb) : "vcc");
}
template <int NC>
__device__ __forceinline__ void build_mask(const unsigned (&kv)[NC], unsigned thr, int need, int lane, GAS unsigned long long* mrow) {
    unsigned mlo = 0u, mhi = 0u; int tbase = 0;
#pragma unroll
    for (int c = 0; c < NC; ++c) {
        unsigned long long m = __ballot(kv[c] > thr);
        if (need > 0 && tbase < need) {
            const unsigned long long em = __ballot(kv[c] == thr);
            const int ce = __popcll(em);
            if (tbase + ce <= need) m |= em;
            else { const int pre = __builtin_amdgcn_mbcnt_hi((unsigned)(em >> 32), __builtin_amdgcn_mbcnt_lo((unsigned)em, 0u)); m |= __ballot(kv[c] == thr && pre < need - tbase); }
            tbase += ce;
        }
        asm volatile("s_nop 1\n\tv_writelane_b32 %0, %2, %4\n\tv_writelane_b32 %1, %3, %4" : "+v"(mlo), "+v"(mhi) : "s"((unsigned)m), "s"((unsigned)(m >> 32)), "i"(c));
    }
    if (lane < 32) mrow[(size_t)lane * SEQ] = ((unsigned long long)mhi << 32) | mlo;
}
__device__ __forceinline__ unsigned wave_max_dpp(unsigned v) {
    unsigned t;
    t = (unsigned)__builtin_amdgcn_update_dpp(0, (int)v, 0x111, 0xf, 0xf, false); v = v > t ? v : t;
    t = (unsigned)__builtin_amdgcn_update_dpp(0, (int)v, 0x112, 0xf, 0xf, false); v = v > t ? v : t;
    t = (unsigned)__builtin_amdgcn_update_dpp(0, (int)v, 0x114, 0xf, 0xf, false); v = v > t ? v : t;
    t = (unsigned)__builtin_amdgcn_update_dpp(0, (int)v, 0x118, 0xf, 0xf, false); v = v > t ? v : t;
    t = (unsigned)__builtin_amdgcn_update_dpp(0, (int)v, 0x142, 0xa, 0xf, false); v = v > t ? v : t;
    t = (unsigned)__builtin_amdgcn_update_dpp(0, (int)v, 0x143, 0xc, 0xf, false); v = v > t ? v : t;
    return (unsigned)__builtin_amdgcn_readlane((int)v, 63);
}
__device__ __forceinline__ unsigned f2key(float f) { const unsigned u = __float_as_uint(f); return (u & 0x80000000u) ? ~u : (u | 0x80000000u); }
__device__ __forceinline__ float key2f(unsigned k) { return __uint_as_float((k & 0x80000000u) ? (k & 0x7fffffffu) : ~k); }
struct RowSearch {
    unsigned lo, hi, thr; int cl, ch, need, last; float wl, wh; bool act;
    __device__ __forceinline__ void init(bool wanted, int ncausal, int cz0, int cz1, unsigned kmax, unsigned kmin) {
        act = false; thr = 0u; need = 0; lo = 0u; hi = 0u; cl = 0; ch = 0; last = 0; wl = 1.f; wh = 1.f;
        if (!wanted) return;
        if (cz1 <= 256 && cz0 >= 256) { thr = 0x80000000u; need = 256 - cz1; return; }
        act = true;
        if (cz1 > 256) { lo = 0x80000001u; cl = cz1; hi = kmax + 1u; ch = 0; }
        else { lo = kmin; cl = ncausal; hi = 0x80000000u; ch = cz0; }
        wl = (float)(cl - 256); wh = (float)(256 - ch);
    }
    __device__ __forceinline__ unsigned next_cand(int it) {
        if (!act) return 0xffffffffu;
        if (hi - lo <= 1u) { thr = lo; need = 256 - ch; act = false; return 0xffffffffu; }
        const float fl = key2f(lo), fh = key2f(hi);
        unsigned c = f2key((fl * wh + fh * wl) * __builtin_amdgcn_rcpf(wl + wh));
        if (it >= 24) c = lo + ((hi - lo) >> 1);
        if (c <= lo) c = lo + 1u;
        if (c >= hi) c = hi - 1u;
        return c;
    }
    __device__ __forceinline__ void update(unsigned c, int cnt) {
        if (!act) return;
        if (cnt == 256) { thr = c - 1u; need = 0; act = false; }
        else if (cnt > 256) { lo = c; cl = cnt; wl = (float)(cnt - 256); if (last == 1) wh *= 0.5f; last = 1; }
        else { hi = c; ch = cnt; wh = (float)(256 - cnt); if (last == -1) wl *= 0.5f; last = -1; }
    }
};
template <int NC>
__device__ __forceinline__ void select_rows2(const LAS unsigned* sa, int nchunks, int ta, int lane, GAS unsigned long long* ma) {
    unsigned ka[NC], kb[NC];
#pragma unroll
    for (int c = 0; c < NC; ++c) { ka[c] = (c < nchunks) ? sa[64 * c + lane] : 0u; kb[c] = (c < nchunks) ? sa[2048 + 64 * c + lane] : 0u; }
    LDS_WAIT(); __builtin_amdgcn_s_barrier(); asm volatile("" ::: "memory");
    RowSearch A, B;
    if (ta + 2 > 256) {
        int a0 = 0, b0 = 0, a1 = 0, b1 = 0;
#pragma unroll
        for (int c = 0; c < NC; c += 2) cnt4(a0, b0, ka[c], kb[c], ka[c + 1], kb[c + 1], 0x80000000u, 0x80000000u);
#pragma unroll
        for (int c = 0; c < NC; c += 2) cnt4(a1, b1, ka[c], kb[c], ka[c + 1], kb[c + 1], 0x80000001u, 0x80000001u);
        unsigned mxa = 0u, mxb = 0u, mna = 0u, mnb = 0u;
#pragma unroll
        for (int c = 0; c < NC; ++c) { mxa = ka[c] > mxa ? ka[c] : mxa; mxb = kb[c] > mxb ? kb[c] : mxb;
            const unsigned ia = ~(ka[c] - 1u), ib = ~(kb[c] - 1u); mna = ia > mna ? ia : mna; mnb = ib > mnb ? ib : mnb; }
        const int t0s = wave_sum_dpp(a0 | (b0 << 16)), t1s = wave_sum_dpp(a1 | (b1 << 16));
        const unsigned kmxa = wave_max_dpp(mxa), kmxb = wave_max_dpp(mxb), kmna = ~wave_max_dpp(mna) + 1u, kmnb = ~wave_max_dpp(mnb) + 1u;
        A.init(ta + 1 > 256, ta + 1, t0s & 0xffff, t1s & 0xffff, kmxa, kmna);
        B.init(true, ta + 2, t0s >> 16, t1s >> 16, kmxb, kmnb);
        for (int it = 0; it < 64; ++it) {
            const unsigned ca = A.next_cand(it), cb = B.next_cand(it);
            if (!(A.act || B.act)) break;
            int na = 0, nb = 0;
#pragma unroll
            for (int c = 0; c < NC; c += 2) cnt4(na, nb, ka[c], kb[c], ka[c + 1], kb[c + 1], ca, cb);
            const int tot = wave_sum_dpp(na | (nb << 16));
            A.update(ca, tot & 0xffff); B.update(cb, tot >> 16);
        }
    } else { A.init(false, 0, 0, 0, 0u, 0u); B.init(false, 0, 0, 0, 0u, 0u); }
    build_mask<NC>(ka, A.thr, A.need, lane, ma);
    build_mask<NC>(kb, B.thr, B.need, lane, ma + 1);
}
__device__ __forceinline__ void select_phase(Frame& F, const bf16* QI, const bf16* KI, const float* WI, unsigned long long* MASK, const bf16* U, bf16* MIX) {
    LAS unsigned* SC = (LAS unsigned*)(F.lds + RING_OFF);
    const int lane = pg8::lane_id_now(), wave = F.wave, fr = lane & 15, fq = lane >> 4;
    LAS unsigned* jobctr = (LAS unsigned*)(F.lds + LDSCTL_OFF + 512);
    if (wave * 64 + lane < 16) jobctr[wave * 64 + lane] = 0u;
    LDS_WAIT(); __builtin_amdgcn_s_barrier(); asm volatile("" ::: "memory");
    pg8::bf16x8 afr[4][2]; f32x4 w[4];
#pragma unroll 1
    for (int uu_ = 0; uu_ < 4 * SEL_REP; ++uu_) {
        const int ui = uu_ & 3, b = F.vcu >> 5, j = F.vcu & 31;
        const int g = (ui == 0) ? 127 - j : (ui == 1) ? 64 + j : (ui == 2) ? 63 - j : j;
        const int t0 = 16 * g; const size_t rowbase = (size_t)b * SEQ;
        const int nchunks = (t0 + 16 + 63) >> 6, ntiles = nchunks * 4;
        if (uu_ == 0) {
#pragma unroll
            for (int h = 0; h < 4; ++h)
#pragma unroll
                for (int ks = 0; ks < 2; ++ks) afr[h][ks] = *(const pg8::bf16x8*)(QI + (rowbase + t0 + fr) * 256 + 64 * h + 32 * ks + 8 * fq);
#pragma unroll
            for (int r = 0; r < 4; ++r) w[r] = *(const f32x4*)(WI + (rowbase + t0 + 4 * fq + r) * 4);
        }
        if (uu_ < 4 || SEL_ABL != 3) {
        LAS unsigned* ctr = jobctr + uu_;
        int job; { unsigned j_ = 0u; if (lane == 0) j_ = __hip_atomic_fetch_add(ctr, 1u, __ATOMIC_RELAXED, __HIP_MEMORY_SCOPE_WORKGROUP); job = __builtin_amdgcn_readfirstlane((int)j_); }
        pg8::bf16x8 bfr[4][2];
        if (job < nchunks) {
#pragma unroll
            for (int i = 0; i < 4; ++i) { const bf16* kp = KI + ((rowbase >> 4) + 4 * job + i) * 1024 + (fq * 16 + fr) * 8; bfr[i][0] = *(const pg8::bf16x8*)kp; bfr[i][1] = *(const pg8::bf16x8*)(kp + 512); }
        }
#pragma unroll 1
        while (job < nchunks) {
            int nxt; { unsigned j_ = 0u; if (lane == 0) j_ = __hip_atomic_fetch_add(ctr, 1u, __ATOMIC_RELAXED, __HIP_MEMORY_SCOPE_WORKGROUP); nxt = __builtin_amdgcn_readfirstlane((int)j_); }
            pg8::bf16x8 bnx[4][2];
            { const int jn = (nxt < nchunks) ? nxt : job;
#pragma unroll
              for (int i = 0; i < 4; ++i) { const bf16* kp = KI + ((rowbase >> 4) + 4 * jn + i) * 1024 + (fq * 16 + fr) * 8; bnx[i][0] = *(const pg8::bf16x8*)kp; bnx[i][1] = *(const pg8::bf16x8*)(kp + 512); } }
#pragma unroll
            for (int i = 0; i < 4; ++i) {
                const int tile = 4 * job + i;
                {
                    const int key = 16 * tile + fr;
                    f32x4 acc[4];
#pragma unroll
                    for (int h = 0; h < 4; ++h) {
                        acc[h] = __builtin_amdgcn_mfma_f32_16x16x32_bf16(afr[h][0], bfr[i][0], (f32x4){0.f, 0.f, 0.f, 0.f}, 0, 0, 0);
                        acc[h] = __builtin_amdgcn_mfma_f32_16x16x32_bf16(afr[h][1], bfr[i][1], acc[h], 0, 0, 0);
                    }
                    const bool edge = 16 * tile + 15 > t0;
#pragma unroll
                    for (int r = 0; r < 4; ++r) {
                        float sc = 0.f;
#pragma unroll
                        for (int h = 0; h < 4; ++h) { const int ri = __float_as_int(acc[h][r]); sc = fmaf(w[r][h], __int_as_float(ri > 0 ? ri : 0), sc); }
                        const int u = __float_as_int(sc);
                        unsigned sk = (unsigned)u ^ ((unsigned)(u >> 31) | 0x80000000u);
                        if (edge) sk = (key <= t0 + 4 * fq + r) ? sk : 0u;
                        SC[(4 * fq + r) * 2048 + key] = sk;
                    }
                }
            }
#pragma unroll
            for (int i = 0; i < 4; ++i) { bfr[i][0] = bnx[i][0]; bfr[i][1] = bnx[i][1]; }
            job = nxt;
        }
        }
        if (uu_ + 1 < 4 * SEL_REP) {
            const int ui2 = (uu_ + 1) & 3, g2 = (ui2 == 0) ? 127 - j : (ui2 == 1) ? 64 + j : (ui2 == 2) ? 63 - j : j, t02 = 16 * g2;
#pragma unroll
            for (int h = 0; h < 4; ++h)
#pragma unroll
                for (int ks = 0; ks < 2; ++ks) afr[h][ks] = *(const pg8::bf16x8*)(QI + (rowbase + t02 + fr) * 256 + 64 * h + 32 * ks + 8 * fq);
#pragma unroll
            for (int r = 0; r < 4; ++r) w[r] = *(const f32x4*)(WI + (rowbase + t02 + 4 * fq + r) * 4);
        }
        LDS_WAIT(); __builtin_amdgcn_s_barrier(); asm volatile("" ::: "memory");
        {
            const int ncr = (nchunks + 3) >> 2;
            const int rl = 2 * wave, t = t0 + rl;
            const LAS unsigned* srow = SC + rl * 2048;
            GAS unsigned long long* mrow = (GAS unsigned long long*)MASK + (uu_ >= 4 ? (size_t)202 * 1024 * 1024 / 8 : (size_t)0) + (size_t)b * 32 * SEQ + t;
            if (uu_ < 4 || SEL_ABL == 1 || SEL_ABL == 3) switch (ncr) {
                case 1: select_rows2<4>(srow, nchunks, t, lane, mrow); break;
                case 2: select_rows2<8>(srow, nchunks, t, lane, mrow); break;
                case 3: select_rows2<12>(srow, nchunks, t, lane, mrow); break;
                case 4: select_rows2<16>(srow, nchunks, t, lane, mrow); break;
                case 5: select_rows2<20>(srow, nchunks, t, lane, mrow); break;
                case 6: select_rows2<24>(srow, nchunks, t, lane, mrow); break;
                case 7: select_rows2<28>(srow, nchunks, t, lane, mrow); break;
                default: select_rows2<32>(srow, nchunks, t, lane, mrow); break;
            }
            else { LDS_WAIT(); __builtin_amdgcn_s_barrier(); asm volatile("" ::: "memory"); }
        }
    }
    const int gw = F.vcu * NWAVES + F.wave, NGW = F.G * NWAVES;
#pragma unroll 1
    for (int task = gw; task < POOL_REP * (M / 4); task += NGW) {
        const int row0 = (task & (M / 4 - 1)) * 4, tq = row0 & (SEQ - 1);
        v4u uu[19];
#pragma unroll
        for (int i = 0; i < 19; ++i) { const int dt = i - 15; uu[i] = (tq + dt >= 0) ? *(const GAS v4u*)(U + (size_t)(row0 + dt) * 512 + 8 * lane) : (v4u){0u, 0u, 0u, 0u}; }
        const int gsel = lane >> 4;
#pragma unroll
        for (int i = 0; i < 4; ++i) {
            const int t = tq + i, wl = 2 << gsel, n = (t + 1 < wl) ? (t + 1) : wl; const float inv = 1.0f / (float)n;
            unsigned ow[4];
#pragma unroll
            for (int q = 0; q < 4; ++q) {
                float lo[16], hi[16];
#pragma unroll
                for (int jj = 0; jj < 16; ++jj) { const unsigned x = uu[15 + i - jj][q]; lo[jj] = __uint_as_float(x << 16); hi[jj] = __uint_as_float(x & 0xffff0000u); }
                const float l2 = lo[0] + lo[1], h2 = hi[0] + hi[1];
                const float l4 = l2 + (lo[2] + lo[3]), h4 = h2 + (hi[2] + hi[3]);
                const float l8 = l4 + ((lo[4] + lo[5]) + (lo[6] + lo[7])), h8 = h4 + ((hi[4] + hi[5]) + (hi[6] + hi[7]));
                const float l16 = l8 + (((lo[8] + lo[9]) + (lo[10] + lo[11])) + ((lo[12] + lo[13]) + (lo[14] + lo[15]))), h16 = h8 + (((hi[8] + hi[9]) + (hi[10] + hi[11])) + ((hi[12] + hi[13]) + (hi[14] + hi[15])));
                const float sl = (gsel == 0) ? l2 : (gsel == 1) ? l4 : (gsel == 2) ? l8 : l16, sh = (gsel == 0) ? h2 : (gsel == 1) ? h4 : (gsel == 2) ? h8 : h16;
                ow[q] = pk2(sl * inv - lo[0], sh * inv - hi[0]);
            }
            *(GAS v4u*)(MIX + (size_t)(row0 + i) * 1024 + 512 + 8 * lane) = (v4u){ow[0], ow[1], ow[2], ow[3]};
        }
    }
}

#include <hip/hip_bf16.h>
namespace attn_body {
using bf16=__hip_bfloat16;
using bf16x8=__attribute__((ext_vector_type(8)))short;
using s16x4=__attribute__((ext_vector_type(4)))short;
using f32x16=__attribute__((ext_vector_type(16)))float;
using u32x4=__attribute__((ext_vector_type(4)))unsigned;
constexpr int BATCH=8,NHEAD=8,SEQ=2048,D=64,KP=512,OP=1024;
constexpr int NW=8,QBLK=32,QB=QBLK*NW,KVBLK=64,NQB=SEQ/QB;
constexpr int ATTN_UNIT_ROWS=QB;
__device__ __forceinline__ int crow(int r,int hi){return (r&3)+8*(r>>2)+4*hi;}
#define SBAR() __builtin_amdgcn_sched_barrier(0)
__device__ __forceinline__ void cmask(f32x16&p0,f32x16&p1,int jb,int qrel,int hi){
  const float NEG=-INFINITY; int kb=64*jb+4*hi;
  #pragma unroll
  for(int r=0;r<16;++r){int kv=kb+(r&3)+8*(r>>2); if(kv>qrel)p0[r]=NEG; if(kv+32>qrel)p1[r]=NEG;}
}

constexpr int NSLOT=3, SLOTB=8192;
constexpr int LDS_K=0, LDS_V=NSLOT*SLOTB, LDS_WS=2*NSLOT*SLOTB, LDS_OST=LDS_WS+NW*64*4, LDS_BYTES=LDS_OST+NW*4096, LDS_MASK=LDS_BYTES, LDS_TOTAL=LDS_MASK+32*2048;
constexpr float C2=0.125f*1.4426950408889634f;
__device__ __forceinline__ void glds16(const void*sbase,unsigned voff,unsigned lds_dst){unsigned keep;
  asm volatile("s_mov_b32 %0, m0\n\ts_mov_b32 m0, %2\n\ts_nop 4\n\tglobal_load_lds_dwordx4 %1, %3\n\ts_mov_b32 m0, %0":"=&s"(keep):"v"(voff),"s"(lds_dst),"s"(sbase):"memory");}
__device__ __forceinline__ float max3f(float a,float b,float c){float r;asm("v_max3_f32 %0, %1, %2, %3":"=v"(r):"v"(a),"v"(b),"v"(c));return r;}
__device__ __forceinline__ float max2f(float a,float b){float r;asm("v_max_f32_e32 %0, %1, %2":"=v"(r):"v"(a),"v"(b));return r;}
__device__ __forceinline__ float fadd_s(float a,float b){float r;asm("v_add_f32_e32 %0, %1, %2":"=v"(r):"v"(a),"v"(b));return r;}
__device__ __forceinline__ float fsub_s(float a,float b){float r;asm("v_sub_f32_e32 %0, %1, %2":"=v"(r):"v"(a),"v"(b));return r;}
typedef float f32x2_t __attribute__((ext_vector_type(2))); typedef __bf16 bf16x2_t __attribute__((ext_vector_type(2)));
__device__ __forceinline__ unsigned cvtpk_s(float lo,float hi){f32x2_t v={lo,hi};bf16x2_t b=__builtin_convertvector(v,bf16x2_t);return __builtin_bit_cast(unsigned,b);}
#define WAIT_BAR(N) asm volatile("s_waitcnt vmcnt(" #N ") lgkmcnt(0)\n\ts_barrier":::"memory")

__device__ __forceinline__ void qkt(f32x16&p0,f32x16&p1,const char*Kslot,const bf16x8*qr,const f32x16&negm,int r32,int hi){
  const char*kb=Kslot+hi*1024+r32*16;
  #pragma unroll
  for(int d0=0;d0<4;++d0){
    const bf16x8 b0=*reinterpret_cast<const bf16x8*>(kb+d0*2048);
    const bf16x8 b1=*reinterpret_cast<const bf16x8*>(kb+d0*2048+512);
    if(d0==0){p0=__builtin_amdgcn_mfma_f32_32x32x16_bf16(b0,qr[0],negm,0,0,0);p1=__builtin_amdgcn_mfma_f32_32x32x16_bf16(b1,qr[0],negm,0,0,0);}
    else{p0=__builtin_amdgcn_mfma_f32_32x32x16_bf16(b0,qr[d0],p0,0,0,0);p1=__builtin_amdgcn_mfma_f32_32x32x16_bf16(b1,qr[d0],p1,0,0,0);}}
}
typedef __attribute__((address_space(3))) const char* lds_cptr;
typedef short v4i16_t __attribute__((ext_vector_type(4)));
__device__ __forceinline__ void kload8(bf16x8*kf,lds_cptr kp){
  kf[0]=*(const __attribute__((address_space(3))) bf16x8*)(kp);      kf[1]=*(const __attribute__((address_space(3))) bf16x8*)(kp+512);
  kf[2]=*(const __attribute__((address_space(3))) bf16x8*)(kp+2048); kf[3]=*(const __attribute__((address_space(3))) bf16x8*)(kp+2560);
  kf[4]=*(const __attribute__((address_space(3))) bf16x8*)(kp+4096); kf[5]=*(const __attribute__((address_space(3))) bf16x8*)(kp+4608);
  kf[6]=*(const __attribute__((address_space(3))) bf16x8*)(kp+6144); kf[7]=*(const __attribute__((address_space(3))) bf16x8*)(kp+6656);
}
__device__ __forceinline__ void kload2(bf16x8*kf,lds_cptr kp,int j){ kf[2*j]=*(const __attribute__((address_space(3))) bf16x8*)(kp+j*2048); kf[2*j+1]=*(const __attribute__((address_space(3))) bf16x8*)(kp+j*2048+512); }
__device__ __forceinline__ s16x4 vtr(lds_cptr p){ return __builtin_bit_cast(s16x4,__builtin_amdgcn_ds_read_tr16_b64_v4i16((__attribute__((address_space(3))) v4i16_t*)p)); }
__device__ __forceinline__ float rowmax(const f32x16&p0,const f32x16&p1){
  float a=max3f(p0[0],p0[1],p1[0]),b=max3f(p0[2],p0[3],p1[1]);a=max3f(a,p1[2],p1[3]);
  #pragma unroll
  for(int r=4;r<16;r+=4){a=max3f(a,p0[r],p0[r+1]);b=max3f(b,p0[r+2],p0[r+3]);a=max3f(a,p1[r],p1[r+1]);b=max3f(b,p1[r+2],p1[r+3]);}
  const float m=max2f(a,b);
  auto rr=__builtin_amdgcn_permlane32_swap(__float_as_uint(m),__float_as_uint(m),false,false);
  return max2f(__uint_as_float(rr[0]),__uint_as_float(rr[1]));
}
__device__ __forceinline__ void pv(f32x16*o,int vb,bf16x8 pa0,bf16x8 pa1,bf16x8 pa2,bf16x8 pa3){
  #pragma unroll
  for(int d0=0;d0<2;++d0){s16x4 lo[4],hi[4];
    #pragma unroll
    for(int ks=0;ks<4;++ks){
      asm volatile("ds_read_b64_tr_b16 %0,%1 offset:%c2":"=&v"(lo[ks]):"v"(vb),"i"(d0*4096+ks*1024):"memory");
      asm volatile("ds_read_b64_tr_b16 %0,%1 offset:%c2":"=&v"(hi[ks]):"v"(vb),"i"(d0*4096+ks*1024+512):"memory");}
    asm volatile("s_waitcnt lgkmcnt(0)":::"memory");SBAR();
    #define PK(k) (bf16x8){lo[k][0],lo[k][1],lo[k][2],lo[k][3],hi[k][0],hi[k][1],hi[k][2],hi[k][3]}
    o[d0]=__builtin_amdgcn_mfma_f32_32x32x16_bf16(pa0,PK(0),o[d0],0,0,0);
    o[d0]=__builtin_amdgcn_mfma_f32_32x32x16_bf16(pa1,PK(1),o[d0],0,0,0);
    o[d0]=__builtin_amdgcn_mfma_f32_32x32x16_bf16(pa2,PK(2),o[d0],0,0,0);
    o[d0]=__builtin_amdgcn_mfma_f32_32x32x16_bf16(pa3,PK(3),o[d0],0,0,0);
    #undef PK
  }
}

#ifndef ATTN_STORE16
#define ATTN_STORE16(p,v) (*(u32x4*)(p)=(v))
#endif
template<int THRL> __device__ __forceinline__ void attn_unit(int b,int h,int qb,const bf16*Q,const bf16*__restrict__ K,const bf16*__restrict__ V,bf16*O,const unsigned long long*MASKT,char*shm,const int wave_id){
  const int wid=wave_id,lane=pg8::lane_id_now(),tid=wid*64+lane,r32=lane&31,hi=lane>>5;
  const long rowbase=(long)b*SEQ; const int q0=qb*QB; const int NT=(q0+QB)/KVBLK;
  const bf16*Qw=Q+(rowbase+q0+wid*QBLK)*KP+h*D;
  const bf16*Kh=K+((long)(b*NHEAD+h)*(SEQ/KVBLK))*4096,*Vh=V+((long)(b*NHEAD+h)*(SEQ/KVBLK))*4096;
  const unsigned lds0=(unsigned)(uintptr_t)shm;
  float*wsf=(float*)(shm+LDS_WS)+wid*64;
  const bf16*ksrc=Kh+wid*512,*vsrc=Vh+wid*512; const unsigned dmaoff=(unsigned)lane*16u;
  const unsigned kdst=lds0+LDS_K+wid*1024, vdst=lds0+LDS_V+wid*1024;
  #define DMA_K(t,slot) glds16(ksrc+(long)(t)*4096,dmaoff,(unsigned)__builtin_amdgcn_readfirstlane(kdst+(slot)))
  #define DMA_V(t,slot) glds16(vsrc+(long)(t)*4096,dmaoff,(unsigned)__builtin_amdgcn_readfirstlane(vdst+(slot)))
  const char*Kbase=shm+LDS_K; bf16x8 kf[8];
  const lds_cptr shm3=(lds_cptr)shm; const lds_cptr kp0=shm3+LDS_K+hi*1024+r32*16; const lds_cptr vp0=shm3+LDS_V+((lane>>4)&1)*32+(lane&3)*8+(4*hi+((lane&15)>>2))*64;
  { int tl=tid; asm volatile("":"+v"(tl));
    const int npc=NT*128; const unsigned long long*msrc=MASKT+((long)b*32)*SEQ+q0; u32x4 mv[8];
    #pragma unroll
    for(int i=0;i<8;++i){ const int p=tl+i*NW*64; if(p<npc)mv[i]=*reinterpret_cast<const u32x4*>(msrc+(long)(p>>7)*SEQ+(p&127)*2); }
    #pragma unroll
    for(int i=0;i<8;++i){ const int p=tl+i*NW*64; if(p<npc)*reinterpret_cast<__attribute__((address_space(3))) u32x4*>((__attribute__((address_space(3))) char*)(lds_cptr)shm+LDS_MASK+(p>>7)*2048+(p&127)*16)=mv[i]; } }
  asm volatile("s_waitcnt vmcnt(0) lgkmcnt(0)":::"memory");
  DMA_K(0,0);DMA_V(0,0);DMA_K(1,SLOTB);
  bf16x8 qr[4];
  #pragma unroll
  for(int d0=0;d0<4;++d0)qr[d0]=*reinterpret_cast<const bf16x8*>(&Qw[(long)r32*KP+d0*16+hi*8]);
  #define BP(r) (((r)&3)+8*((r)>>2))
  #define EXM(x,w,r) __uint_as_float(__float_as_uint(__builtin_amdgcn_exp2f(x))&(unsigned)__builtin_amdgcn_sbfe((int)(w),BP(r),1))
  #define MASKLD(tt,m0,m1) int ro_=r32; asm volatile("":"+v"(ro_)); const unsigned long long mw_=*(const __attribute__((address_space(3))) unsigned long long*)((lds_cptr)shm+LDS_MASK+wid*(QBLK*8)+ro_*8+(tt)*2048); const unsigned m0=((unsigned)mw_)>>(4*hi),m1=((unsigned)(mw_>>32))>>(4*hi)
  float mhat=0.f,l_reg=0.f;f32x16 o[2];o[0]=f32x16{};o[1]=f32x16{};f32x16 negm=f32x16{};asm volatile("":"+v"(negm));
  const int qrel=wid*QBLK+r32;
  #define CMASK(P0,P1,t) do{}while(0)
  bool resc=false;
  #define START(P0,P1) do{ const float rm=rowmax(P0,P1); resc=false; \
    { const float dl=rm; mhat=fadd_s(mhat,dl); \
      _Pragma("unroll") for(int r=0;r<16;++r){P0[r]=fsub_s(P0[r],dl);P1[r]=fsub_s(P1[r],dl);} \
      _Pragma("unroll") for(int r=0;r<16;++r)negm[r]=-mhat; asm volatile("":"+v"(negm)); } \
    _Pragma("unroll") for(int r=0;r<16;++r)P0[r]=EXM(P0[r],mS0,r); }while(0)
  #define RESC() do{ if(resc){ asm volatile("s_waitcnt lgkmcnt(0)":::"memory"); \
      _Pragma("unroll") for(int d_=0;d_<2;++d_) _Pragma("unroll") for(int r=0;r<16;++r)o[d_][r]*=wsf[crow(r,hi)]; } }while(0)
  f32x16 pA0,pA1,pB0,pB1;
  int sl_prev=0,sl_cur=0,sl_next=SLOTB;
  #define ROT() do{sl_prev=sl_cur;sl_cur=sl_next;sl_next=(sl_next==(NSLOT-1)*SLOTB)?0:sl_next+SLOTB;}while(0)
  DMA_K(2,2*SLOTB);
  WAIT_BAR(3);
  qkt(pA0,pA1,Kbase,qr,negm,r32,hi);asm volatile("s_nop 15\n\ts_nop 7":"+v"(pA0),"+v"(pA1));CMASK(pA0,pA1,0);
  { MASKLD(0,mS0,mS1);
  START(pA0,pA1);
  _Pragma("unroll") for(int r=0;r<16;++r)pA1[r]=EXM(pA1[r],mS1,r); }
  WAIT_BAR(0);
  DMA_K(3,0);DMA_V(1,SLOTB);
  ROT();
  kload8(kf,kp0+sl_cur);
  WAIT_BAR(2);
  s16x4 vlo[8],vhi[8]; u32x4 pw0,pw1,pw2,pw3;
  #define PKW(P,B) cvtpk_s(P[B],P[B+1])
  #define PAF(k) __builtin_bit_cast(bf16x8,pw##k)
  #define VFR(i) (bf16x8){vlo[i][0],vlo[i][1],vlo[i][2],vlo[i][3],vhi[i][0],vhi[i][1],vhi[i][2],vhi[i][3]}
  #define PIN(x) asm volatile("":"+v"(x))
  #define MX3(a,b,c) __builtin_fmaxf(__builtin_fmaxf((a),(b)),(c))
  #define GAPA(MF,A0,A1,A2,A3,W0,W1,PW) do{ MF; sacc+=A0; sacc+=A1; sacc+=A2; sacc+=A3; PIN(sacc); W0; W1; PIN(PW); SBAR(); }while(0)
  #define EX(v) __builtin_amdgcn_exp2f(v)
  #define GAPB(MF,X,B,W) do{ MF; X[B]=EXM(X[B],W,B); X[B+1]=EXM(X[B+1],W,B+1); X[B+2]=EXM(X[B+2],W,B+2); X[B+3]=EXM(X[B+3],W,B+3); PIN(X); SBAR(); }while(0)
  #define VRD(i) do{ vlo[i]=vtr(vp_+(((i)>>2)*4096+((i)&3)*1024)); vhi[i]=vtr(vp_+(((i)>>2)*4096+((i)&3)*1024+512)); }while(0)
  #define KRD(G,j) do{ if(G){ kload2(kf,kp0+sl_next,j); SBAR(); } }while(0)
  #define STEP(C0,C1,P0,P1,t,GK,GV,GL) do{ SBAR(); \
    const lds_cptr vp_=vp0+sl_prev; \
    VRD(0); SBAR(); float sacc=(P0[0]+P0[1]); \
    GAPA(C0=__builtin_amdgcn_mfma_f32_32x32x16_bf16(kf[0],qr[0],negm,0,0,0), P0[2],P0[3],P0[4],P0[5],     pw0[0]=PKW(P0,0), pw0[1]=PKW(P0,2), pw0); \
    VRD(4); SBAR(); GAPA(C1=__builtin_amdgcn_mfma_f32_32x32x16_bf16(kf[1],qr[0],negm,0,0,0), P0[6],P0[7],P0[8],P0[9],     pw0[2]=PKW(P0,4), pw0[3]=PKW(P0,6), pw0); \
    VRD(1); SBAR(); GAPA(C0=__builtin_amdgcn_mfma_f32_32x32x16_bf16(kf[2],qr[1],C0,0,0,0),   P0[10],P0[11],P0[12],P0[13], pw1[0]=PKW(P0,8), pw1[1]=PKW(P0,10), pw1); \
    VRD(5); SBAR(); GAPA(C1=__builtin_amdgcn_mfma_f32_32x32x16_bf16(kf[3],qr[1],C1,0,0,0),   P0[14],P0[15],P1[0],P1[1],   pw1[2]=PKW(P0,12),pw1[3]=PKW(P0,14), pw1); \
    VRD(2); SBAR(); GAPA(C0=__builtin_amdgcn_mfma_f32_32x32x16_bf16(kf[4],qr[2],C0,0,0,0),   P1[2],P1[3],P1[4],P1[5],     pw2[0]=PKW(P1,0), pw2[1]=PKW(P1,2), pw2); \
    VRD(6); SBAR(); GAPA(C1=__builtin_amdgcn_mfma_f32_32x32x16_bf16(kf[5],qr[2],C1,0,0,0),   P1[6],P1[7],P1[8],P1[9],     pw2[2]=PKW(P1,4), pw2[3]=PKW(P1,6), pw2); \
    VRD(3); SBAR(); GAPA(C0=__builtin_amdgcn_mfma_f32_32x32x16_bf16(kf[6],qr[3],C0,0,0,0),   P1[10],P1[11],P1[12],P1[13], pw3[0]=PKW(P1,8), pw3[1]=PKW(P1,10), pw3); \
    VRD(7); SBAR(); GAPA(C1=__builtin_amdgcn_mfma_f32_32x32x16_bf16(kf[7],qr[3],C1,0,0,0),   P1[14],P1[15],0.f,0.f,       pw3[2]=PKW(P1,12),pw3[3]=PKW(P1,14), pw3); \
    l_reg+=sacc; \
    if(GK){DMA_K((t)+3,sl_cur);} if(GV){DMA_V((t)+1,sl_next);} \
    MASKLD(t,mA_,mB_); \
    { float a=MX3(C0[0],C0[1],C1[0]),b=MX3(C0[2],C0[3],C1[1]); a=MX3(a,C1[2],C1[3]); \
      _Pragma("unroll") for(int r=4;r<16;r+=4){a=MX3(a,C0[r],C0[r+1]);b=MX3(b,C0[r+2],C0[r+3]);a=MX3(a,C1[r],C1[r+1]);b=MX3(b,C1[r+2],C1[r+3]);} \
      float rm=__builtin_fmaxf(a,b); { auto rr=__builtin_amdgcn_permlane32_swap(__float_as_uint(rm),__float_as_uint(rm),false,false); rm=__builtin_fmaxf(__uint_as_float(rr[0]),__uint_as_float(rr[1])); } \
      resc=false; \
      if(__builtin_expect(__any(rm>(float)THRL),0)){ const float dl=__builtin_fmaxf(rm,0.f); mhat+=dl; \
        _Pragma("unroll") for(int r=0;r<16;++r){C0[r]-=dl;C1[r]-=dl;} \
        _Pragma("unroll") for(int r=0;r<16;++r)negm[r]=-mhat; asm volatile("":"+v"(negm)); \
        const float f=__builtin_amdgcn_exp2f(-dl); l_reg*=f; { int rq_=r32; asm volatile("":"+v"(rq_)); if(hi==0)wsf[rq_]=f; } resc=true; } } \
    SBAR(); \
    GAPB(o[0]=__builtin_amdgcn_mfma_f32_32x32x16_bf16(PAF(0),VFR(0),o[0],0,0,0), C0,0,mA_); \
    GAPB(o[1]=__builtin_amdgcn_mfma_f32_32x32x16_bf16(PAF(0),VFR(4),o[1],0,0,0), C0,4,mA_); \
    KRD(GL,0); GAPB(o[0]=__builtin_amdgcn_mfma_f32_32x32x16_bf16(PAF(1),VFR(1),o[0],0,0,0), C0,8,mA_); \
    KRD(GL,1); GAPB(o[1]=__builtin_amdgcn_mfma_f32_32x32x16_bf16(PAF(1),VFR(5),o[1],0,0,0), C0,12,mA_); \
    KRD(GL,2); GAPB(o[0]=__builtin_amdgcn_mfma_f32_32x32x16_bf16(PAF(2),VFR(2),o[0],0,0,0), C1,0,mB_); \
    KRD(GL,3); GAPB(o[1]=__builtin_amdgcn_mfma_f32_32x32x16_bf16(PAF(2),VFR(6),o[1],0,0,0), C1,4,mB_); \
    GAPB(o[0]=__builtin_amdgcn_mfma_f32_32x32x16_bf16(PAF(3),VFR(3),o[0],0,0,0), C1,8,mB_); \
    GAPB(o[1]=__builtin_amdgcn_mfma_f32_32x32x16_bf16(PAF(3),VFR(7),o[1],0,0,0), C1,12,mB_); \
    }while(0)
  int t=1;
  #undef CMASK
  #define CMASK(P0,P1,t) do{}while(0)
  for(;t+5<NT;t+=2){
    STEP(pB0,pB1,pA0,pA1,t,true,true,true);     WAIT_BAR(2); RESC(); ROT();
    STEP(pA0,pA1,pB0,pB1,t+1,true,true,true);   WAIT_BAR(2); RESC(); ROT();
  }
  #undef CMASK
  #define CMASK(P0,P1,t) do{}while(0)
  #define ENDW(tt) do{ if((tt)+3<NT){WAIT_BAR(2);} else if((tt)+2<NT){WAIT_BAR(1);} else {WAIT_BAR(0);} }while(0)
  for(;t+1<NT;t+=2){
    STEP(pB0,pB1,pA0,pA1,t,(t+3<NT),(t+1<NT),(t+1<NT));       ENDW(t);   RESC(); ROT();
    STEP(pA0,pA1,pB0,pB1,t+1,(t+4<NT),(t+2<NT),(t+2<NT));     ENDW(t+1); RESC(); ROT();
  }
  STEP(pB0,pB1,pA0,pA1,NT-1,false,false,false); RESC();
  { float sacc=pB0[0]+pB0[1]; _Pragma("unroll") for(int r=2;r<16;++r)sacc+=pB0[r]; _Pragma("unroll") for(int r=0;r<16;++r)sacc+=pB1[r]; l_reg+=sacc;
    pw0=(u32x4){PKW(pB0,0),PKW(pB0,2),PKW(pB0,4),PKW(pB0,6)};pw1=(u32x4){PKW(pB0,8),PKW(pB0,10),PKW(pB0,12),PKW(pB0,14)};pw2=(u32x4){PKW(pB1,0),PKW(pB1,2),PKW(pB1,4),PKW(pB1,6)};pw3=(u32x4){PKW(pB1,8),PKW(pB1,10),PKW(pB1,12),PKW(pB1,14)};
    SBAR(); { int lq_=lane; asm volatile("":"+v"(lq_)); const int vb0=(int)(lds0+LDS_V)+((lq_>>4)&1)*32+(lq_&3)*8+(4*(lq_>>5)+((lq_&15)>>2))*64; pv(o,vb0+sl_cur,PAF(0),PAF(1),PAF(2),PAF(3)); } }
  #undef PKW
  #undef PAF
  #undef VFR
  #undef PIN
  #undef MX3
  #undef GAPA
  #undef GAPB
  #undef EX
  #undef VRD
  #undef KRD
  #undef STEP
  #undef ENDW
  {auto rr=__builtin_amdgcn_permlane32_swap(__float_as_uint(l_reg),__float_as_uint(l_reg),false,false);l_reg=__uint_as_float(rr[0])+__uint_as_float(rr[1]);}
  if(hi==0)wsf[32+r32]=l_reg;asm volatile("s_waitcnt lgkmcnt(0)":::"memory");
  float rli[16];
  #pragma unroll
  for(int r=0;r<16;++r)rli[r]=__builtin_amdgcn_rcpf(wsf[32+crow(r,hi)]);
  bf16*Ow=O+(rowbase+q0+wid*QBLK)*OP+h*D;
  { bf16*stg=(bf16*)(shm+LDS_OST)+wid*2048;
    #pragma unroll
    for(int r=0;r<16;++r){const int orow=crow(r,hi);
      #pragma unroll
      for(int d0=0;d0<2;++d0)stg[orow*64+d0*32+r32]=__float2bfloat16(o[d0][r]*rli[r]);}
    asm volatile("s_waitcnt lgkmcnt(0)":::"memory");
    #pragma unroll
    for(int i=0;i<4;++i){const int row=i*8+(lane>>3),ch=lane&7; const u32x4 v=*(const u32x4*)(stg+row*64+ch*8); ATTN_STORE16(Ow+(long)row*OP+ch*8,v);} }
  asm volatile("s_waitcnt lgkmcnt(0)\n\ts_barrier":::"memory");
  #undef DMA_K
  #undef DMA_V
  #undef CMASK
  #undef START
  #undef RESC
  #undef ROT
  #undef BP
  #undef EXM
  #undef MASKLD
}
constexpr int ATTN_LDS_BYTES=LDS_BYTES;
struct AttnTensors { const bf16* Q; const bf16* K; const bf16* V; bf16* O; const unsigned long long* MASKT; };
struct AttnUnit { int bh; int qb; };
struct StaticOrder {
  int vcu;
  __device__ __forceinline__ explicit StaticOrder(int grid,int block):vcu((block%8)*(grid/8)+block/8){}
  __device__ __forceinline__ bool next(int i,AttnUnit&u)const{ if(i>=2)return false; const int s=vcu&3; u.bh=vcu>>2; u.qb=(i==0)?7-s:s; return true; }
  __device__ __forceinline__ void a_ready(const AttnUnit&)const{}
  __device__ __forceinline__ void done(const AttnUnit&)const{}
};
template<class Sched,int THRL=8> __device__ __forceinline__ void attn_phase(char*lds,const AttnTensors&T,const Sched&S,const int wave_id){
  AttnUnit u;
  for(int i=0;S.next(i,u);++i){ S.a_ready(u); attn_unit<THRL>(u.bh/NHEAD,u.bh%NHEAD,u.qb,T.Q,T.K,T.V,T.O,T.MASKT,lds,wave_id); S.done(u); }
}
#undef SBAR
#undef WAIT_BAR
}


__global__ void __launch_bounds__(NWAVES * 64, 2) mk_fwd(Args args) {
    extern __shared__ __attribute__((aligned(16))) unsigned char lds[];
    Frame F;
    F.lds = (LAS unsigned char*)lds;
    F.MISC = (volatile LAS unsigned*)(F.lds + MISC_OFF);
    F.wave = __builtin_amdgcn_readfirstlane((int)threadIdx.x >> 6); F.lane = (int)__builtin_amdgcn_mbcnt_hi(~0u, __builtin_amdgcn_mbcnt_lo(~0u, 0u)); F.tid = F.wave * 64 + F.lane;
    F.G = gridDim.x; { const int bx = blockIdx.x; F.vcu = (F.G % 8 == 0) ? (bx % 8) * (F.G / 8) + bx / 8 : bx; }
    unsigned char* ws = args.ws;
    F.ctl = (gu32*)(ws + WS_CTL);
    for (int u = F.tid; u < (LDS_BYTES - LDSCTL_OFF) / 4; u += NWAVES * 64) ((LAS unsigned*)(F.lds + LDSCTL_OFF))[u] = 0u;
    __syncthreads();
    XcdBarrier bar = xcd_barrier_post((unsigned*)(F.ctl + CW_BAR) + args.li * XCD_BAR_WORDS, F.MISC + 8, F.wave);
    const int lo = args.ph_lo, hi = args.ph_hi;
#define IN(k) (lo <= (k) && (k) < hi)
#define BOTH(k) (IN(k) && IN((k) + 1))
#ifdef TS_SEL
    const unsigned long long ts0_ = rt();
#define GRID_BAR() do { xcd_barrier(bar); if (blockIdx.x == 0 && F.tid == 0) F.MISC[16 + (ts_n_++)] = (unsigned)(rt() - ts0_); } while (0)
    int ts_n_ = 0;
#else
#define GRID_BAR() xcd_barrier(bar)
#endif
    bf16* XB = (bf16*)(ws + WS_XB); bf16* MIX = (bf16*)(ws + WS_MIX); bf16* H = (bf16*)(ws + WS_H);
    float* sspA = (float*)(ws + WS_SSPA); float* sspB = (float*)(ws + WS_SSPB);
    float* cosH = (float*)(ws + WS_TAB); float* sinH = cosH + SEQ * 32; float* cosI = sinH + SEQ * 32; float* sinI = cosI + SEQ * 16;
    const float* x = args.in[0]; float* out = args.out;

    if (IN(0)) { p0_prologue(F, args);
#if PROBE_REP & 1
        GRID_BAR(); p0_prologue(F, args);
#endif
        if (BOTH(0)) GRID_BAR();
#ifdef PROBE_BARS
        for (int i_ = 0; i_ < PROBE_BARS; ++i_) GRID_BAR();
#endif
        }
    if (IN(1)) {
        {
        pg8::Gemm g{XB, (bf16*)(ws + WS_WGU1), M, NGU, D}; pg8::StaticOrder S; S.init(M, NGU, F.G, (int)blockIdx.x);
        pg8::EpiSwiGLU E{H, sspA, F.lds + RING_OFF + pg8::STAGE_BYTES};
        pg8::gemm_phase<pg8::EpiSwiGLU, pg8::StaticOrder, PG8_ALIGN, PG8_SP2>(F.lds + RING_OFF, g, S, E, F.wave);
#ifdef TS_SEL
        if (F.tid == 0 && blockIdx.x == 0) F.MISC[40] = (unsigned)(rt() - ts0_);
        if (F.tid == 0 && blockIdx.x == 200) ((gu32*)(ws + WS_CTL))[8192 + 0] = (unsigned)(rt() - ts0_);
#endif
        if (F.G == 256 && blockIdx.x >= 128) { weight_items(F, args, 1, ((int)blockIdx.x - 128) * NWAVES + F.wave, 128 * NWAVES); wpo_items(F, args, ((int)blockIdx.x - 128) * NWAVES + F.wave, 128 * NWAVES, 0, 1024); }
#ifdef TS_SEL
        asm volatile("s_waitcnt vmcnt(0)" ::: "memory");
        if (F.tid == 0 && blockIdx.x == 200) ((gu32*)(ws + WS_CTL))[8192 + 64] = (unsigned)(rt() - ts0_);
#endif
        }
#if PROBE_REP & (1 << 1)
        GRID_BAR();
        {
        pg8::Gemm g{XB, (bf16*)(ws + WS_WGU1), M, NGU, D}; pg8::StaticOrder S; S.init(M, NGU, F.G, (int)blockIdx.x);
        pg8::EpiSwiGLU E{H, sspA, F.lds + RING_OFF + pg8::STAGE_BYTES};
        pg8::gemm_phase<pg8::EpiSwiGLU, pg8::StaticOrder, PG8_ALIGN, PG8_SP2>(F.lds + RING_OFF, g, S, E, F.wave);
        }
#endif
        if (BOTH(1)) GRID_BAR();
    }
    if (IN(2)) {
        {
        pg8::Gemm g{H, (bf16*)(ws + WS_WD1), M, D, DFF}; pg8::StaticOrder S; S.init(M, D, F.G, (int)blockIdx.x);
        pg8::EpiResid<true, false, true> E{nullptr, nullptr, XB, sspA, 0.5f};
        pg8::gemm_phase<pg8::EpiResid<true, false, true>, pg8::StaticOrder, PG8_ALIGN, PG8_SP2>(F.lds + RING_OFF, g, S, E, F.wave);
#ifdef TS_SEL
        if (F.tid == 0) { const unsigned t_ = (unsigned)(rt() - ts0_); __hip_atomic_fetch_max((gu32*)(ws + WS_CTL) + 9216 + 128 * 1, 0x40000000u - t_, RLX_AGENT); __hip_atomic_fetch_max((gu32*)(ws + WS_CTL) + 9216 + 128 * 1 + 64, t_, RLX_AGENT); }
#endif

        }
#if PROBE_REP & (1 << 2)
        GRID_BAR();
        {
        pg8::Gemm g{H, (bf16*)(ws + WS_WD1), M, D, DFF}; pg8::StaticOrder S; S.init(M, D, F.G, (int)blockIdx.x);
        pg8::EpiResid<true, false, true> E{nullptr, nullptr, XB, sspA, 0.5f};
        pg8::gemm_phase<pg8::EpiResid<true, false, true>, pg8::StaticOrder, PG8_ALIGN, PG8_SP2>(F.lds + RING_OFF, g, S, E, F.wave);
        }
#endif
        if (BOTH(2)) GRID_BAR();
    }
    if (IN(3)) {
        {
        pg8::Gemm g{XB, (bf16*)(ws + WS_WIN), M, NIN, D}; pg8::StaticOrder S; S.init(M, NIN, F.G, (int)blockIdx.x);
        static_assert(pg8::EpiInProj::O_SSP == WS_SSPA && pg8::EpiInProj::O_TAB == WS_TAB && pg8::EpiInProj::O_WI == WS_WI && pg8::EpiInProj::O_Q == WS_Q && pg8::EpiInProj::O_K == WS_K && pg8::EpiInProj::O_V == WS_V &&
                      pg8::EpiInProj::O_U == WS_U && pg8::EpiInProj::O_QI == WS_QI && pg8::EpiInProj::O_KI == WS_KI && SEQ == 2048, "EpiInProj offsets");
        pg8::EpiInProj E{ws, args.in[7], args.in[8], C2, F.lds + RING_OFF + pg8::STAGE_BYTES};
        pg8::gemm_phase<pg8::EpiInProj, pg8::StaticOrder, PG8_ALIGN, PG8_SP2>(F.lds + RING_OFF, g, S, E, F.wave);
#ifdef TS_SEL
        if (F.tid == 0 && blockIdx.x == 0) F.MISC[41] = (unsigned)(rt() - ts0_);
        if (F.tid == 0 && blockIdx.x == 200) ((gu32*)(ws + WS_CTL))[8192 + 128] = (unsigned)(rt() - ts0_);
#endif
        if (F.G == 256 && blockIdx.x >= 128) { weight_items(F, args, 2, ((int)blockIdx.x - 128) * NWAVES + F.wave, 128 * NWAVES); wpo_items(F, args, ((int)blockIdx.x - 128) * NWAVES + F.wave, 128 * NWAVES, 1024, 2048); }
#ifdef TS_SEL
        asm volatile("s_waitcnt vmcnt(0)" ::: "memory");
        if (F.tid == 0 && blockIdx.x == 200) ((gu32*)(ws + WS_CTL))[8192 + 192] = (unsigned)(rt() - ts0_);
#endif
        }
#if PROBE_REP & (1 << 3)
        GRID_BAR();
        {
        pg8::Gemm g{XB, (bf16*)(ws + WS_WIN), M, NIN, D}; pg8::StaticOrder S; S.init(M, NIN, F.G, (int)blockIdx.x);
        static_assert(pg8::EpiInProj::O_SSP == WS_SSPA && pg8::EpiInProj::O_TAB == WS_TAB && pg8::EpiInProj::O_WI == WS_WI && pg8::EpiInProj::O_Q == WS_Q && pg8::EpiInProj::O_K == WS_K && pg8::EpiInProj::O_V == WS_V &&
                      pg8::EpiInProj::O_U == WS_U && pg8::EpiInProj::O_QI == WS_QI && pg8::EpiInProj::O_KI == WS_KI && SEQ == 2048, "EpiInProj offsets");
        pg8::EpiInProj E{ws, args.in[7], args.in[8], C2, F.lds + RING_OFF + pg8::STAGE_BYTES};
        pg8::gemm_phase<pg8::EpiInProj, pg8::StaticOrder, PG8_ALIGN, PG8_SP2>(F.lds + RING_OFF, g, S, E, F.wave);
        }
#endif
        if (BOTH(3)) GRID_BAR();
    }
    if (IN(4)) {
        {
        select_phase(F, (const bf16*)(ws + WS_QI), (const bf16*)(ws + WS_KI), (const float*)(ws + WS_WI), (unsigned long long*)(ws + WS_MASK), (const bf16*)(ws + WS_U), MIX);
        }
#if PROBE_REP & (1 << 4)
        GRID_BAR();
        {
        select_phase(F, (const bf16*)(ws + WS_QI), (const bf16*)(ws + WS_KI), (const float*)(ws + WS_WI), (unsigned long long*)(ws + WS_MASK), (const bf16*)(ws + WS_U), MIX);
        }
#endif
        if (BOTH(4)) GRID_BAR();
    }
    if (IN(5)) {
        {
        static_assert(attn_body::LDS_TOTAL <= LDSCTL_OFF, "attention LDS");
        const attn_body::AttnTensors AT{(const attn_body::bf16*)(ws + WS_Q), (const attn_body::bf16*)(ws + WS_K), (const attn_body::bf16*)(ws + WS_V), (attn_body::bf16*)MIX, (const unsigned long long*)(ws + WS_MASK)};
        const attn_body::StaticOrder S((int)F.G, (int)blockIdx.x);
        attn_body::attn_phase<attn_body::StaticOrder>((char*)lds + RING_OFF, AT, S, F.wave);
        }
#if PROBE_REP & (1 << 5)
        GRID_BAR();
        {
        static_assert(attn_body::LDS_TOTAL <= LDSCTL_OFF, "attention LDS");
        const attn_body::AttnTensors AT{(const attn_body::bf16*)(ws + WS_Q), (const attn_body::bf16*)(ws + WS_K), (const attn_body::bf16*)(ws + WS_V), (attn_body::bf16*)MIX, (const unsigned long long*)(ws + WS_MASK)};
        const attn_body::StaticOrder S((int)F.G, (int)blockIdx.x);
        attn_body::attn_phase<attn_body::StaticOrder>((char*)lds + RING_OFF, AT, S, F.wave);
        }
#endif
        if (BOTH(5)) GRID_BAR();
    }
    if (IN(6)) {
        pg8::Gemm g{MIX, (bf16*)(ws + WS_WOUT), M, D, D}; pg8::StaticOrder S; S.init(M, D, F.G, (int)blockIdx.x);
        pg8::EpiResid<true, false, true> E{nullptr, nullptr, XB, sspB, 1.0f};
        pg8::gemm_phase<pg8::EpiResid<true, false, true>, pg8::StaticOrder, PG8_ALIGN, PG8_SP2>(F.lds + RING_OFF, g, S, E, F.wave);
#if PROBE_REP & (1 << 6)
        GRID_BAR();
        { pg8::EpiResid<true, false, true> E2{nullptr, nullptr, (bf16*)(ws + 208 * MiB), (float*)(ws + 244 * MiB), 1.0f};
          pg8::gemm_phase<pg8::EpiResid<true, false, true>, pg8::StaticOrder, PG8_ALIGN, PG8_SP2>(F.lds + RING_OFF, g, S, E2, F.wave); }
#endif
        if (BOTH(6)) GRID_BAR();
    }
    if (IN(7)) {
        {
        pg8::Gemm g{XB, (bf16*)(ws + WS_WGU2), M, NGU, D}; pg8::StaticOrder S; S.init(M, NGU, F.G, (int)blockIdx.x);
        pg8::EpiSwiGLU E{H, sspB, F.lds + RING_OFF + pg8::STAGE_BYTES};
        pg8::gemm_phase<pg8::EpiSwiGLU, pg8::StaticOrder, PG8_ALIGN, PG8_SP2>(F.lds + RING_OFF, g, S, E, F.wave);
        if (F.G == 256 && blockIdx.x >= 128) weight_items(F, args, 3, ((int)blockIdx.x - 128) * NWAVES + F.wave, 128 * NWAVES);
        }
#if PROBE_REP & (1 << 7)
        GRID_BAR();
        {
        pg8::Gemm g{XB, (bf16*)(ws + WS_WGU2), M, NGU, D}; pg8::StaticOrder S; S.init(M, NGU, F.G, (int)blockIdx.x);
        pg8::EpiSwiGLU E{H, sspB, F.lds + RING_OFF + pg8::STAGE_BYTES};
        pg8::gemm_phase<pg8::EpiSwiGLU, pg8::StaticOrder, PG8_ALIGN, PG8_SP2>(F.lds + RING_OFF, g, S, E, F.wave);
        }
#endif
        if (BOTH(7)) GRID_BAR();
    }
    if (IN(8)) {
        {
        pg8::Gemm g{H, (bf16*)(ws + WS_WD2), M, D, DFF}; pg8::StaticOrder S; S.init(M, D, F.G, (int)blockIdx.x);
        pg8::EpiResid<true, true, false> E{nullptr, out, XB, nullptr, 0.5f};
        pg8::gemm_phase<pg8::EpiResid<true, true, false>, pg8::StaticOrder, PG8_ALIGN, PG8_SP2>(F.lds + RING_OFF, g, S, E, F.wave);
        }
#if PROBE_REP & (1 << 8)
        GRID_BAR();
        {
        pg8::Gemm g{H, (bf16*)(ws + WS_WD2), M, D, DFF}; pg8::StaticOrder S; S.init(M, D, F.G, (int)blockIdx.x);
        pg8::EpiResid<true, true, false> E{nullptr, out, XB, nullptr, 0.5f};
        pg8::gemm_phase<pg8::EpiResid<true, true, false>, pg8::StaticOrder, PG8_ALIGN, PG8_SP2>(F.lds + RING_OFF, g, S, E, F.wave);
        }
#endif
    }
#ifdef TS_SEL
    if (blockIdx.x == 0 && F.tid == 0) {
        const unsigned now = (unsigned)(rt() - ts0_);
        const unsigned v = (TS_SEL == 41) ? (__hip_atomic_load((gu32*)(ws + WS_CTL) + 9216 + 128 + 64, RLX_AGENT) - (0x40000000u - __hip_atomic_load((gu32*)(ws + WS_CTL) + 9216 + 128, RLX_AGENT))) : (TS_SEL == 30) ? F.MISC[41] : (TS_SEL == 31) ? __hip_atomic_load((gu32*)(ws + WS_CTL) + 8192 + 128, RLX_AGENT) : (TS_SEL == 32) ? __hip_atomic_load((gu32*)(ws + WS_CTL) + 8192 + 192, RLX_AGENT) : (TS_SEL == 20) ? F.MISC[40] : (TS_SEL == 21) ? __hip_atomic_load((gu32*)(ws + WS_CTL) + 8192, RLX_AGENT) : (TS_SEL == 22) ? __hip_atomic_load((gu32*)(ws + WS_CTL) + 8192 + 64, RLX_AGENT) : (TS_SEL >= 8) ? now : F.MISC[16 + TS_SEL];
        asm volatile("s_waitcnt vmcnt(0)" ::: "memory");
        out[0] += (float)v * 0.01f * TS_SCALE;
    }
#endif
#undef IN
#undef BOTH
}

extern "C" void kernel_launch(void* const* d_in, const int* in_sizes, int n_in, void* d_out, int out_size, void* d_ws, size_t ws_size, hipStream_t stream) {
    static int grid = 0;
    if (grid == 0) {
        if (n_in != 16 || out_size != M * D || ws_size < WS_END) { fprintf(stderr, "kernel_launch: unexpected shapes (n_in %d out %d ws %zu)\n", n_in, out_size, ws_size); grid = -1; return; }
        int dev = 0, cus = 0, per_cu = 0;
        if (hipGetDevice(&dev) != hipSuccess || hipDeviceGetAttribute(&cus, hipDeviceAttributeMultiprocessorCount, dev) != hipSuccess) { grid = -1; return; }
        if (hipFuncSetAttribute((const void*)mk_fwd, hipFuncAttributeMaxDynamicSharedMemorySize, LDS_BYTES) != hipSuccess) { fprintf(stderr, "kernel_launch: hipFuncSetAttribute failed\n"); grid = -1; return; }
        if (hipOccupancyMaxActiveBlocksPerMultiprocessor(&per_cu, (const void*)mk_fwd, NWAVES * 64, LDS_BYTES) != hipSuccess || per_cu < 1) fprintf(stderr, "kernel_launch: occupancy query reports %d\n", per_cu);
        (void)hipGetLastError();
        grid = cus;
        if (cus != 256) { fprintf(stderr, "kernel_launch: this kernel is laid out for 256 CUs (MI355X); found %d; nothing launched\n", cus); grid = -1; return; }
    }
    if (grid < 0) return;
    (void)hipMemsetAsync((char*)d_ws + WS_CTL, 0, CTL_ZERO_BYTES, stream);
    Args a{};
    for (int i = 0; i < 16; ++i) a.in[i] = (const float*)d_in[i];
    a.out = (float*)d_out; a.ws = (unsigned char*)d_ws;
    a.ph_lo = 0; a.ph_hi = 9; a.li = 0;
    void* kargs[] = {(void*)&a};
    hipError_t le = hipLaunchCooperativeKernel((const void*)mk_fwd, dim3(grid), dim3(NWAVES * 64), kargs, LDS_BYTES, stream);
    if (le != hipSuccess) { fprintf(stderr, "kernel_launch: cooperative launch failed: %s (grid %d); falling back to a plain launch\n", hipGetErrorString(le), grid); (void)hipGetLastError();
        hipLaunchKernelGGL(mk_fwd, dim3(grid), dim3(NWAVES * 64), LDS_BYTES, stream, a); }
}
```

```cpp
#include <hip/hip_runtime.h>
#include <cstdio>
#include <cstdint>
#include <math.h>
namespace pg8 {
#define PG8_LAS __attribute__((address_space(3)))
typedef unsigned short bf16_t;
typedef short bf16x8 __attribute__((ext_vector_type(8)));
typedef float f32x4 __attribute__((ext_vector_type(4)));
typedef unsigned u32x4 __attribute__((ext_vector_type(4)));
constexpr int BM = 256, BK = 64, HALF = 128, HTB = HALF * BK * 2  , STAGE_BYTES = 8 * HTB, NXCD = 8, WGM = 8;

__host__ __device__ __forceinline__ int lds_byte(int r, int c) { const int st = (r >> 4) * 2 + (c >> 5), rr = r & 15, cc = c & 31, ob = rr * 64 + cc * 2; return st * 1024 + (ob ^ (((ob >> 9) & 1) << 5)); }
__host__ __device__ __forceinline__ void stage_rc(int b, int& R, int& C) { const int st = b / 1024, sb = b % 1024, swz = sb ^ (((sb >> 9) & 1) << 5); R = (st >> 1) * 16 + swz / 64; C = (st & 1) * 32 + (swz % 64) / 2; }
__host__ __device__ __forceinline__ int perm32(int rho) { const int n = rho >> 4, i = rho & 15; return 8 * (i >> 2) + 4 * n + (i & 3); }

__device__ __forceinline__ int lane_id_now() { int l; asm volatile("v_mbcnt_lo_u32_b32 %0, -1, 0\n\tv_mbcnt_hi_u32_b32 %0, -1, %0" : "=v"(l)); return l; }
struct Unit { int pm, pn; };
struct Gemm { const bf16_t* A; const bf16_t* Bt; int M, N, K; };

struct StaticOrder {
    int nM, nN, nwg, G, c;
    __host__ __device__ void init(int M, int N, int G_, int c_) { nM = M / BM; nN = N / BM; nwg = nM * nN; G = G_; c = c_; }
    __host__ __device__ bool next(int i, Unit& u) const {
        const long L = (long)i * G + c; if (L >= nwg) return false;
        int wgid = (int)L; { const int q = nwg / NXCD, r = nwg % NXCD, xcd = wgid % NXCD, off = wgid / NXCD; wgid = (xcd < r ? xcd * (q + 1) : r * (q + 1) + (xcd - r) * q) + off; }
        const int nig = WGM * nN, gid = wgid / nig, fm = gid * WGM, gsz = (nM - fm) < WGM ? (nM - fm) : WGM;
        u.pm = fm + ((wgid % nig) % gsz); u.pn = (wgid % nig) / gsz; return true;
    }
    __device__ __forceinline__ void a_ready(const Unit&) const {}
    __device__ __forceinline__ void done(const Unit&) const {}
};


__device__ __forceinline__ unsigned cvt_pk_bf16(float lo, float hi) { unsigned r; asm volatile("v_cvt_pk_bf16_f32 %0, %1, %2" : "=v"(r) : "v"(lo), "v"(hi)); return r; }
typedef float f32x2 __attribute__((ext_vector_type(2)));

typedef float f32x2 __attribute__((ext_vector_type(2)));
__device__ __forceinline__ float fq_sum(float s) {
    { auto r = __builtin_amdgcn_permlane16_swap(__float_as_uint(s), __float_as_uint(s), false, false); s = __uint_as_float(r[0]) + __uint_as_float(r[1]); }
    { auto r = __builtin_amdgcn_permlane32_swap(__float_as_uint(s), __float_as_uint(s), false, false); s = __uint_as_float(r[0]) + __uint_as_float(r[1]); }
    return s;
}
__device__ __forceinline__ float rrow(const float* ssp, int row, int fq) {
    const f32x4 p = *(const f32x4*)(ssp + (size_t)row * 16 + 4 * fq);
    float s = (p[0] + p[1]) + (p[2] + p[3]);
    s = fq_sum(s);
    return __builtin_amdgcn_rsqf(s * (1.0f / 1024.0f) + 1e-6f);
}
__device__ __forceinline__ float msrow_lds(const PG8_LAS unsigned char* pf, int lrow, int fq) {
    const f32x4 p = *(const PG8_LAS f32x4*)(pf + lrow * 64 + fq * 16);
    float s = (p[0] + p[1]) + (p[2] + p[3]);
    s = fq_sum(s);
    return s * (1.0f / 1024.0f) + 1e-6f;
}
__device__ __forceinline__ float rrow_lds(const PG8_LAS unsigned char* pf, int lrow, int fq) { return __builtin_amdgcn_rsqf(msrow_lds(pf, lrow, fq)); }
__device__ __forceinline__ void ssp_prefetch(const float* ssp, int pm, PG8_LAS unsigned char* pf, int wid, int kp) {
    const char* sbase = (const char*)(ssp + (size_t)pm * (BM * 16)) + wid * 2048 + (kp & 7) * 256;
    const unsigned dst = (unsigned)(unsigned long)pf + (unsigned)wid * 2048u + (unsigned)(kp & 7) * 256u;
    unsigned keep, off;
    asm volatile("s_mov_b32 %0, m0\n\tv_mbcnt_lo_u32_b32 %1, -1, 0\n\tv_mbcnt_hi_u32_b32 %1, -1, %1\n\tv_lshlrev_b32_e32 %1, 2, %1\n\ts_mov_b32 m0, %2\n\ts_nop 4\n\t"
                 "global_load_lds_dword %1, %3\n\ts_mov_b32 m0, %0"
                 : "=&s"(keep), "=&v"(off) : "s"(dst), "s"(sbase) : "memory");
}
__device__ __forceinline__ f32x4 silu_mul(f32x4 g, f32x4 u, float c1, float ir2) {
    const f32x2 c1v = {c1, c1}, irv = {ir2, ir2};
    const f32x2 g0 = {g[0], g[1]}, g1 = {g[2], g[3]}, u0 = {u[0], u[1]}, u1 = {u[2], u[3]};
    const f32x2 x0 = g0 * c1v, x1 = g1 * c1v;
    const f32x2 t0 = {__builtin_amdgcn_exp2f(x0[0]), __builtin_amdgcn_exp2f(x0[1])}, t1 = {__builtin_amdgcn_exp2f(x1[0]), __builtin_amdgcn_exp2f(x1[1])};
    const f32x2 d0 = __builtin_elementwise_fma(t0, irv, irv), d1 = __builtin_elementwise_fma(t1, irv, irv);
    const f32x2 q0 = {__builtin_amdgcn_rcpf(d0[0]), __builtin_amdgcn_rcpf(d0[1])}, q1 = {__builtin_amdgcn_rcpf(d1[0]), __builtin_amdgcn_rcpf(d1[1])};
    const f32x2 o0 = (g0 * u0) * q0, o1 = (g1 * u1) * q1;
    return (f32x4){o0[0], o0[1], o1[0], o1[1]};
}
__device__ __forceinline__ u32x4 pack8(f32x4 a, f32x4 b) { u32x4 w; w.x = cvt_pk_bf16(a[0], a[1]); w.y = cvt_pk_bf16(a[2], a[3]); w.z = cvt_pk_bf16(b[0], b[1]); w.w = cvt_pk_bf16(b[2], b[3]); return w; }
__device__ __forceinline__ float dot4(f32x4 a) { return (a[0] * a[0] + a[1] * a[1]) + (a[2] * a[2] + a[3] * a[3]); }

struct EpiSwiGLU {
    static constexpr bool PERM = true, AFTER_DRAIN = false; static constexpr int NPF = 1;
    bf16_t* H; const float* ssp; PG8_LAS unsigned char* pf;
    __device__ __forceinline__ void prefetch(const Unit& u, int wid, int kp) const { ssp_prefetch(ssp, u.pm, pf, wid, kp); }
    __device__ __forceinline__ void operator()(const f32x4 (&acc)[2][2][4][2], const Unit& u, int wr, int wc, int fr, int fq) const {
        const int row0 = u.pm * BM + wr * 64 + fr, hc0 = u.pn * 128 + wc * 32 + 8 * fq;
        float rs[2][4];
#pragma unroll
        for (int ai = 0; ai < 2; ++ai)
#pragma unroll
            for (int m = 0; m < 4; ++m) rs[ai][m] = msrow_lds(pf, wr * 64 + fr + ai * HALF + m * 16, fq);
#pragma unroll
        for (int ai = 0; ai < 2; ++ai)
#pragma unroll
            for (int m = 0; m < 4; ++m) {
                const int row = row0 + ai * HALF + m * 16; const float ir2 = rs[ai][m], c1 = __builtin_amdgcn_rsqf(ir2) * -1.4426950408889634f;
                const f32x4 h0 = silu_mul(acc[ai][0][m][0], acc[ai][1][m][0], c1, ir2), h1 = silu_mul(acc[ai][0][m][1], acc[ai][1][m][1], c1, ir2);
                *(u32x4*)(H + (size_t)row * 2816 + hc0) = pack8(h0, h1);
            }
    }
};
template <bool RB, bool OF, bool WB>
struct EpiResid {
    static constexpr bool PERM = true, AFTER_DRAIN = false; static constexpr int NPF = 0;
    const float* R; float* OUT; bf16_t* XB; float* ssp; float alpha;
    __device__ __forceinline__ void operator()(const f32x4 (&acc)[2][2][4][2], const Unit& u, int wr, int wc, int fr, int fq) const {
        static_assert(RB, "the residual base is the bf16 stream XB");
        const int row0 = u.pm * BM + wr * 64 + fr, c0 = u.pn * BM + wc * 32 + 8 * fq;
        u32x4 w[2][4];
#define PG8_LDSB(sb, buf) _Pragma("unroll") for (int q = 0; q < 4; ++q) w[buf][q] = *(const u32x4*)(XB + (size_t)(row0 + ((sb) >> 1) * HALF + (((sb) & 1) * 2 + (q >> 1)) * 16) * 1024 + c0 + (q & 1) * HALF)
        PG8_LDSB(0, 0); PG8_LDSB(1, 1);
#pragma unroll
        for (int sb = 0; sb < 4; ++sb) {
            const int ai = sb >> 1, buf = sb & 1;
            f32x4 rv[4][2];
#pragma unroll
            for (int q = 0; q < 4; ++q) { const u32x4 t = w[buf][q];
                rv[q][0] = (f32x4){__uint_as_float(t.x << 16), __uint_as_float(t.x & 0xffff0000u), __uint_as_float(t.y << 16), __uint_as_float(t.y & 0xffff0000u)};
                rv[q][1] = (f32x4){__uint_as_float(t.z << 16), __uint_as_float(t.z & 0xffff0000u), __uint_as_float(t.w << 16), __uint_as_float(t.w & 0xffff0000u)}; }
            if (sb < 2) { PG8_LDSB(sb + 2, buf); }
#pragma unroll
            for (int mm = 0; mm < 2; ++mm) {
                const int m = (sb & 1) * 2 + mm, row = row0 + ai * HALF + m * 16; float ss = 0.f;
#pragma unroll
                for (int bj = 0; bj < 2; ++bj) {
                    const size_t off = (size_t)row * 1024 + c0 + bj * HALF;
                    const f32x4 o0 = rv[mm * 2 + bj][0] + acc[ai][bj][m][0] * alpha, o1 = rv[mm * 2 + bj][1] + acc[ai][bj][m][1] * alpha;
                    if (OF) { *(f32x4*)(OUT + off) = o0; *(f32x4*)(OUT + off + 4) = o1; }
                    if (WB) { *(u32x4*)(XB + off) = pack8(o0, o1); ss += dot4(o0) + dot4(o1); }
                }
                if (WB) { ss = fq_sum(ss); if (fq == 0) ssp[(size_t)row * 16 + u.pn * 4 + wc] = ss; }
            }
        }
#undef PG8_LDSB
    }
};
struct EpiInProj {
    static constexpr bool PERM = true, AFTER_DRAIN = false; static constexpr int NPF = 1;
    static constexpr size_t O_SSP = (size_t)2 << 20, O_TAB = (size_t)4 << 20, O_WI = (size_t)5 << 20, O_Q = (size_t)116 << 20, O_K = (size_t)132 << 20, O_V = (size_t)148 << 20, O_U = (size_t)164 << 20, O_QI = (size_t)180 << 20, O_KI = (size_t)188 << 20;
    unsigned char* wsb; const float *qn, *kn; float qscale; PG8_LAS unsigned char* pf;
    __device__ __forceinline__ void prefetch(const Unit& u, int wid, int kp) const { ssp_prefetch((const float*)(wsb + O_SSP), u.pm, pf, wid, kp); }
    __device__ __forceinline__ void operator()(const f32x4 (&acc)[2][2][4][2], const Unit& u, int wr, int wc, int fr, int fq) const {
        const int row0 = u.pm * BM + wr * 64 + fr, pn = u.pn;
        const float* ssp = (const float*)(wsb + O_SSP); const float* cosH = (const float*)(wsb + O_TAB); const float* sinH = cosH + 2048 * 32; const float* cosI = sinH + 2048 * 32; const float* sinI = cosI + 2048 * 16;
        bf16_t* Q = (bf16_t*)(wsb + O_Q); bf16_t* K = (bf16_t*)(wsb + O_K); bf16_t* V = (bf16_t*)(wsb + O_V); bf16_t* U = (bf16_t*)(wsb + O_U); bf16_t* QI = (bf16_t*)(wsb + O_QI); bf16_t* KI = (bf16_t*)(wsb + O_KI);
        float* WI = (float*)(wsb + O_WI);
#define PG8_SEP(t) __builtin_assume_separate_storage(t, Q); __builtin_assume_separate_storage(t, K); __builtin_assume_separate_storage(t, V); __builtin_assume_separate_storage(t, U); \
        __builtin_assume_separate_storage(t, QI); __builtin_assume_separate_storage(t, KI); __builtin_assume_separate_storage(t, WI);
        PG8_SEP(ssp) PG8_SEP(qn) PG8_SEP(kn) PG8_SEP(cosH) PG8_SEP(sinH) PG8_SEP(cosI) PG8_SEP(sinI)
#undef PG8_SEP
        float rs[2][4];
#pragma unroll
        for (int ai = 0; ai < 2; ++ai)
#pragma unroll
            for (int m = 0; m < 4; ++m) rs[ai][m] = rrow_lds(pf, wr * 64 + fr + ai * HALF + m * 16, fq);
        const int pos0 = row0 & 2047;
        if (pn < 4) {
            const float* gp = (pn < 2) ? qn : kn;
            const f32x4 g00 = *(const f32x4*)(gp + 8 * fq), g01 = *(const f32x4*)(gp + 8 * fq + 4), g10 = *(const f32x4*)(gp + 32 + 8 * fq), g11 = *(const f32x4*)(gp + 36 + 8 * fq);
            const float sc = (pn < 2) ? qscale : 1.0f;
            const f32x4 Ca = *(const f32x4*)(cosH + 16 * 32 + 8 * fq), Cb = *(const f32x4*)(cosH + 16 * 32 + 8 * fq + 4), Sa = *(const f32x4*)(sinH + 16 * 32 + 8 * fq), Sb = *(const f32x4*)(sinH + 16 * 32 + 8 * fq + 4);
#pragma unroll
            for (int ai = 0; ai < 2; ++ai) {
                const int o = (pos0 + ai * HALF) * 32 + 8 * fq;
                f32x4 ca = *(const f32x4*)(cosH + o), cb = *(const f32x4*)(cosH + o + 4), sa = *(const f32x4*)(sinH + o), sb = *(const f32x4*)(sinH + o + 4);
#pragma unroll
                for (int m = 0; m < 4; ++m) {
                    const int row = row0 + ai * HALF + m * 16, pos = row & 2047; const float r = rs[ai][m];
                    const f32x4 a00 = acc[ai][0][m][0] * r, a01 = acc[ai][0][m][1] * r, a10 = acc[ai][1][m][0] * r, a11 = acc[ai][1][m][1] * r;
                    float ss = (dot4(a00) + dot4(a01)) + (dot4(a10) + dot4(a11));
                    ss = fq_sum(ss);
                    const float rh = __builtin_amdgcn_rsqf(ss * (1.0f / 64.0f) + 1e-6f);
                    const f32x4 x1a = a00 * rh * g00, x1b = a01 * rh * g01, x2a = a10 * rh * g10, x2b = a11 * rh * g11;
                    const f32x4 o1a = (x1a * ca - x2a * sa) * sc, o1b = (x1b * cb - x2b * sb) * sc, o2a = (x2a * ca + x1a * sa) * sc, o2b = (x2b * cb + x1b * sb) * sc;
                    if (pn < 2) { bf16_t* dst = Q + (size_t)row * 512 + ((pn & 1) * 4 + wc) * 64 + 8 * fq; *(u32x4*)dst = pack8(o1a, o1b); *(u32x4*)(dst + 32) = pack8(o2a, o2b); }
                    else {
                        bf16_t* dst = K + ((size_t)((row >> 11) * 8 + (pn & 1) * 4 + wc) * 32 + (pos >> 6)) * 4096 + (pos & 63) * 8 + fq * 512;
                        *(u32x4*)dst = pack8(o1a, o1b); *(u32x4*)(dst + 4 * 512) = pack8(o2a, o2b); }
                    if (m < 3) { const f32x4 na = ca * Ca - sa * Sa, nb = cb * Cb - sb * Sb; sa = sa * Ca + ca * Sa; sb = sb * Cb + cb * Sb; ca = na; cb = nb; }
                }
            }
        } else if (pn < 8) {
#pragma unroll
            for (int ai = 0; ai < 2; ++ai)
#pragma unroll
                for (int m = 0; m < 4; ++m) {
                    const int row = row0 + ai * HALF + m * 16, pos = row & 2047; const float r = rs[ai][m];
                    const f32x4 a00 = acc[ai][0][m][0] * r, a01 = acc[ai][0][m][1] * r, a10 = acc[ai][1][m][0] * r, a11 = acc[ai][1][m][1] * r;
                    if (pn >= 6) { bf16_t* dst = U + (size_t)row * 512 + (pn & 1) * 256 + wc * 32 + 8 * fq; *(u32x4*)dst = pack8(a00, a01); *(u32x4*)(dst + 128) = pack8(a10, a11); }
                    else {
                        const int col = (pn & 1) * 256 + wc * 32, hd = col >> 6, ch = (col >> 5) & 1;
                        bf16_t* dst = V + ((size_t)((row >> 11) * 8 + hd) * 32 + (pos >> 6)) * 4096 + (ch * 4 + ((pos & 63) >> 4)) * 512 + ((pos & 15) * 4 + fq) * 8;
                        *(u32x4*)dst = pack8(a00, a01); *(u32x4*)(dst + (size_t)2 * 32 * 4096) = pack8(a10, a11); }
                }
        } else if (pn == 8 || wc == 0) {
            const int tq = (fq & 1) * 8;
            f32x4 Ca = *(const f32x4*)(cosI + 16 * 16 + tq), Cb = *(const f32x4*)(cosI + 16 * 16 + tq + 4), Sa = *(const f32x4*)(sinI + 16 * 16 + tq), Sb = *(const f32x4*)(sinI + 16 * 16 + tq + 4);
            const f32x4 one = (f32x4){1.f, 1.f, 1.f, 1.f}, zero = (f32x4){0.f, 0.f, 0.f, 0.f};
            if (fq >= 2) { Ca = one; Cb = one; Sa = zero; Sb = zero; }
            const int d1 = 8 * fq + ((fq >= 2) ? 16 : 0);
#pragma unroll
            for (int ai = 0; ai < 2; ++ai) {
                const int o = (pos0 + ai * HALF) * 16 + tq;
                f32x4 ca = *(const f32x4*)(cosI + o), cb = *(const f32x4*)(cosI + o + 4), sa = *(const f32x4*)(sinI + o), sb = *(const f32x4*)(sinI + o + 4);
                if (fq >= 2) { ca = one; cb = one; sa = zero; sb = zero; }
#pragma unroll
                for (int m = 0; m < 4; ++m) {
                    const int row = row0 + ai * HALF + m * 16; const float r = rs[ai][m];
                    const f32x4 a00 = acc[ai][0][m][0] * r, a01 = acc[ai][0][m][1] * r, a10 = acc[ai][1][m][0] * r, a11 = acc[ai][1][m][1] * r;
                    const f32x4 o1a = a00 * ca - a10 * sa, o1b = a01 * cb - a11 * sb, o2a = a10 * ca + a00 * sa, o2b = a11 * cb + a01 * sb;
                    if (pn == 8) { bf16_t* dst = QI + (size_t)row * 256 + wc * 64 + d1; *(u32x4*)dst = pack8(o1a, o1b); *(u32x4*)(dst + 16) = pack8(o2a, o2b); }
                    else {
                        const int d2 = d1 + 16; bf16_t* tb = KI + (size_t)(row >> 4) * 1024 + (row & 15) * 8;
                        *(u32x4*)(tb + ((d1 >> 5) * 4 + ((d1 & 31) >> 3)) * 128) = pack8(o1a, o1b); *(u32x4*)(tb + ((d2 >> 5) * 4 + ((d2 & 31) >> 3)) * 128) = pack8(o2a, o2b); }
                    if (m < 3) { const f32x4 na = ca * Ca - sa * Sa, nb = cb * Cb - sb * Sb; sa = sa * Ca + ca * Sa; sb = sb * Cb + cb * Sb; ca = na; cb = nb; }
                }
            }
        } else if (wc == 1) {
#pragma unroll
            for (int ai = 0; ai < 2; ++ai)
#pragma unroll
                for (int m = 0; m < 4; ++m) { const int row = row0 + ai * HALF + m * 16; if (fq == 0) *(f32x4*)(WI + (size_t)row * 4) = acc[ai][0][m][0] * (rs[ai][m] * 0.0625f); }
        }
    }
};
template <class Epi, class Sched, bool ALIGN_EPI = false, bool SP2 = false>
__device__ __forceinline__ void gemm_phase(PG8_LAS unsigned char* lds, const Gemm g, const Sched& S, const Epi& E, const int wave_id) {
    const int lane_ = lane_id_now();
    const int wid = wave_id, lane = lane_, tid = wid * 64 + lane,     wr = wid >> 2, wc = wid & 3, fr = lane & 15, fq = lane >> 4;
    const int K = g.K, nt = K / BK;
    unsigned voffA[2], voffB[2];
#pragma unroll
    for (int i = 0; i < 2; ++i) { int R, C; stage_rc(tid * 16 + i * 8192, R, C); const int Rb = Epi::PERM ? ((R & ~31) + perm32(R & 31)) : R;
        voffA[i] = (unsigned)(R * K + C) * 2u; voffB[i] = (unsigned)(Rb * K + C) * 2u; }
    const size_t kstep = (size_t)(BK * 2);
    const size_t hstep = (size_t)HALF * K * 2;
    const size_t tstep = 2 * hstep;
    const unsigned ldsw = (unsigned)wid * 1024u;
    const int aoff = lds_byte(wr * 64 + fr, fq * 8), boff = lds_byte(wc * 32 + fr, fq * 8);
#define PG8_SA(b, h) (((b) * 2 + (h)) * HTB)
#define PG8_SB(b, h) ((4 + (b) * 2 + (h)) * HTB)
#define PG8_STAGE(bufoff, gbase, voff) do { _Pragma("unroll") for (int _i = 0; _i < 2; ++_i) \
        __builtin_amdgcn_global_load_lds((const unsigned*)((const char*)(gbase) + (voff)[_i]), (PG8_LAS unsigned*)(lds + (bufoff) + ldsw + _i * 8192), 16, 0, 0); } while (0)
#define PG8_LDA(dst, b, h) do { _Pragma("unroll") for (int m = 0; m < 4; ++m) _Pragma("unroll") for (int k = 0; k < 2; ++k) dst[m][k] = *(const PG8_LAS bf16x8*)(lds + PG8_SA(b, h) + aoff + m * 2048 + k * 1024); } while (0)
#define PG8_LDB(dst, b, h) do { _Pragma("unroll") for (int n = 0; n < 2; ++n) _Pragma("unroll") for (int k = 0; k < 2; ++k) dst[n][k] = *(const PG8_LAS bf16x8*)(lds + PG8_SB(b, h) + boff + n * 2048 + k * 1024); } while (0)
#define PG8_MMA(ai, bj, At, Bt) do { __builtin_amdgcn_s_setprio(1); _Pragma("unroll") for (int m = 0; m < 4; ++m) _Pragma("unroll") for (int n = 0; n < 2; ++n) _Pragma("unroll") for (int k = 0; k < 2; ++k) \
        acc[ai][bj][m][n] = __builtin_amdgcn_mfma_f32_16x16x32_bf16(Bt[n][k], At[m][k], acc[ai][bj][m][n], 0, 0, 0); __builtin_amdgcn_s_setprio(0); } while (0)
#define PG8_MMA0(ai, bj, At, Bt) do { __builtin_amdgcn_s_setprio(1); _Pragma("unroll") for (int m = 0; m < 4; ++m) _Pragma("unroll") for (int n = 0; n < 2; ++n) { \
        acc[ai][bj][m][n] = __builtin_amdgcn_mfma_f32_16x16x32_bf16(Bt[n][0], At[m][0], (f32x4){0.f, 0.f, 0.f, 0.f}, 0, 0, 0); \
        acc[ai][bj][m][n] = __builtin_amdgcn_mfma_f32_16x16x32_bf16(Bt[n][1], At[m][1], acc[ai][bj][m][n], 0, 0, 0); } __builtin_amdgcn_s_setprio(0); } while (0)
#define PG8_WAIT_V(n) asm volatile("s_waitcnt vmcnt(" #n ")" ::: "memory")
#define PG8_WAIT_L(n) asm volatile("s_waitcnt lgkmcnt(" #n ")" ::: "memory")
#define PG8_BAR __builtin_amdgcn_s_barrier()
#define PG8_SCHED __builtin_amdgcn_sched_barrier(0)
    Unit cur, nxt; int ui = 0;
    if (!S.next(0, cur)) return;
    static_assert(SP2, "only the two-super-phase K-loop is kept here");
    f32x4 acc[2][2][4][2];
    bf16x8 At[4][2], B0[2][2], B1[2][2];
    const char* cA = (const char*)g.A + (size_t)cur.pm * tstep; const char* cB = (const char*)g.Bt + (size_t)cur.pn * tstep;
    S.a_ready(cur);
    if constexpr (SP2) {
        PG8_STAGE(PG8_SB(0, 0), cB, voffB); PG8_STAGE(PG8_SB(0, 1), cB + hstep, voffB); PG8_STAGE(PG8_SA(0, 0), cA, voffA); PG8_STAGE(PG8_SA(0, 1), cA + hstep, voffA);
        if (wr == 1) PG8_BAR;
        PG8_WAIT_V(2); PG8_BAR;
        PG8_STAGE(PG8_SB(1, 0), cB + kstep, voffB); PG8_STAGE(PG8_SA(1, 0), cA + kstep, voffA); PG8_STAGE(PG8_SB(1, 1), cB + hstep + kstep, voffB);
        PG8_WAIT_V(6); PG8_BAR;
    } else {
        PG8_STAGE(PG8_SB(0, 0), cB, voffB); PG8_STAGE(PG8_SA(0, 0), cA, voffA); PG8_STAGE(PG8_SB(0, 1), cB + hstep, voffB); PG8_STAGE(PG8_SA(0, 1), cA + hstep, voffA);
        if (wr == 1) PG8_BAR;
        PG8_WAIT_V(4); PG8_BAR;
        PG8_STAGE(PG8_SB(1, 0), cB + kstep, voffB); PG8_STAGE(PG8_SA(1, 0), cA + kstep, voffA); PG8_STAGE(PG8_SB(1, 1), cB + hstep + kstep, voffB);
        PG8_WAIT_V(6); PG8_BAR;
    }
    for (;;) {
        const bool has_next = S.next(ui + 1, nxt);
        const char* nA = has_next ? (const char*)g.A + (size_t)nxt.pm * tstep : cA; const char* nB = has_next ? (const char*)g.Bt + (size_t)nxt.pn * tstep : cB;
#define PG8_KPAIR(MMAF) do { \
            const bool last = (t == nt - 2); \
            const char* a1 = cA + (size_t)(t + 1) * kstep; \
            const char* a2 = last ? nA : cA + (size_t)(t + 2) * kstep; const char* b2 = last ? nB : cB + (size_t)(t + 2) * kstep; \
            const char* a3 = a2 + kstep; const char* b3 = b2 + kstep; \
            if (last && has_next) S.a_ready(nxt); \
            PG8_LDB(B0, 0, 0); PG8_LDB(B1, 0, 1); PG8_SCHED; PG8_LDA(At, 0, 0); PG8_STAGE(PG8_SA(1, 1), a1 + hstep, voffA); \
            PG8_WAIT_V(8); PG8_WAIT_L(0); PG8_BAR; MMAF(0, 0, At, B0); MMAF(0, 1, At, B1); PG8_BAR; PG8_SCHED; \
            PG8_LDA(At, 0, 1); \
            if constexpr (Epi::NPF > 0) { static_assert(Epi::NPF == 1, "wait counts below"); E.prefetch(cur, wid, t >> 1); } \
            PG8_STAGE(PG8_SB(0, 0), b2, voffB); PG8_STAGE(PG8_SB(0, 1), b2 + hstep, voffB); PG8_STAGE(PG8_SA(0, 0), a2, voffA); \
            if constexpr (Epi::NPF > 0) PG8_WAIT_V(9); else PG8_WAIT_V(8); \
            PG8_WAIT_L(0); PG8_BAR; MMAF(1, 0, At, B0); MMAF(1, 1, At, B1); PG8_BAR; PG8_SCHED; \
            PG8_LDB(B0, 1, 0); PG8_LDB(B1, 1, 1); PG8_SCHED; PG8_LDA(At, 1, 0); PG8_STAGE(PG8_SA(0, 1), a2 + hstep, voffA); \
            if constexpr (Epi::NPF > 0) PG8_WAIT_V(9); else PG8_WAIT_V(8); \
            PG8_WAIT_L(0); PG8_BAR; PG8_MMA(0, 0, At, B0); PG8_MMA(0, 1, At, B1); PG8_BAR; PG8_SCHED; \
            PG8_LDA(At, 1, 1); PG8_STAGE(PG8_SB(1, 0), b3, voffB); PG8_STAGE(PG8_SB(1, 1), b3 + hstep, voffB); PG8_STAGE(PG8_SA(1, 0), a3, voffA); \
            PG8_WAIT_V(8); PG8_WAIT_L(0); PG8_BAR; PG8_MMA(1, 0, At, B0); PG8_MMA(1, 1, At, B1); PG8_BAR; PG8_SCHED; } while (0)
        { const int t = 0; PG8_KPAIR(PG8_MMA0); }
#pragma unroll 1
        for (int t = 2; t < nt; t += 2) PG8_KPAIR(PG8_MMA);
#undef PG8_KPAIR
        if constexpr (ALIGN_EPI) { if (wr == 0) PG8_BAR; }
        if constexpr (!Epi::AFTER_DRAIN) { const int l2_ = lane_id_now(); int fr_ = l2_ & 15, fq_ = l2_ >> 4;
            E(acc, cur, wr, wc, fr_, fq_); S.done(cur); }
        if (!has_next) break;
        cur = nxt; cA = nA; cB = nB; ++ui;
        if constexpr (ALIGN_EPI) { if (wr == 1) PG8_BAR; }
    }
    PG8_WAIT_V(0);
    if constexpr (!ALIGN_EPI) { if (wr == 0) PG8_BAR; }
    PG8_BAR;
    if constexpr (Epi::AFTER_DRAIN) { E.fused(acc, cur, wr, wc, fr, fq, lds, wid, lane); S.done(cur); }
#undef PG8_SA
#undef PG8_SB
#undef PG8_STAGE
#undef PG8_LDA
#undef PG8_LDB
#undef PG8_MMA
#undef PG8_MMA0
#undef PG8_WAIT_V
#undef PG8_WAIT_L
#undef PG8_BAR
#undef PG8_SCHED
}
}


#ifndef PG8_SP2
#define PG8_SP2 true
#endif
#ifndef PG8_ALIGN
#define PG8_ALIGN true
#endif

#ifndef PROBE_REP
#define PROBE_REP 0
#endif
#define TS_SCALE 0.01f
constexpr int NWAVES = 8;
constexpr int BATCH = 8, SEQ = 2048, D = 1024, M = BATCH * SEQ, DFF = 2816, NGU = 2 * DFF, NIN = 2560, INC = 2372;
constexpr size_t MiB = 1u << 20;
constexpr size_t WS_CTL = 0, CTL_ZERO_BYTES = 64 * 1024;
constexpr size_t WS_SSPA = 2 * MiB, WS_SSPB = 3 * MiB;
constexpr size_t WS_TAB = 4 * MiB;
constexpr size_t WS_WI = 5 * MiB;
constexpr size_t WS_MASK = 6 * MiB;
constexpr size_t WS_WGU1 = 10 * MiB, WS_WD1 = 21 * MiB, WS_WIN = 27 * MiB, WS_WOUT = 32 * MiB, WS_WGU2 = 34 * MiB, WS_WD2 = 45 * MiB;
constexpr size_t WS_XB = 52 * MiB;
constexpr size_t WS_MIX = 84 * MiB;
constexpr size_t WS_H = 116 * MiB;
constexpr size_t WS_Q = 116 * MiB, WS_K = 132 * MiB, WS_V = 148 * MiB, WS_U = 164 * MiB, WS_QI = 180 * MiB, WS_KI = 188 * MiB;
constexpr size_t WS_END = 204 * MiB;
constexpr int CW_BAR = 4096;
constexpr int RING_OFF = 0, RING_BYTES = 131072;
constexpr int LDS_BYTES = 163840;
constexpr int LDSCTL_OFF = LDS_BYTES - 1024, MISC_OFF = LDSCTL_OFF + 320;
constexpr float C2 = 0.125f * 1.4426950408889634f;

#define GAS __attribute__((address_space(1)))
#define LAS __attribute__((address_space(3)))
typedef unsigned short bf16;
typedef unsigned v4u __attribute__((ext_vector_type(4)));
typedef float f32x4 __attribute__((ext_vector_type(4)));
typedef short bf16x8 __attribute__((ext_vector_type(8)));
typedef GAS unsigned gu32;
typedef GAS unsigned long long gu64;
#define RLX_AGENT __ATOMIC_RELAXED, __HIP_MEMORY_SCOPE_AGENT
#define LDS_WAIT() asm volatile("s_waitcnt lgkmcnt(0)" ::: "memory")
#define VM_WAIT() asm volatile("s_waitcnt vmcnt(0)" ::: "memory")
__device__ __forceinline__ unsigned long long rt() { return __builtin_amdgcn_s_memrealtime(); }
__device__ __forceinline__ unsigned f2bf(float f) { unsigned u = __builtin_bit_cast(unsigned, f); return (u + 0x7fffu + ((u >> 16) & 1u)) >> 16; }
__device__ __forceinline__ unsigned pk2(float lo, float hi) { return f2bf(lo) | (f2bf(hi) << 16); }

#define XB_TMO      128
#define XB_XCNT(j)  (256  + 64 * (j))
#define XB_XSUB(j)  (1280 + 64 * (j))
#define XB_XGEN(j)  (2304 + 64 * (j))
#define XB_TOP      3328
#define XB_TOPGEN   3392
#define XCD_BAR_WORDS 3456
#define XB_SPIN_CAP (1u << 18)

__device__ __forceinline__ unsigned xb_ld(unsigned* p)              { return __hip_atomic_load(p, __ATOMIC_RELAXED, __HIP_MEMORY_SCOPE_AGENT); }
__device__ __forceinline__ unsigned xb_add(unsigned* p, unsigned v) { return __hip_atomic_fetch_add(p, v, __ATOMIC_RELAXED, __HIP_MEMORY_SCOPE_AGENT); }
__device__ __forceinline__ unsigned xb_xcc_id() { return (unsigned)__builtin_amdgcn_s_getreg((3 << 11) | 20) & 0xFu; }
#define XB_SPIN(cond, bar) do { unsigned _sp = 0; while (cond) { __builtin_amdgcn_s_sleep(1); \
    if ((++_sp & 255u) == 0u) { if (xb_ld(&(bar)[XB_TMO])) break; if (_sp > XB_SPIN_CAP) { atomicAdd(&(bar)[XB_TMO], 1u); break; } } } } while (0)

struct XcdBarrier {
    unsigned* bar; unsigned x; int leader;
    volatile LAS unsigned* st;
};

__device__ __forceinline__ bool xb_is_thread0(int leader) { return leader && pg8::lane_id_now() == 0; }
__device__ __forceinline__ XcdBarrier xcd_barrier_post(unsigned* bar, volatile LAS unsigned* st, int wave_id) {
    XcdBarrier b; b.bar = bar; b.x = xb_xcc_id(); b.st = st; b.leader = (wave_id == 0) ? 1 : 0;
    if (xb_is_thread0(b.leader)) (void)xb_add(&bar[XB_XCNT(b.x)], 1u);
    return b;
}
__device__ __forceinline__ void xcd_barrier_complete(unsigned* bar, unsigned x, unsigned& nloc, unsigned& nx) {
    const unsigned G = gridDim.x * gridDim.y * gridDim.z;
    unsigned sum, cnt, mine, sp = 0u;
    for (;;) {
        sum = 0u; cnt = 0u; mine = 0u;
#pragma unroll
        for (unsigned j = 0; j < 16; ++j) { const unsigned c = xb_ld(&bar[XB_XCNT(j)]); sum += c; cnt += (c > 0u) ? 1u : 0u; mine = (j == x) ? c : mine; }
        if (sum == G) break;
        __builtin_amdgcn_s_sleep(1);
        if ((++sp & 255u) == 0u) { if (xb_ld(&bar[XB_TMO])) break; if (sp > XB_SPIN_CAP) { atomicAdd(&bar[XB_TMO], 1u); break; } }
    }
    nloc = mine > 0u ? mine : 1u; nx = cnt > 0u ? cnt : 1u;
}

__device__ __forceinline__ void xcd_barrier(const XcdBarrier& b) {
    asm volatile("s_waitcnt vmcnt(0)" ::: "memory");
    __syncthreads();
    if (xb_is_thread0(b.leader)) {
        unsigned* bar = b.bar;
        __builtin_amdgcn_s_waitcnt(0);
        unsigned nloc = b.st[0], nx = b.st[1];
        if (nloc == 0u) { xcd_barrier_complete(bar, b.x, nloc, nx); b.st[0] = nloc; b.st[1] = nx; }
        const unsigned old = xb_add(&bar[XB_XSUB(b.x)], 1u);
        const unsigned gen = old / nloc;
        if (old + 1u == (gen + 1u) * nloc) {
            __builtin_amdgcn_fence(__ATOMIC_RELEASE, "agent");
            asm volatile("s_waitcnt vmcnt(0)" ::: "memory");
            const unsigned og = xb_add(&bar[XB_TOP], 1u);
            const unsigned tg = og / nx;
            if (og + 1u == (tg + 1u) * nx) xb_add(&bar[XB_TOPGEN], 1u);
            else XB_SPIN(xb_ld(&bar[XB_TOPGEN]) == tg, bar);
            __builtin_amdgcn_fence(__ATOMIC_ACQUIRE, "agent");
            xb_add(&bar[XB_XGEN(b.x)], 1u);
            asm volatile("s_waitcnt vmcnt(0)" ::: "memory");
        } else {
            XB_SPIN(xb_ld(&bar[XB_XGEN(b.x)]) == gen, bar);
            __builtin_amdgcn_fence(__ATOMIC_ACQUIRE, "agent");
            asm volatile("s_waitcnt vmcnt(0)" ::: "memory");
        }
    }
    __syncthreads();
}


struct Frame {
    LAS unsigned char* lds;
    volatile LAS unsigned* MISC;
    gu32* ctl;
    int tid, lane, wave;
    int vcu, G;
};
__device__ __forceinline__ float wave_sum(float v) {
#pragma unroll
    for (int o = 1; o < 64; o <<= 1) v += __shfl_xor(v, o);
    return v;
}
template <class Map>
__device__ __forceinline__ void transpose_item(const float* W, int K, int N, const float* gk, bf16* WT, int ldk, Map map, LAS float* scr, int item, int lane) {
    const int nblk = (N + 31) / 32, kb = item / nblk, nb = item % nblk, k0 = 64 * kb, n0 = 32 * nb;
    (void)K;
    float tv[32];
    { const int n = n0 + (lane & 31); const bool ok = n < N; const float* wp = W + (size_t)(k0 + (lane >> 5)) * N + (ok ? n : 0);
#pragma unroll
      for (int i = 0; i < 32; ++i) tv[i] = wp[(size_t)(2 * i) * N];
      if (gk) {
#pragma unroll
          for (int i = 0; i < 32; ++i) tv[i] *= gk[k0 + 2 * i + (lane >> 5)];
      }
#pragma unroll
      for (int i = 0; i < 32; ++i) scr[(2 * i + (lane >> 5)) * 33 + (lane & 31)] = ok ? tv[i] : 0.f; }
    LDS_WAIT(); asm volatile("" ::: "memory");
    const int c = lane & 7;
#pragma unroll
    for (int j = 0; j < 4; ++j) { const int nn = (lane >> 3) + 8 * j, n = n0 + nn; const LAS float* s = scr + (8 * c) * 33 + nn;
        if (n < N) { const int dst = map(n);
            v4u o; o.x = pk2(s[0 * 33], s[1 * 33]); o.y = pk2(s[2 * 33], s[3 * 33]); o.z = pk2(s[4 * 33], s[5 * 33]); o.w = pk2(s[6 * 33], s[7 * 33]);
            *(GAS v4u*)(WT + (size_t)dst * ldk + k0 + 8 * c) = o; } }
    LDS_WAIT(); asm volatile("" ::: "memory");
}
struct MapPlain { __device__ __forceinline__ int operator()(int n) const { return n; } };
struct MapGate { int add; __device__ __forceinline__ int operator()(int n) const { return 256 * (n >> 7) + (n & 127) + add; } };
__device__ __forceinline__ int idx_slot(int d) { return (d < 16) ? d : (d < 32) ? 128 + (d - 16) : (d < 48) ? 16 + (d - 32) : 128 + 16 + (d - 48); }
struct MapIn {
    __device__ __forceinline__ int operator()(int n) const {
        if (n < 1024) { const int kq = n >> 9, nn = n & 511, head = nn >> 6, d = nn & 63; return kq * 512 + 256 * (head >> 2) + 128 * (d >> 5) + 32 * (head & 3) + (d & 31); }
        if (n < 1536) return n;
        if (n < 1792) { const int nn = n - 1536, h = nn >> 6, d = nn & 63; return 2048 + 32 * h + idx_slot(d); }
        if (n < 1856) return 2304 + idx_slot(n - 1792);
        if (n < 1860) return 2304 + 32 + (n - 1856);
        return 1536 + (n - 1860);
    }
};

struct Args { const float* in[16]; float* out; unsigned char* ws; int ph_lo, ph_hi, li, pad; };

__device__ __forceinline__ void weight_items(Frame& F, const Args& a, int set, int gw, int NGW) {
    unsigned char* ws = a.ws;
    LAS float* scr = (LAS float*)(F.lds + RING_OFF + F.wave * 16384);
    const int lane = pg8::lane_id_now();
    const float *f1n = a.in[1], *f1g = a.in[2], *f1u = a.in[3], *f1d = a.in[4], *mixn = a.in[5], *win = a.in[6], *poolw = a.in[9], *pools = a.in[10], *wout = a.in[11],
                *f2n = a.in[12], *f2g = a.in[13], *f2u = a.in[14], *f2d = a.in[15];
    bf16* WGU1 = (bf16*)(ws + WS_WGU1); bf16* WD1 = (bf16*)(ws + WS_WD1); bf16* WIN = (bf16*)(ws + WS_WIN); bf16* WOUT = (bf16*)(ws + WS_WOUT); bf16* WGU2 = (bf16*)(ws + WS_WGU2); bf16* WD2 = (bf16*)(ws + WS_WD2);
    constexpr int I_G = (D / 64) * (DFF / 32), I_D = (DFF / 64) * (D / 32), I_IN = (D / 64) * ((INC + 31) / 32), I_O = (512 / 64) * (D / 32);
    if (set == 0) {
        for (int it = gw; it < 2 * I_G; it += NGW) {
            if (it < I_G) transpose_item(f1g, D, DFF, f1n, WGU1, D, MapGate{0}, scr, it, lane);
            else transpose_item(f1u, D, DFF, f1n, WGU1, D, MapGate{128}, scr, it - I_G, lane);
        }
    } else if (set == 2) {
        for (int it = gw; it < 2 * I_G; it += NGW) {
            if (it < I_G) transpose_item(f2g, D, DFF, f2n, WGU2, D, MapGate{0}, scr, it, lane);
            else transpose_item(f2u, D, DFF, f2n, WGU2, D, MapGate{128}, scr, it - I_G, lane);
        }
    } else if (set == 3) {
        for (int it = gw; it < I_D; it += NGW) transpose_item(f2d, DFF, D, nullptr, WD2, DFF, MapPlain{}, scr, it, lane);
    } else {
        for (int it = gw; it < I_D + I_IN + I_O; it += NGW) {
            int r = it;
            if (r < I_D) { transpose_item(f1d, DFF, D, nullptr, WD1, DFF, MapPlain{}, scr, r, lane); continue; } r -= I_D;
            if (r < I_IN) { transpose_item(win, D, INC, mixn, WIN, D, MapIn{}, scr, r, lane); continue; } r -= I_IN;
            transpose_item(wout, 512, D, nullptr, WOUT, D, MapPlain{}, scr, r, lane);
        }
    }
    if (set == 1) {
        for (int j = gw; j < 256; j += NGW) {
            const int bj = j >> 7, wc = (j >> 5) & 3, i = j & 31;
            const bool covered = (wc == 0) || (wc == 1 && bj == 0 && i < 4);
            if (!covered) { GAS v4u* o = (GAS v4u*)(WIN + (size_t)(2304 + j) * D) + lane; o[0] = (v4u){0u, 0u, 0u, 0u}; o[64] = (v4u){0u, 0u, 0u, 0u}; }
        }
    }
}
__device__ __forceinline__ void wpo_items(Frame& F, const Args& a, int gw, int NGW, int it_lo, int it_hi) {
    unsigned char* ws = a.ws; bf16* WOUT = (bf16*)(ws + WS_WOUT);
    LAS float* scr = (LAS float*)(F.lds + RING_OFF + F.wave * 16384);
    const int lane = pg8::lane_id_now(); const float *poolw = a.in[9], *pools = a.in[10], *wout = a.in[11];
#pragma unroll 1
    for (int it = it_lo + gw; it < it_hi; it += NGW) {
        const int g = it >> 9, nb = (it >> 5) & 15, cb = it & 31, n = nb * 64 + lane;
        float ac[4] = {0.f, 0.f, 0.f, 0.f};
        const float* pw = poolw + ((size_t)g * 128 + cb * 4) * 128;
        const float* wsrc = wout + (size_t)(512 + g * 128) * D + nb * 64; const float* psrc = pools + g * 128;
#pragma unroll 1
        for (int half = 0; half < 2; ++half) {
#pragma unroll
            for (int dd = 0; dd < 64; ++dd)
                __builtin_amdgcn_global_load_lds((const unsigned*)(wsrc + (size_t)(half * 64 + dd) * D) + lane, (LAS unsigned*)(scr + dd * 64), 4, 0, 0);
            asm volatile("s_waitcnt vmcnt(0)" ::: "memory");
#pragma unroll 8
            for (int dd = 0; dd < 64; ++dd) { const float w = scr[dd * 64 + lane] * psrc[half * 64 + dd];
#pragma unroll
                for (int cc = 0; cc < 4; ++cc) ac[cc] = fmaf(pw[cc * 128 + half * 64 + dd], w, ac[cc]); }
            LDS_WAIT(); asm volatile("" ::: "memory");
        }
        *(GAS unsigned long long*)(WOUT + (size_t)n * D + 512 + g * 128 + cb * 4) = (unsigned long long)pk2(ac[0], ac[1]) | ((unsigned long long)pk2(ac[2], ac[3]) << 32);
    }
}
__device__ __forceinline__ void p0_prologue(Frame& F, const Args& a) {
    unsigned char* ws = a.ws;
    const int gw = F.vcu * NWAVES + F.wave, NGW = F.G * NWAVES, lane = pg8::lane_id_now();
    const float* x = a.in[0];
    weight_items(F, a, 0, gw, NGW);
    if (F.G != 256) wpo_items(F, a, gw, NGW, 0, 2048);
    if (F.G != 256) { weight_items(F, a, 1, gw, NGW); weight_items(F, a, 2, gw, NGW); weight_items(F, a, 3, gw, NGW); }
    float* cosH = (float*)(ws + WS_TAB); float* sinH = cosH + SEQ * 32; float* cosI = sinH + SEQ * 32; float* sinI = cosI + SEQ * 16;
    for (int idx = gw * 64 + lane; idx < SEQ * 48; idx += NGW * 64) {
        if (idx < SEQ * 32) { const int p = idx >> 5, i = idx & 31; const float inv = (float)pow(10000.0, -(double)i / 32.0); const float ang = __fmul_rn((float)p, inv); cosH[idx] = (float)cos((double)ang); sinH[idx] = (float)sin((double)ang); }
        else { const int j = idx - SEQ * 32, p = j >> 4, i = j & 15; const float inv = (float)pow(10000.0, -(double)i / 16.0); const float ang = __fmul_rn((float)p, inv); cosI[j] = (float)cos((double)ang); sinI[j] = (float)sin((double)ang); }
    }
    bf16* XB = (bf16*)(ws + WS_XB); float* sspA = (float*)(ws + WS_SSPA);
    for (int m0 = gw; m0 < M; m0 += 4 * NGW) {
        f32x4 v[4][4]; float s[4];
#pragma unroll
        for (int q = 0; q < 4; ++q) { const GAS f32x4* xr = (const GAS f32x4*)(x + (size_t)(m0 + q * NGW) * D) + lane;
#pragma unroll
            for (int j = 0; j < 4; ++j) v[q][j] = xr[64 * j]; }
#pragma unroll
        for (int q = 0; q < 4; ++q) { float a = 0.f;
#pragma unroll
            for (int j = 0; j < 4; ++j) a += (v[q][j].x * v[q][j].x + v[q][j].y * v[q][j].y) + (v[q][j].z * v[q][j].z + v[q][j].w * v[q][j].w);
            s[q] = wave_sum(a); }
#pragma unroll
        for (int q = 0; q < 4; ++q) { const int m = m0 + q * NGW;
            GAS unsigned long long* o8 = (GAS unsigned long long*)(XB + (size_t)m * D) + lane;
#pragma unroll
            for (int j = 0; j < 4; ++j) o8[64 * j] = (unsigned long long)pk2(v[q][j].x, v[q][j].y) | ((unsigned long long)pk2(v[q][j].z, v[q][j].w) << 32);
            if (lane < 16) sspA[(size_t)m * 16 + lane] = (lane == 0) ? s[q] : 0.f; }
    }
}

#ifndef SEL_REP
#define SEL_REP 1
#endif
#ifndef SEL_ABL
#define SEL_ABL 1
#endif
#ifndef POOL_REP
#define POOL_REP 1
#endif
__device__ __forceinline__ int wave_sum_dpp(int v) {
    v += __builtin_amdgcn_update_dpp(0, v, 0x111, 0xf, 0xf, false);
    v += __builtin_amdgcn_update_dpp(0, v, 0x112, 0xf, 0xf, false);
    v += __builtin_amdgcn_update_dpp(0, v, 0x114, 0xf, 0xf, false);
    v += __builtin_amdgcn_update_dpp(0, v, 0x118, 0xf, 0xf, false);
    v += __builtin_amdgcn_update_dpp(0, v, 0x142, 0xa, 0xf, false);
    v += __builtin_amdgcn_update_dpp(0, v, 0x143, 0xc, 0xf, false);
    return __builtin_amdgcn_readlane(v, 63);
}
__device__ __forceinline__ void cnt4(int& na, int& nb, unsigned ka0, unsigned kb0, unsigned ka1, unsigned kb1, unsigned ca, unsigned cb) {
    unsigned long long s0, s1, s2;
    asm volatile("v_cmp_le_u32_e32 vcc, %9, %5\n\t"
                 "v_cmp_le_u32_e64 %2, %10, %6\n\t"
                 "v_cmp_le_u32_e64 %3, %9, %7\n\t"
                 "v_cmp_le_u32_e64 %4, %10, %8\n\t"
                 "v_addc_co_u32_e32 %0, vcc, 0, %0, vcc\n\t"
                 "v_addc_co_u32_e64 %1, %2, 0, %1, %2\n\t"
                 "v_addc_co_u32_e64 %0, %3, 0, %0, %3\n\t"
                 "v_addc_co_u32_e64 %1, %4, 0, %1, %4"
                 : "+v"(na), "+v"(nb), "=&s"(s0), "=&s"(s1), "=&s"(s2) : "v"(ka0), "v"(kb0), "v"(ka1), "v"(kb1), "s"(ca), "s"(cb) : "vcc");
}
template <int NC>
__device__ __forceinline__ void build_mask(const unsigned (&kv)[NC], unsigned thr, int need, int lane, GAS unsigned long long* mrow) {
    unsigned mlo = 0u, mhi = 0u; int tbase = 0;
#pragma unroll
    for (int c = 0; c < NC; ++c) {
        unsigned long long m = __ballot(kv[c] > thr);
        if (need > 0 && tbase < need) {
            const unsigned long long em = __ballot(kv[c] == thr);
            const int ce = __popcll(em);
            if (tbase + ce <= need) m |= em;
            else { const int pre = __builtin_amdgcn_mbcnt_hi((unsigned)(em >> 32), __builtin_amdgcn_mbcnt_lo((unsigned)em, 0u)); m |= __ballot(kv[c] == thr && pre < need - tbase); }
            tbase += ce;
        }
        asm volatile("s_nop 1\n\tv_writelane_b32 %0, %2, %4\n\tv_writelane_b32 %1, %3, %4" : "+v"(mlo), "+v"(mhi) : "s"((unsigned)m), "s"((unsigned)(m >> 32)), "i"(c));
    }
    if (lane < 32) mrow[(size_t)lane * SEQ] = ((unsigned long long)mhi << 32) | mlo;
}
__device__ __forceinline__ unsigned wave_max_dpp(unsigned v) {
    unsigned t;
    t = (unsigned)__builtin_amdgcn_update_dpp(0, (int)v, 0x111, 0xf, 0xf, false); v = v > t ? v : t;
    t = (unsigned)__builtin_amdgcn_update_dpp(0, (int)v, 0x112, 0xf, 0xf, false); v = v > t ? v : t;
    t = (unsigned)__builtin_amdgcn_update_dpp(0, (int)v, 0x114, 0xf, 0xf, false); v = v > t ? v : t;
    t = (unsigned)__builtin_amdgcn_update_dpp(0, (int)v, 0x118, 0xf, 0xf, false); v = v > t ? v : t;
    t = (unsigned)__builtin_amdgcn_update_dpp(0, (int)v, 0x142, 0xa, 0xf, false); v = v > t ? v : t;
    t = (unsigned)__builtin_amdgcn_update_dpp(0, (int)v, 0x143, 0xc, 0xf, false); v = v > t ? v : t;
    return (unsigned)__builtin_amdgcn_readlane((int)v, 63);
}
__device__ __forceinline__ unsigned f2key(float f) { const unsigned u = __float_as_uint(f); return (u & 0x80000000u) ? ~u : (u | 0x80000000u); }
__device__ __forceinline__ float key2f(unsigned k) { return __uint_as_float((k & 0x80000000u) ? (k & 0x7fffffffu) : ~k); }
struct RowSearch {
    unsigned lo, hi, thr; int cl, ch, need, last; float wl, wh; bool act;
    __device__ __forceinline__ void init(bool wanted, int ncausal, int cz0, int cz1, unsigned kmax, unsigned kmin) {
        act = false; thr = 0u; need = 0; lo = 0u; hi = 0u; cl = 0; ch = 0; last = 0; wl = 1.f; wh = 1.f;
        if (!wanted) return;
        if (cz1 <= 256 && cz0 >= 256) { thr = 0x80000000u; need = 256 - cz1; return; }
        act = true;
        if (cz1 > 256) { lo = 0x80000001u; cl = cz1; hi = kmax + 1u; ch = 0; }
        else { lo = kmin; cl = ncausal; hi = 0x80000000u; ch = cz0; }
        wl = (float)(cl - 256); wh = (float)(256 - ch);
    }
    __device__ __forceinline__ unsigned next_cand(int it) {
        if (!act) return 0xffffffffu;
        if (hi - lo <= 1u) { thr = lo; need = 256 - ch; act = false; return 0xffffffffu; }
        const float fl = key2f(lo), fh = key2f(hi);
        unsigned c = f2key((fl * wh + fh * wl) * __builtin_amdgcn_rcpf(wl + wh));
        if (it >= 24) c = lo + ((hi - lo) >> 1);
        if (c <= lo) c = lo + 1u;
        if (c >= hi) c = hi - 1u;
        return c;
    }
    __device__ __forceinline__ void update(unsigned c, int cnt) {
        if (!act) return;
        if (cnt == 256) { thr = c - 1u; need = 0; act = false; }
        else if (cnt > 256) { lo = c; cl = cnt; wl = (float)(cnt - 256); if (last == 1) wh *= 0.5f; last = 1; }
        else { hi = c; ch = cnt; wh = (float)(256 - cnt); if (last == -1) wl *= 0.5f; last = -1; }
    }
};
template <int NC>
__device__ __forceinline__ void select_rows2(const LAS unsigned* sa, int nchunks, int ta, int lane, GAS unsigned long long* ma) {
    unsigned ka[NC], kb[NC];
#pragma unroll
    for (int c = 0; c < NC; ++c) { ka[c] = (c < nchunks) ? sa[64 * c + lane] : 0u; kb[c] = (c < nchunks) ? sa[2048 + 64 * c + lane] : 0u; }
    LDS_WAIT(); __builtin_amdgcn_s_barrier(); asm volatile("" ::: "memory");
    RowSearch A, B;
    if (ta + 2 > 256) {
        int a0 = 0, b0 = 0, a1 = 0, b1 = 0;
#pragma unroll
        for (int c = 0; c < NC; c += 2) cnt4(a0, b0, ka[c], kb[c], ka[c + 1], kb[c + 1], 0x80000000u, 0x80000000u);
#pragma unroll
        for (int c = 0; c < NC; c += 2) cnt4(a1, b1, ka[c], kb[c], ka[c + 1], kb[c + 1], 0x80000001u, 0x80000001u);
        unsigned mxa = 0u, mxb = 0u, mna = 0u, mnb = 0u;
#pragma unroll
        for (int c = 0; c < NC; ++c) { mxa = ka[c] > mxa ? ka[c] : mxa; mxb = kb[c] > mxb ? kb[c] : mxb;
            const unsigned ia = ~(ka[c] - 1u), ib = ~(kb[c] - 1u); mna = ia > mna ? ia : mna; mnb = ib > mnb ? ib : mnb; }
        const int t0s = wave_sum_dpp(a0 | (b0 << 16)), t1s = wave_sum_dpp(a1 | (b1 << 16));
        const unsigned kmxa = wave_max_dpp(mxa), kmxb = wave_max_dpp(mxb), kmna = ~wave_max_dpp(mna) + 1u, kmnb = ~wave_max_dpp(mnb) + 1u;
        A.init(ta + 1 > 256, ta + 1, t0s & 0xffff, t1s & 0xffff, kmxa, kmna);
        B.init(true, ta + 2, t0s >> 16, t1s >> 16, kmxb, kmnb);
        for (int it = 0; it < 64; ++it) {
            const unsigned ca = A.next_cand(it), cb = B.next_cand(it);
            if (!(A.act || B.act)) break;
            int na = 0, nb = 0;
#pragma unroll
            for (int c = 0; c < NC; c += 2) cnt4(na, nb, ka[c], kb[c], ka[c + 1], kb[c + 1], ca, cb);
            const int tot = wave_sum_dpp(na | (nb << 16));
            A.update(ca, tot & 0xffff); B.update(cb, tot >> 16);
        }
    } else { A.init(false, 0, 0, 0, 0u, 0u); B.init(false, 0, 0, 0, 0u, 0u); }
    build_mask<NC>(ka, A.thr, A.need, lane, ma);
    build_mask<NC>(kb, B.thr, B.need, lane, ma + 1);
}
template <int G>
__device__ __forceinline__ void pool_task(const bf16* U, bf16* MIX, int R0, int lane) {
    constexpr int WL = 2 << G;
    const int rq = lane >> 4, co = lane & 15, r0 = R0 + 4 * rq, tq = r0 & (SEQ - 1), ch = G * 128 + co * 8;
    v4u uu[WL + 3];
#pragma unroll
    for (int i = 0; i < WL + 3; ++i) { const int dt = i - (WL - 1); uu[i] = (tq + dt >= 0) ? *(const GAS v4u*)(U + (size_t)(r0 + dt) * 512 + ch) : (v4u){0u, 0u, 0u, 0u}; }
    float sl[4], sh[4];
#pragma unroll
    for (int q = 0; q < 4; ++q) {
        float al = 0.f, ah = 0.f;
#pragma unroll
        for (int jj = 0; jj < WL; ++jj) { const unsigned x = uu[jj][q]; al += __uint_as_float(x << 16); ah += __uint_as_float(x & 0xffff0000u); }
        sl[q] = al; sh[q] = ah;
    }
#pragma unroll
    for (int i = 0; i < 4; ++i) {
        const int t = tq + i, n = (t + 1 < WL) ? (t + 1) : WL; const float inv = 1.0f / (float)n;
        unsigned ow[4];
#pragma unroll
        for (int q = 0; q < 4; ++q) {
            const unsigned xc = uu[WL - 1 + i][q]; const float cl = __uint_as_float(xc << 16), chh = __uint_as_float(xc & 0xffff0000u);
            if (i > 0) { const unsigned xo = uu[i - 1][q]; sl[q] += cl - __uint_as_float(xo << 16); sh[q] += chh - __uint_as_float(xo & 0xffff0000u); }
            ow[q] = pk2(sl[q] * inv - cl, sh[q] * inv - chh);
        }
        *(GAS v4u*)(MIX + (size_t)(r0 + i) * 1024 + 512 + ch) = (v4u){ow[0], ow[1], ow[2], ow[3]};
    }
}
__device__ __forceinline__ void select_phase(Frame& F, const bf16* QI, const bf16* KI, const float* WI, unsigned long long* MASK, const bf16* U, bf16* MIX) {
    LAS unsigned* SC = (LAS unsigned*)(F.lds + RING_OFF);
    const int lane = pg8::lane_id_now(), wave = F.wave, fr = lane & 15, fq = lane >> 4;
    LAS unsigned* jobctr = (LAS unsigned*)(F.lds + LDSCTL_OFF + 512);
    if (wave * 64 + lane < 16) jobctr[wave * 64 + lane] = 0u;
    LDS_WAIT(); __builtin_amdgcn_s_barrier(); asm volatile("" ::: "memory");
    pg8::bf16x8 afr[4][2]; f32x4 w[4];
#pragma unroll 1
    for (int uu_ = 0; uu_ < 4 * SEL_REP; ++uu_) {
        const int ui = uu_ & 3, b = F.vcu >> 5, j = F.vcu & 31;
        const int g = (ui == 0) ? 127 - j : (ui == 1) ? 64 + j : (ui == 2) ? 63 - j : j;
        const int t0 = 16 * g; const size_t rowbase = (size_t)b * SEQ;
        const int nchunks = (t0 + 16 + 63) >> 6, ntiles = nchunks * 4;
        if (uu_ == 0) {
#pragma unroll
            for (int h = 0; h < 4; ++h)
#pragma unroll
                for (int ks = 0; ks < 2; ++ks) afr[h][ks] = *(const pg8::bf16x8*)(QI + (rowbase + t0 + fr) * 256 + 64 * h + 32 * ks + 8 * fq);
#pragma unroll
            for (int r = 0; r < 4; ++r) w[r] = *(const f32x4*)(WI + (rowbase + t0 + 4 * fq + r) * 4);
        }
        if (uu_ < 4 || SEL_ABL != 3) {
        LAS unsigned* ctr = jobctr + uu_;
        int job; { unsigned j_ = 0u; if (lane == 0) j_ = __hip_atomic_fetch_add(ctr, 1u, __ATOMIC_RELAXED, __HIP_MEMORY_SCOPE_WORKGROUP); job = __builtin_amdgcn_readfirstlane((int)j_); }
        pg8::bf16x8 bfr[4][2];
        if (job < nchunks) {
#pragma unroll
            for (int i = 0; i < 4; ++i) { const bf16* kp = KI + ((rowbase >> 4) + 4 * job + i) * 1024 + (fq * 16 + fr) * 8; bfr[i][0] = *(const pg8::bf16x8*)kp; bfr[i][1] = *(const pg8::bf16x8*)(kp + 512); }
        }
#pragma unroll 1
        while (job < nchunks) {
            int nxt; { unsigned j_ = 0u; if (lane == 0) j_ = __hip_atomic_fetch_add(ctr, 1u, __ATOMIC_RELAXED, __HIP_MEMORY_SCOPE_WORKGROUP); nxt = __builtin_amdgcn_readfirstlane((int)j_); }
            pg8::bf16x8 bnx[4][2];
            { const int jn = (nxt < nchunks) ? nxt : job;
#pragma unroll
              for (int i = 0; i < 4; ++i) { const bf16* kp = KI + ((rowbase >> 4) + 4 * jn + i) * 1024 + (fq * 16 + fr) * 8; bnx[i][0] = *(const pg8::bf16x8*)kp; bnx[i][1] = *(const pg8::bf16x8*)(kp + 512); } }
#pragma unroll
            for (int i = 0; i < 4; ++i) {
                const int tile = 4 * job + i;
                {
                    const int key = 16 * tile + fr;
                    f32x4 acc[4];
#pragma unroll
                    for (int h = 0; h < 4; ++h) {
                        acc[h] = __builtin_amdgcn_mfma_f32_16x16x32_bf16(afr[h][0], bfr[i][0], (f32x4){0.f, 0.f, 0.f, 0.f}, 0, 0, 0);
                        acc[h] = __builtin_amdgcn_mfma_f32_16x16x32_bf16(afr[h][1], bfr[i][1], acc[h], 0, 0, 0);
                    }
                    const bool edge = 16 * tile + 15 > t0;
#pragma unroll
                    for (int r = 0; r < 4; ++r) {
                        float sc = 0.f;
#pragma unroll
                        for (int h = 0; h < 4; ++h) { const int ri = __float_as_int(acc[h][r]); sc = fmaf(w[r][h], __int_as_float(ri > 0 ? ri : 0), sc); }
                        const int u = __float_as_int(sc);
                        unsigned sk = (unsigned)u ^ ((unsigned)(u >> 31) | 0x80000000u);
                        if (edge) sk = (key <= t0 + 4 * fq + r) ? sk : 0u;
                        SC[(4 * fq + r) * 2048 + key] = sk;
                    }
                }
            }
#pragma unroll
            for (int i = 0; i < 4; ++i) { bfr[i][0] = bnx[i][0]; bfr[i][1] = bnx[i][1]; }
            job = nxt;
        }
        }
        if (uu_ + 1 < 4 * SEL_REP) {
            const int ui2 = (uu_ + 1) & 3, g2 = (ui2 == 0) ? 127 - j : (ui2 == 1) ? 64 + j : (ui2 == 2) ? 63 - j : j, t02 = 16 * g2;
#pragma unroll
            for (int h = 0; h < 4; ++h)
#pragma unroll
                for (int ks = 0; ks < 2; ++ks) afr[h][ks] = *(const pg8::bf16x8*)(QI + (rowbase + t02 + fr) * 256 + 64 * h + 32 * ks + 8 * fq);
#pragma unroll
            for (int r = 0; r < 4; ++r) w[r] = *(const f32x4*)(WI + (rowbase + t02 + 4 * fq + r) * 4);
        }
        LDS_WAIT(); __builtin_amdgcn_s_barrier(); asm volatile("" ::: "memory");
        {
            const int ncr = (nchunks + 3) >> 2;
            const int rl = 2 * wave, t = t0 + rl;
            const LAS unsigned* srow = SC + rl * 2048;
            GAS unsigned long long* mrow = (GAS unsigned long long*)MASK + (uu_ >= 4 ? (size_t)202 * 1024 * 1024 / 8 : (size_t)0) + (size_t)b * 32 * SEQ + t;
            if (uu_ < 4 || SEL_ABL == 1 || SEL_ABL == 3) switch (ncr) {
                case 1: select_rows2<4>(srow, nchunks, t, lane, mrow); break;
                case 2: select_rows2<8>(srow, nchunks, t, lane, mrow); break;
                case 3: select_rows2<12>(srow, nchunks, t, lane, mrow); break;
                case 4: select_rows2<16>(srow, nchunks, t, lane, mrow); break;
                case 5: select_rows2<20>(srow, nchunks, t, lane, mrow); break;
                case 6: select_rows2<24>(srow, nchunks, t, lane, mrow); break;
                case 7: select_rows2<28>(srow, nchunks, t, lane, mrow); break;
                default: select_rows2<32>(srow, nchunks, t, lane, mrow); break;
            }
            else { LDS_WAIT(); __builtin_amdgcn_s_barrier(); asm volatile("" ::: "memory"); }
        }
    }
    const int gw = F.vcu * NWAVES + F.wave, NGW = F.G * NWAVES;
#pragma unroll 1
    for (int wt = gw; wt < POOL_REP * (M / 8); wt += NGW) {
        const int rb = (wt >> 1) & (M / 16 - 1), odd = wt & 1;
        if (odd) { pool_task<1>(U, MIX, rb * 16, lane); pool_task<2>(U, MIX, rb * 16, lane); }
        else     { pool_task<0>(U, MIX, rb * 16, lane); pool_task<3>(U, MIX, rb * 16, lane); }
    }
}

#include <hip/hip_bf16.h>
namespace attn_body {
using bf16=__hip_bfloat16;
using bf16x8=__attribute__((ext_vector_type(8)))short;
using s16x4=__attribute__((ext_vector_type(4)))short;
using f32x16=__attribute__((ext_vector_type(16)))float;
using u32x4=__attribute__((ext_vector_type(4)))unsigned;
constexpr int BATCH=8,NHEAD=8,SEQ=2048,D=64,KP=512,OP=1024;
constexpr int NW=8,QBLK=32,QB=QBLK*NW,KVBLK=64,NQB=SEQ/QB;
constexpr int ATTN_UNIT_ROWS=QB;
__device__ __forceinline__ int crow(int r,int hi){return (r&3)+8*(r>>2)+4*hi;}
#define SBAR() __builtin_amdgcn_sched_barrier(0)
__device__ __forceinline__ void cmask(f32x16&p0,f32x16&p1,int jb,int qrel,int hi){
  const float NEG=-INFINITY; int kb=64*jb+4*hi;
  #pragma unroll
  for(int r=0;r<16;++r){int kv=kb+(r&3)+8*(r>>2); if(kv>qrel)p0[r]=NEG; if(kv+32>qrel)p1[r]=NEG;}
}

constexpr int NSLOT=3, SLOTB=8192;
constexpr int LDS_K=0, LDS_V=NSLOT*SLOTB, LDS_WS=2*NSLOT*SLOTB, LDS_OST=LDS_WS+NW*64*4, LDS_BYTES=LDS_OST+NW*4096, LDS_MASK=LDS_BYTES, LDS_TOTAL=LDS_MASK+32*2048;
constexpr float C2=0.125f*1.4426950408889634f;
__device__ __forceinline__ void glds16(const void*sbase,unsigned voff,unsigned lds_dst){unsigned keep;
  asm volatile("s_mov_b32 %0, m0\n\ts_mov_b32 m0, %2\n\ts_nop 4\n\tglobal_load_lds_dwordx4 %1, %3\n\ts_mov_b32 m0, %0":"=&s"(keep):"v"(voff),"s"(lds_dst),"s"(sbase):"memory");}
__device__ __forceinline__ float max3f(float a,float b,float c){float r;asm("v_max3_f32 %0, %1, %2, %3":"=v"(r):"v"(a),"v"(b),"v"(c));return r;}
__device__ __forceinline__ float max2f(float a,float b){float r;asm("v_max_f32_e32 %0, %1, %2":"=v"(r):"v"(a),"v"(b));return r;}
__device__ __forceinline__ float fadd_s(float a,float b){float r;asm("v_add_f32_e32 %0, %1, %2":"=v"(r):"v"(a),"v"(b));return r;}
__device__ __forceinline__ float fsub_s(float a,float b){float r;asm("v_sub_f32_e32 %0, %1, %2":"=v"(r):"v"(a),"v"(b));return r;}
typedef float f32x2_t __attribute__((ext_vector_type(2))); typedef __bf16 bf16x2_t __attribute__((ext_vector_type(2)));
__device__ __forceinline__ unsigned cvtpk_s(float lo,float hi){f32x2_t v={lo,hi};bf16x2_t b=__builtin_convertvector(v,bf16x2_t);return __builtin_bit_cast(unsigned,b);}
#define WAIT_BAR(N) asm volatile("s_waitcnt vmcnt(" #N ") lgkmcnt(0)\n\ts_barrier":::"memory")

__device__ __forceinline__ void qkt(f32x16&p0,f32x16&p1,const char*Kslot,const bf16x8*qr,const f32x16&negm,int r32,int hi){
  const char*kb=Kslot+hi*1024+r32*16;
  #pragma unroll
  for(int d0=0;d0<4;++d0){
    const bf16x8 b0=*reinterpret_cast<const bf16x8*>(kb+d0*2048);
    const bf16x8 b1=*reinterpret_cast<const bf16x8*>(kb+d0*2048+512);
    if(d0==0){p0=__builtin_amdgcn_mfma_f32_32x32x16_bf16(b0,qr[0],negm,0,0,0);p1=__builtin_amdgcn_mfma_f32_32x32x16_bf16(b1,qr[0],negm,0,0,0);}
    else{p0=__builtin_amdgcn_mfma_f32_32x32x16_bf16(b0,qr[d0],p0,0,0,0);p1=__builtin_amdgcn_mfma_f32_32x32x16_bf16(b1,qr[d0],p1,0,0,0);}}
}
typedef __attribute__((address_space(3))) const char* lds_cptr;
typedef short v4i16_t __attribute__((ext_vector_type(4)));
__device__ __forceinline__ void kload8(bf16x8*kf,lds_cptr kp){
  kf[0]=*(const __attribute__((address_space(3))) bf16x8*)(kp);      kf[1]=*(const __attribute__((address_space(3))) bf16x8*)(kp+512);
  kf[2]=*(const __attribute__((address_space(3))) bf16x8*)(kp+2048); kf[3]=*(const __attribute__((address_space(3))) bf16x8*)(kp+2560);
  kf[4]=*(const __attribute__((address_space(3))) bf16x8*)(kp+4096); kf[5]=*(const __attribute__((address_space(3))) bf16x8*)(kp+4608);
  kf[6]=*(const __attribute__((address_space(3))) bf16x8*)(kp+6144); kf[7]=*(const __attribute__((address_space(3))) bf16x8*)(kp+6656);
}
__device__ __forceinline__ void kload2(bf16x8*kf,lds_cptr kp,int j){ kf[2*j]=*(const __attribute__((address_space(3))) bf16x8*)(kp+j*2048); kf[2*j+1]=*(const __attribute__((address_space(3))) bf16x8*)(kp+j*2048+512); }
__device__ __forceinline__ s16x4 vtr(lds_cptr p){ return __builtin_bit_cast(s16x4,__builtin_amdgcn_ds_read_tr16_b64_v4i16((__attribute__((address_space(3))) v4i16_t*)p)); }
__device__ __forceinline__ float rowmax(const f32x16&p0,const f32x16&p1){
  float a=max3f(p0[0],p0[1],p1[0]),b=max3f(p0[2],p0[3],p1[1]);a=max3f(a,p1[2],p1[3]);
  #pragma unroll
  for(int r=4;r<16;r+=4){a=max3f(a,p0[r],p0[r+1]);b=max3f(b,p0[r+2],p0[r+3]);a=max3f(a,p1[r],p1[r+1]);b=max3f(b,p1[r+2],p1[r+3]);}
  const float m=max2f(a,b);
  auto rr=__builtin_amdgcn_permlane32_swap(__float_as_uint(m),__float_as_uint(m),false,false);
  return max2f(__uint_as_float(rr[0]),__uint_as_float(rr[1]));
}
__device__ __forceinline__ void pv(f32x16*o,int vb,bf16x8 pa0,bf16x8 pa1,bf16x8 pa2,bf16x8 pa3){
  #pragma unroll
  for(int d0=0;d0<2;++d0){s16x4 lo[4],hi[4];
    #pragma unroll
    for(int ks=0;ks<4;++ks){
      asm volatile("ds_read_b64_tr_b16 %0,%1 offset:%c2":"=&v"(lo[ks]):"v"(vb),"i"(d0*4096+ks*1024):"memory");
      asm volatile("ds_read_b64_tr_b16 %0,%1 offset:%c2":"=&v"(hi[ks]):"v"(vb),"i"(d0*4096+ks*1024+512):"memory");}
    asm volatile("s_waitcnt lgkmcnt(0)":::"memory");SBAR();
    #define PK(k) (bf16x8){lo[k][0],lo[k][1],lo[k][2],lo[k][3],hi[k][0],hi[k][1],hi[k][2],hi[k][3]}
    o[d0]=__builtin_amdgcn_mfma_f32_32x32x16_bf16(pa0,PK(0),o[d0],0,0,0);
    o[d0]=__builtin_amdgcn_mfma_f32_32x32x16_bf16(pa1,PK(1),o[d0],0,0,0);
    o[d0]=__builtin_amdgcn_mfma_f32_32x32x16_bf16(pa2,PK(2),o[d0],0,0,0);
    o[d0]=__builtin_amdgcn_mfma_f32_32x32x16_bf16(pa3,PK(3),o[d0],0,0,0);
    #undef PK
  }
}

#ifndef ATTN_STORE16
#define ATTN_STORE16(p,v) (*(u32x4*)(p)=(v))
#endif
template<int THRL> __device__ __forceinline__ void attn_unit(int b,int h,int qb,const bf16*Q,const bf16*__restrict__ K,const bf16*__restrict__ V,bf16*O,const unsigned long long*MASKT,char*shm,const int wave_id){
  const int wid=wave_id,lane=pg8::lane_id_now(),tid=wid*64+lane,r32=lane&31,hi=lane>>5;
  const long rowbase=(long)b*SEQ; const int q0=qb*QB; const int NT=(q0+QB)/KVBLK;
  const bf16*Qw=Q+(rowbase+q0+wid*QBLK)*KP+h*D;
  const bf16*Kh=K+((long)(b*NHEAD+h)*(SEQ/KVBLK))*4096,*Vh=V+((long)(b*NHEAD+h)*(SEQ/KVBLK))*4096;
  const unsigned lds0=(unsigned)(uintptr_t)shm;
  float*wsf=(float*)(shm+LDS_WS)+wid*64;
  const bf16*ksrc=Kh+wid*512,*vsrc=Vh+wid*512; const unsigned dmaoff=(unsigned)lane*16u;
  const unsigned kdst=lds0+LDS_K+wid*1024, vdst=lds0+LDS_V+wid*1024;
  #define DMA_K(t,slot) glds16(ksrc+(long)(t)*4096,dmaoff,(unsigned)__builtin_amdgcn_readfirstlane(kdst+(slot)))
  #define DMA_V(t,slot) glds16(vsrc+(long)(t)*4096,dmaoff,(unsigned)__builtin_amdgcn_readfirstlane(vdst+(slot)))
  const char*Kbase=shm+LDS_K; bf16x8 kf[8];
  const lds_cptr shm3=(lds_cptr)shm; const lds_cptr kp0=shm3+LDS_K+hi*1024+r32*16; const lds_cptr vp0=shm3+LDS_V+((lane>>4)&1)*32+(lane&3)*8+(4*hi+((lane&15)>>2))*64;
  { const char*msrc=(const char*)(MASKT+((long)b*32)*SEQ+q0);
    #pragma unroll
    for(int i=0;i<8;++i){ const int j_=wid+8*i; if(j_<2*NT)glds16(msrc+(long)(j_>>1)*(SEQ*8)+(j_&1)*1024,dmaoff,(unsigned)__builtin_amdgcn_readfirstlane(lds0+LDS_MASK+j_*1024)); } }
  DMA_K(0,0);DMA_V(0,0);DMA_K(1,SLOTB);
  bf16x8 qr[4];
  #pragma unroll
  for(int d0=0;d0<4;++d0)qr[d0]=*reinterpret_cast<const bf16x8*>(&Qw[(long)r32*KP+d0*16+hi*8]);
  #define BP(r) (((r)&3)+8*((r)>>2))
  #define EXM(x,w,r) __uint_as_float(__float_as_uint(__builtin_amdgcn_exp2f(x))&(unsigned)__builtin_amdgcn_sbfe((int)(w),BP(r),1))
  #define MASKLD(tt,m0,m1) int ro_=r32; asm volatile("":"+v"(ro_)); const unsigned long long mw_=*(const __attribute__((address_space(3))) unsigned long long*)((lds_cptr)shm+LDS_MASK+wid*(QBLK*8)+ro_*8+(tt)*2048); const unsigned m0=((unsigned)mw_)>>(4*hi),m1=((unsigned)(mw_>>32))>>(4*hi)
  float mhat=0.f,l_reg=0.f;f32x16 o[2];o[0]=f32x16{};o[1]=f32x16{};f32x16 negm=f32x16{};asm volatile("":"+v"(negm));
  const int qrel=wid*QBLK+r32;
  #define CMASK(P0,P1,t) do{}while(0)
  bool resc=false;
  #define START(P0,P1) do{ const float rm=rowmax(P0,P1); resc=false; \
    { const float dl=rm; mhat=fadd_s(mhat,dl); \
      _Pragma("unroll") for(int r=0;r<16;++r){P0[r]=fsub_s(P0[r],dl);P1[r]=fsub_s(P1[r],dl);} \
      _Pragma("unroll") for(int r=0;r<16;++r)negm[r]=-mhat; asm volatile("":"+v"(negm)); } \
    _Pragma("unroll") for(int r=0;r<16;++r)P0[r]=EXM(P0[r],mS0,r); }while(0)
  #define RESC() do{ if(resc){ asm volatile("s_waitcnt lgkmcnt(0)":::"memory"); \
      _Pragma("unroll") for(int d_=0;d_<2;++d_) _Pragma("unroll") for(int r=0;r<16;++r)o[d_][r]*=wsf[crow(r,hi)]; } }while(0)
  f32x16 pA0,pA1,pB0,pB1;
  int sl_prev=0,sl_cur=0,sl_next=SLOTB;
  #define ROT() do{sl_prev=sl_cur;sl_cur=sl_next;sl_next=(sl_next==(NSLOT-1)*SLOTB)?0:sl_next+SLOTB;}while(0)
  DMA_K(2,2*SLOTB);
  WAIT_BAR(3);
  qkt(pA0,pA1,Kbase,qr,negm,r32,hi);asm volatile("s_nop 15\n\ts_nop 7":"+v"(pA0),"+v"(pA1));CMASK(pA0,pA1,0);
  { MASKLD(0,mS0,mS1);
  START(pA0,pA1);
  _Pragma("unroll") for(int r=0;r<16;++r)pA1[r]=EXM(pA1[r],mS1,r); }
  WAIT_BAR(0);
  DMA_K(3,0);DMA_V(1,SLOTB);
  ROT();
  kload8(kf,kp0+sl_cur);
  WAIT_BAR(2);
  s16x4 vlo[8],vhi[8]; u32x4 pw0,pw1,pw2,pw3;
  #define PKW(P,B) cvtpk_s(P[B],P[B+1])
  #define PAF(k) __builtin_bit_cast(bf16x8,pw##k)
  #define VFR(i) (bf16x8){vlo[i][0],vlo[i][1],vlo[i][2],vlo[i][3],vhi[i][0],vhi[i][1],vhi[i][2],vhi[i][3]}
  #define PIN(x) asm volatile("":"+v"(x))
  #define MX3(a,b,c) __builtin_fmaxf(__builtin_fmaxf((a),(b)),(c))
  #define GAPA(MF,A0,A1,A2,A3,W0,W1,PW) do{ MF; sacc+=A0; sacc+=A1; sacc+=A2; sacc+=A3; PIN(sacc); W0; W1; PIN(PW); SBAR(); }while(0)
  #define EX(v) __builtin_amdgcn_exp2f(v)
  #define GAPB(MF,X,B,W) do{ MF; X[B]=EXM(X[B],W,B); X[B+1]=EXM(X[B+1],W,B+1); X[B+2]=EXM(X[B+2],W,B+2); X[B+3]=EXM(X[B+3],W,B+3); PIN(X); SBAR(); }while(0)
  #define VRD(i) do{ vlo[i]=vtr(vp_+(((i)>>2)*4096+((i)&3)*1024)); vhi[i]=vtr(vp_+(((i)>>2)*4096+((i)&3)*1024+512)); }while(0)
  #define KRD(G,j) do{ if(G){ kload2(kf,kp0+sl_next,j); SBAR(); } }while(0)
  #define STEP(C0,C1,P0,P1,t,GK,GV,GL) do{ SBAR(); \
    const lds_cptr vp_=vp0+sl_prev; \
    VRD(0); SBAR(); float sacc=(P0[0]+P0[1]); \
    GAPA(C0=__builtin_amdgcn_mfma_f32_32x32x16_bf16(kf[0],qr[0],negm,0,0,0), P0[2],P0[3],P0[4],P0[5],     pw0[0]=PKW(P0,0), pw0[1]=PKW(P0,2), pw0); \
    VRD(4); SBAR(); GAPA(C1=__builtin_amdgcn_mfma_f32_32x32x16_bf16(kf[1],qr[0],negm,0,0,0), P0[6],P0[7],P0[8],P0[9],     pw0[2]=PKW(P0,4), pw0[3]=PKW(P0,6), pw0); \
    VRD(1); SBAR(); GAPA(C0=__builtin_amdgcn_mfma_f32_32x32x16_bf16(kf[2],qr[1],C0,0,0,0),   P0[10],P0[11],P0[12],P0[13], pw1[0]=PKW(P0,8), pw1[1]=PKW(P0,10), pw1); \
    VRD(5); SBAR(); GAPA(C1=__builtin_amdgcn_mfma_f32_32x32x16_bf16(kf[3],qr[1],C1,0,0,0),   P0[14],P0[15],P1[0],P1[1],   pw1[2]=PKW(P0,12),pw1[3]=PKW(P0,14), pw1); \
    VRD(2); SBAR(); GAPA(C0=__builtin_amdgcn_mfma_f32_32x32x16_bf16(kf[4],qr[2],C0,0,0,0),   P1[2],P1[3],P1[4],P1[5],     pw2[0]=PKW(P1,0), pw2[1]=PKW(P1,2), pw2); \
    VRD(6); SBAR(); GAPA(C1=__builtin_amdgcn_mfma_f32_32x32x16_bf16(kf[5],qr[2],C1,0,0,0),   P1[6],P1[7],P1[8],P1[9],     pw2[2]=PKW(P1,4), pw2[3]=PKW(P1,6), pw2); \
    VRD(3); SBAR(); GAPA(C0=__builtin_amdgcn_mfma_f32_32x32x16_bf16(kf[6],qr[3],C0,0,0,0),   P1[10],P1[11],P1[12],P1[13], pw3[0]=PKW(P1,8), pw3[1]=PKW(P1,10), pw3); \
    VRD(7); SBAR(); GAPA(C1=__builtin_amdgcn_mfma_f32_32x32x16_bf16(kf[7],qr[3],C1,0,0,0),   P1[14],P1[15],0.f,0.f,       pw3[2]=PKW(P1,12),pw3[3]=PKW(P1,14), pw3); \
    l_reg+=sacc; \
    if(GK){DMA_K((t)+3,sl_cur);} if(GV){DMA_V((t)+1,sl_next);} \
    MASKLD(t,mA_,mB_); \
    { float a=MX3(C0[0],C0[1],C1[0]),b=MX3(C0[2],C0[3],C1[1]); a=MX3(a,C1[2],C1[3]); \
      _Pragma("unroll") for(int r=4;r<16;r+=4){a=MX3(a,C0[r],C0[r+1]);b=MX3(b,C0[r+2],C0[r+3]);a=MX3(a,C1[r],C1[r+1]);b=MX3(b,C1[r+2],C1[r+3]);} \
      float rm=__builtin_fmaxf(a,b); { auto rr=__builtin_amdgcn_permlane32_swap(__float_as_uint(rm),__float_as_uint(rm),false,false); rm=__builtin_fmaxf(__uint_as_float(rr[0]),__uint_as_float(rr[1])); } \
      resc=false; \
      if(__builtin_expect(__any(rm>(float)THRL),0)){ const float dl=__builtin_fmaxf(rm,0.f); mhat+=dl; \
        _Pragma("unroll") for(int r=0;r<16;++r){C0[r]-=dl;C1[r]-=dl;} \
        _Pragma("unroll") for(int r=0;r<16;++r)negm[r]=-mhat; asm volatile("":"+v"(negm)); \
        const float f=__builtin_amdgcn_exp2f(-dl); l_reg*=f; { int rq_=r32; asm volatile("":"+v"(rq_)); if(hi==0)wsf[rq_]=f; } resc=true; } } \
    SBAR(); \
    GAPB(o[0]=__builtin_amdgcn_mfma_f32_32x32x16_bf16(PAF(0),VFR(0),o[0],0,0,0), C0,0,mA_); \
    GAPB(o[1]=__builtin_amdgcn_mfma_f32_32x32x16_bf16(PAF(0),VFR(4),o[1],0,0,0), C0,4,mA_); \
    KRD(GL,0); GAPB(o[0]=__builtin_amdgcn_mfma_f32_32x32x16_bf16(PAF(1),VFR(1),o[0],0,0,0), C0,8,mA_); \
    KRD(GL,1); GAPB(o[1]=__builtin_amdgcn_mfma_f32_32x32x16_bf16(PAF(1),VFR(5),o[1],0,0,0), C0,12,mA_); \
    KRD(GL,2); GAPB(o[0]=__builtin_amdgcn_mfma_f32_32x32x16_bf16(PAF(2),VFR(2),o[0],0,0,0), C1,0,mB_); \
    KRD(GL,3); GAPB(o[1]=__builtin_amdgcn_mfma_f32_32x32x16_bf16(PAF(2),VFR(6),o[1],0,0,0), C1,4,mB_); \
    GAPB(o[0]=__builtin_amdgcn_mfma_f32_32x32x16_bf16(PAF(3),VFR(3),o[0],0,0,0), C1,8,mB_); \
    GAPB(o[1]=__builtin_amdgcn_mfma_f32_32x32x16_bf16(PAF(3),VFR(7),o[1],0,0,0), C1,12,mB_); \
    }while(0)
  int t=1;
  #undef CMASK
  #define CMASK(P0,P1,t) do{}while(0)
  for(;t+5<NT;t+=2){
    STEP(pB0,pB1,pA0,pA1,t,true,true,true);     WAIT_BAR(2); RESC(); ROT();
    STEP(pA0,pA1,pB0,pB1,t+1,true,true,true);   WAIT_BAR(2); RESC(); ROT();
  }
  #undef CMASK
  #define CMASK(P0,P1,t) do{}while(0)
  #define ENDW(tt) do{ if((tt)+3<NT){WAIT_BAR(2);} else if((tt)+2<NT){WAIT_BAR(1);} else {WAIT_BAR(0);} }while(0)
  for(;t+1<NT;t+=2){
    STEP(pB0,pB1,pA0,pA1,t,(t+3<NT),(t+1<NT),(t+1<NT));       ENDW(t);   RESC(); ROT();
    STEP(pA0,pA1,pB0,pB1,t+1,(t+4<NT),(t+2<NT),(t+2<NT));     ENDW(t+1); RESC(); ROT();
  }
  STEP(pB0,pB1,pA0,pA1,NT-1,false,false,false); RESC();
  { float sacc=pB0[0]+pB0[1]; _Pragma("unroll") for(int r=2;r<16;++r)sacc+=pB0[r]; _Pragma("unroll") for(int r=0;r<16;++r)sacc+=pB1[r]; l_reg+=sacc;
    pw0=(u32x4){PKW(pB0,0),PKW(pB0,2),PKW(pB0,4),PKW(pB0,6)};pw1=(u32x4){PKW(pB0,8),PKW(pB0,10),PKW(pB0,12),PKW(pB0,14)};pw2=(u32x4){PKW(pB1,0),PKW(pB1,2),PKW(pB1,4),PKW(pB1,6)};pw3=(u32x4){PKW(pB1,8),PKW(pB1,10),PKW(pB1,12),PKW(pB1,14)};
    SBAR(); { int lq_=lane; asm volatile("":"+v"(lq_)); const int vb0=(int)(lds0+LDS_V)+((lq_>>4)&1)*32+(lq_&3)*8+(4*(lq_>>5)+((lq_&15)>>2))*64; pv(o,vb0+sl_cur,PAF(0),PAF(1),PAF(2),PAF(3)); } }
  #undef PKW
  #undef PAF
  #undef VFR
  #undef PIN
  #undef MX3
  #undef GAPA
  #undef GAPB
  #undef EX
  #undef VRD
  #undef KRD
  #undef STEP
  #undef ENDW
  {auto rr=__builtin_amdgcn_permlane32_swap(__float_as_uint(l_reg),__float_as_uint(l_reg),false,false);l_reg=__uint_as_float(rr[0])+__uint_as_float(rr[1]);}
  if(hi==0)wsf[32+r32]=l_reg;asm volatile("s_waitcnt lgkmcnt(0)":::"memory");
  float rli[16];
  #pragma unroll
  for(int r=0;r<16;++r)rli[r]=__builtin_amdgcn_rcpf(wsf[32+crow(r,hi)]);
  bf16*Ow=O+(rowbase+q0+wid*QBLK)*OP+h*D;
  { bf16*stg=(bf16*)(shm+LDS_OST)+wid*2048;
    #pragma unroll
    for(int r=0;r<16;++r){const int orow=crow(r,hi);
      #pragma unroll
      for(int d0=0;d0<2;++d0)stg[orow*64+d0*32+r32]=__float2bfloat16(o[d0][r]*rli[r]);}
    asm volatile("s_waitcnt lgkmcnt(0)":::"memory");
    #pragma unroll
    for(int i=0;i<4;++i){const int row=i*8+(lane>>3),ch=lane&7; const u32x4 v=*(const u32x4*)(stg+row*64+ch*8); ATTN_STORE16(Ow+(long)row*OP+ch*8,v);} }
  asm volatile("s_waitcnt lgkmcnt(0)\n\ts_barrier":::"memory");
  #undef DMA_K
  #undef DMA_V
  #undef CMASK
  #undef START
  #undef RESC
  #undef ROT
  #undef BP
  #undef EXM
  #undef MASKLD
}
constexpr int ATTN_LDS_BYTES=LDS_BYTES;
struct AttnTensors { const bf16* Q; const bf16* K; const bf16* V; bf16* O; const unsigned long long* MASKT; };
struct AttnUnit { int bh; int qb; };
struct StaticOrder {
  int vcu;
  __device__ __forceinline__ explicit StaticOrder(int grid,int block):vcu((block%8)*(grid/8)+block/8){}
  __device__ __forceinline__ bool next(int i,AttnUnit&u)const{ if(i>=2)return false; const int s=vcu&3; u.bh=vcu>>2; u.qb=(i==0)?7-s:s; return true; }
  __device__ __forceinline__ void a_ready(const AttnUnit&)const{}
  __device__ __forceinline__ void done(const AttnUnit&)const{}
};
template<class Sched,int THRL=8> __device__ __forceinline__ void attn_phase(char*lds,const AttnTensors&T,const Sched&S,const int wave_id){
  AttnUnit u;
  for(int i=0;S.next(i,u);++i){ S.a_ready(u); attn_unit<THRL>(u.bh/NHEAD,u.bh%NHEAD,u.qb,T.Q,T.K,T.V,T.O,T.MASKT,lds,wave_id); S.done(u); }
}
#undef SBAR
#undef WAIT_BAR
}


__global__ void __launch_bounds__(NWAVES * 64, 2) mk_fwd(Args args) {
    extern __shared__ __attribute__((aligned(16))) unsigned char lds[];
    Frame F;
    F.lds = (LAS unsigned char*)lds;
    F.MISC = (volatile LAS unsigned*)(F.lds + MISC_OFF);
    F.wave = __builtin_amdgcn_readfirstlane((int)threadIdx.x >> 6); F.lane = (int)__builtin_amdgcn_mbcnt_hi(~0u, __builtin_amdgcn_mbcnt_lo(~0u, 0u)); F.tid = F.wave * 64 + F.lane;
    F.G = gridDim.x; { const int bx = blockIdx.x; F.vcu = (F.G % 8 == 0) ? (bx % 8) * (F.G / 8) + bx / 8 : bx; }
    unsigned char* ws = args.ws;
    F.ctl = (gu32*)(ws + WS_CTL);
    for (int u = F.tid; u < (LDS_BYTES - LDSCTL_OFF) / 4; u += NWAVES * 64) ((LAS unsigned*)(F.lds + LDSCTL_OFF))[u] = 0u;
    __syncthreads();
    XcdBarrier bar = xcd_barrier_post((unsigned*)(F.ctl + CW_BAR) + args.li * XCD_BAR_WORDS, F.MISC + 8, F.wave);
    const int lo = args.ph_lo, hi = args.ph_hi;
#define IN(k) (lo <= (k) && (k) < hi)
#define BOTH(k) (IN(k) && IN((k) + 1))
#ifdef TS_SEL
    const unsigned long long ts0_ = rt();
#define GRID_BAR() do { xcd_barrier(bar); if (blockIdx.x == 0 && F.tid == 0) F.MISC[16 + (ts_n_++)] = (unsigned)(rt() - ts0_); } while (0)
    int ts_n_ = 0;
#else
#define GRID_BAR() xcd_barrier(bar)
#endif
    bf16* XB = (bf16*)(ws + WS_XB); bf16* MIX = (bf16*)(ws + WS_MIX); bf16* H = (bf16*)(ws + WS_H);
    float* sspA = (float*)(ws + WS_SSPA); float* sspB = (float*)(ws + WS_SSPB);
    float* cosH = (float*)(ws + WS_TAB); float* sinH = cosH + SEQ * 32; float* cosI = sinH + SEQ * 32; float* sinI = cosI + SEQ * 16;
    const float* x = args.in[0]; float* out = args.out;

    if (IN(0)) { p0_prologue(F, args);
#if PROBE_REP & 1
        GRID_BAR(); p0_prologue(F, args);
#endif
        if (BOTH(0)) GRID_BAR();
#ifdef PROBE_BARS
        for (int i_ = 0; i_ < PROBE_BARS; ++i_) GRID_BAR();
#endif
        }
    if (IN(1)) {
        {
        pg8::Gemm g{XB, (bf16*)(ws + WS_WGU1), M, NGU, D}; pg8::StaticOrder S; S.init(M, NGU, F.G, (int)blockIdx.x);
        pg8::EpiSwiGLU E{H, sspA, F.lds + RING_OFF + pg8::STAGE_BYTES};
        pg8::gemm_phase<pg8::EpiSwiGLU, pg8::StaticOrder, PG8_ALIGN, PG8_SP2>(F.lds + RING_OFF, g, S, E, F.wave);
#ifdef TS_SEL
        if (F.tid == 0 && blockIdx.x == 0) F.MISC[40] = (unsigned)(rt() - ts0_);
        if (F.tid == 0 && blockIdx.x == 200) ((gu32*)(ws + WS_CTL))[8192 + 0] = (unsigned)(rt() - ts0_);
#endif
        if (F.G == 256 && blockIdx.x >= 128) { weight_items(F, args, 1, ((int)blockIdx.x - 128) * NWAVES + F.wave, 128 * NWAVES); wpo_items(F, args, ((int)blockIdx.x - 128) * NWAVES + F.wave, 128 * NWAVES, 0, 1024); }
#ifdef TS_SEL
        asm volatile("s_waitcnt vmcnt(0)" ::: "memory");
        if (F.tid == 0 && blockIdx.x == 200) ((gu32*)(ws + WS_CTL))[8192 + 64] = (unsigned)(rt() - ts0_);
#endif
        }
#if PROBE_REP & (1 << 1)
        GRID_BAR();
        {
        pg8::Gemm g{XB, (bf16*)(ws + WS_WGU1), M, NGU, D}; pg8::StaticOrder S; S.init(M, NGU, F.G, (int)blockIdx.x);
        pg8::EpiSwiGLU E{H, sspA, F.lds + RING_OFF + pg8::STAGE_BYTES};
        pg8::gemm_phase<pg8::EpiSwiGLU, pg8::StaticOrder, PG8_ALIGN, PG8_SP2>(F.lds + RING_OFF, g, S, E, F.wave);
        }
#endif
        if (BOTH(1)) GRID_BAR();
    }
    if (IN(2)) {
        {
        pg8::Gemm g{H, (bf16*)(ws + WS_WD1), M, D, DFF}; pg8::StaticOrder S; S.init(M, D, F.G, (int)blockIdx.x);
        pg8::EpiResid<true, false, true> E{nullptr, nullptr, XB, sspA, 0.5f};
        pg8::gemm_phase<pg8::EpiResid<true, false, true>, pg8::StaticOrder, PG8_ALIGN, PG8_SP2>(F.lds + RING_OFF, g, S, E, F.wave);
#ifdef TS_SEL
        if (F.tid == 0) { const unsigned t_ = (unsigned)(rt() - ts0_); __hip_atomic_fetch_max((gu32*)(ws + WS_CTL) + 9216 + 128 * 1, 0x40000000u - t_, RLX_AGENT); __hip_atomic_fetch_max((gu32*)(ws + WS_CTL) + 9216 + 128 * 1 + 64, t_, RLX_AGENT); }
#endif

        }
#if PROBE_REP & (1 << 2)
        GRID_BAR();
        {
        pg8::Gemm g{H, (bf16*)(ws + WS_WD1), M, D, DFF}; pg8::StaticOrder S; S.init(M, D, F.G, (int)blockIdx.x);
        pg8::EpiResid<true, false, true> E{nullptr, nullptr, XB, sspA, 0.5f};
        pg8::gemm_phase<pg8::EpiResid<true, false, true>, pg8::StaticOrder, PG8_ALIGN, PG8_SP2>(F.lds + RING_OFF, g, S, E, F.wave);
        }
#endif
        if (BOTH(2)) GRID_BAR();
    }
    if (IN(3)) {
        {
        pg8::Gemm g{XB, (bf16*)(ws + WS_WIN), M, NIN, D}; pg8::StaticOrder S; S.init(M, NIN, F.G, (int)blockIdx.x);
        static_assert(pg8::EpiInProj::O_SSP == WS_SSPA && pg8::EpiInProj::O_TAB == WS_TAB && pg8::EpiInProj::O_WI == WS_WI && pg8::EpiInProj::O_Q == WS_Q && pg8::EpiInProj::O_K == WS_K && pg8::EpiInProj::O_V == WS_V &&
                      pg8::EpiInProj::O_U == WS_U && pg8::EpiInProj::O_QI == WS_QI && pg8::EpiInProj::O_KI == WS_KI && SEQ == 2048, "EpiInProj offsets");
        pg8::EpiInProj E{ws, args.in[7], args.in[8], C2, F.lds + RING_OFF + pg8::STAGE_BYTES};
        pg8::gemm_phase<pg8::EpiInProj, pg8::StaticOrder, PG8_ALIGN, PG8_SP2>(F.lds + RING_OFF, g, S, E, F.wave);
#ifdef TS_SEL
        if (F.tid == 0 && blockIdx.x == 0) F.MISC[41] = (unsigned)(rt() - ts0_);
        if (F.tid == 0 && blockIdx.x == 200) ((gu32*)(ws + WS_CTL))[8192 + 128] = (unsigned)(rt() - ts0_);
#endif
        if (F.G == 256 && blockIdx.x >= 128) { weight_items(F, args, 2, ((int)blockIdx.x - 128) * NWAVES + F.wave, 128 * NWAVES); wpo_items(F, args, ((int)blockIdx.x - 128) * NWAVES + F.wave, 128 * NWAVES, 1024, 2048); }
#ifdef TS_SEL
        asm volatile("s_waitcnt vmcnt(0)" ::: "memory");
        if (F.tid == 0 && blockIdx.x == 200) ((gu32*)(ws + WS_CTL))[8192 + 192] = (unsigned)(rt() - ts0_);
#endif
        }
#if PROBE_REP & (1 << 3)
        GRID_BAR();
        {
        pg8::Gemm g{XB, (bf16*)(ws + WS_WIN), M, NIN, D}; pg8::StaticOrder S; S.init(M, NIN, F.G, (int)blockIdx.x);
        static_assert(pg8::EpiInProj::O_SSP == WS_SSPA && pg8::EpiInProj::O_TAB == WS_TAB && pg8::EpiInProj::O_WI == WS_WI && pg8::EpiInProj::O_Q == WS_Q && pg8::EpiInProj::O_K == WS_K && pg8::EpiInProj::O_V == WS_V &&
                      pg8::EpiInProj::O_U == WS_U && pg8::EpiInProj::O_QI == WS_QI && pg8::EpiInProj::O_KI == WS_KI && SEQ == 2048, "EpiInProj offsets");
        pg8::EpiInProj E{ws, args.in[7], args.in[8], C2, F.lds + RING_OFF + pg8::STAGE_BYTES};
        pg8::gemm_phase<pg8::EpiInProj, pg8::StaticOrder, PG8_ALIGN, PG8_SP2>(F.lds + RING_OFF, g, S, E, F.wave);
        }
#endif
        if (BOTH(3)) GRID_BAR();
    }
    if (IN(4)) {
        {
        select_phase(F, (const bf16*)(ws + WS_QI), (const bf16*)(ws + WS_KI), (const float*)(ws + WS_WI), (unsigned long long*)(ws + WS_MASK), (const bf16*)(ws + WS_U), MIX);
        }
#if PROBE_REP & (1 << 4)
        GRID_BAR();
        {
        select_phase(F, (const bf16*)(ws + WS_QI), (const bf16*)(ws + WS_KI), (const float*)(ws + WS_WI), (unsigned long long*)(ws + WS_MASK), (const bf16*)(ws + WS_U), MIX);
        }
#endif
        if (BOTH(4)) GRID_BAR();
    }
    if (IN(5)) {
        {
        static_assert(attn_body::LDS_TOTAL <= LDSCTL_OFF, "attention LDS");
        const attn_body::AttnTensors AT{(const attn_body::bf16*)(ws + WS_Q), (const attn_body::bf16*)(ws + WS_K), (const attn_body::bf16*)(ws + WS_V), (attn_body::bf16*)MIX, (const unsigned long long*)(ws + WS_MASK)};
        const attn_body::StaticOrder S((int)F.G, (int)blockIdx.x);
        attn_body::attn_phase<attn_body::StaticOrder>((char*)lds + RING_OFF, AT, S, F.wave);
        }
#if PROBE_REP & (1 << 5)
        GRID_BAR();
        {
        static_assert(attn_body::LDS_TOTAL <= LDSCTL_OFF, "attention LDS");
        const attn_body::AttnTensors AT{(const attn_body::bf16*)(ws + WS_Q), (const attn_body::bf16*)(ws + WS_K), (const attn_body::bf16*)(ws + WS_V), (attn_body::bf16*)MIX, (const unsigned long long*)(ws + WS_MASK)};
        const attn_body::StaticOrder S((int)F.G, (int)blockIdx.x);
        attn_body::attn_phase<attn_body::StaticOrder>((char*)lds + RING_OFF, AT, S, F.wave);
        }
#endif
        if (BOTH(5)) GRID_BAR();
    }
    if (IN(6)) {
        pg8::Gemm g{MIX, (bf16*)(ws + WS_WOUT), M, D, D}; pg8::StaticOrder S; S.init(M, D, F.G, (int)blockIdx.x);
        pg8::EpiResid<true, false, true> E{nullptr, nullptr, XB, sspB, 1.0f};
        pg8::gemm_phase<pg8::EpiResid<true, false, true>, pg8::StaticOrder, PG8_ALIGN, PG8_SP2>(F.lds + RING_OFF, g, S, E, F.wave);
#if PROBE_REP & (1 << 6)
        GRID_BAR();
        { pg8::EpiResid<true, false, true> E2{nullptr, nullptr, (bf16*)(ws + 208 * MiB), (float*)(ws + 244 * MiB), 1.0f};
          pg8::gemm_phase<pg8::EpiResid<true, false, true>, pg8::StaticOrder, PG8_ALIGN, PG8_SP2>(F.lds + RING_OFF, g, S, E2, F.wave); }
#endif
        if (BOTH(6)) GRID_BAR();
    }
    if (IN(7)) {
        {
        pg8::Gemm g{XB, (bf16*)(ws + WS_WGU2), M, NGU, D}; pg8::StaticOrder S; S.init(M, NGU, F.G, (int)blockIdx.x);
        pg8::EpiSwiGLU E{H, sspB, F.lds + RING_OFF + pg8::STAGE_BYTES};
        pg8::gemm_phase<pg8::EpiSwiGLU, pg8::StaticOrder, PG8_ALIGN, PG8_SP2>(F.lds + RING_OFF, g, S, E, F.wave);
        if (F.G == 256 && blockIdx.x >= 128) weight_items(F, args, 3, ((int)blockIdx.x - 128) * NWAVES + F.wave, 128 * NWAVES);
        }
#if PROBE_REP & (1 << 7)
        GRID_BAR();
        {
        pg8::Gemm g{XB, (bf16*)(ws + WS_WGU2), M, NGU, D}; pg8::StaticOrder S; S.init(M, NGU, F.G, (int)blockIdx.x);
        pg8::EpiSwiGLU E{H, sspB, F.lds + RING_OFF + pg8::STAGE_BYTES};
        pg8::gemm_phase<pg8::EpiSwiGLU, pg8::StaticOrder, PG8_ALIGN, PG8_SP2>(F.lds + RING_OFF, g, S, E, F.wave);
        }
#endif
        if (BOTH(7)) GRID_BAR();
    }
    if (IN(8)) {
        {
        pg8::Gemm g{H, (bf16*)(ws + WS_WD2), M, D, DFF}; pg8::StaticOrder S; S.init(M, D, F.G, (int)blockIdx.x);
        pg8::EpiResid<true, true, false> E{nullptr, out, XB, nullptr, 0.5f};
        pg8::gemm_phase<pg8::EpiResid<true, true, false>, pg8::StaticOrder, PG8_ALIGN, PG8_SP2>(F.lds + RING_OFF, g, S, E, F.wave);
        }
#if PROBE_REP & (1 << 8)
        GRID_BAR();
        {
        pg8::Gemm g{H, (bf16*)(ws + WS_WD2), M, D, DFF}; pg8::StaticOrder S; S.init(M, D, F.G, (int)blockIdx.x);
        pg8::EpiResid<true, true, false> E{nullptr, out, XB, nullptr, 0.5f};
        pg8::gemm_phase<pg8::EpiResid<true, true, false>, pg8::StaticOrder, PG8_ALIGN, PG8_SP2>(F.lds + RING_OFF, g, S, E, F.wave);
        }
#endif
    }
#ifdef TS_SEL
    if (blockIdx.x == 0 && F.tid == 0) {
        const unsigned now = (unsigned)(rt() - ts0_);
        const unsigned v = (TS_SEL == 41) ? (__hip_atomic_load((gu32*)(ws + WS_CTL) + 9216 + 128 + 64, RLX_AGENT) - (0x40000000u - __hip_atomic_load((gu32*)(ws + WS_CTL) + 9216 + 128, RLX_AGENT))) : (TS_SEL == 30) ? F.MISC[41] : (TS_SEL == 31) ? __hip_atomic_load((gu32*)(ws + WS_CTL) + 8192 + 128, RLX_AGENT) : (TS_SEL == 32) ? __hip_atomic_load((gu32*)(ws + WS_CTL) + 8192 + 192, RLX_AGENT) : (TS_SEL == 20) ? F.MISC[40] : (TS_SEL == 21) ? __hip_atomic_load((gu32*)(ws + WS_CTL) + 8192, RLX_AGENT) : (TS_SEL == 22) ? __hip_atomic_load((gu32*)(ws + WS_CTL) + 8192 + 64, RLX_AGENT) : (TS_SEL >= 8) ? now : F.MISC[16 + TS_SEL];
        asm volatile("s_waitcnt vmcnt(0)" ::: "memory");
        out[0] += (float)v * 0.01f * TS_SCALE;
    }
#endif
#undef IN
#undef BOTH
}

extern "C" void kernel_launch(void* const* d_in, const int* in_sizes, int n_in, void* d_out, int out_size, void* d_ws, size_t ws_size, hipStream_t stream) {
    static int grid = 0;
    if (grid == 0) {
        if (n_in != 16 || out_size != M * D || ws_size < WS_END) { fprintf(stderr, "kernel_launch: unexpected shapes (n_in %d out %d ws %zu)\n", n_in, out_size, ws_size); grid = -1; return; }
        int dev = 0, cus = 0, per_cu = 0;
        if (hipGetDevice(&dev) != hipSuccess || hipDeviceGetAttribute(&cus, hipDeviceAttributeMultiprocessorCount, dev) != hipSuccess) { grid = -1; return; }
        if (hipFuncSetAttribute((const void*)mk_fwd, hipFuncAttributeMaxDynamicSharedMemorySize, LDS_BYTES) != hipSuccess) { fprintf(stderr, "kernel_launch: hipFuncSetAttribute failed\n"); grid = -1; return; }
        if (hipOccupancyMaxActiveBlocksPerMultiprocessor(&per_cu, (const void*)mk_fwd, NWAVES * 64, LDS_BYTES) != hipSuccess || per_cu < 1) fprintf(stderr, "kernel_launch: occupancy query reports %d\n", per_cu);
        (void)hipGetLastError();
        grid = cus;
        if (cus != 256) { fprintf(stderr, "kernel_launch: this kernel is laid out for 256 CUs (MI355X); found %d; nothing launched\n", cus); grid = -1; return; }
    }
    if (grid < 0) return;
    (void)hipMemsetAsync((char*)d_ws + WS_CTL, 0, CTL_ZERO_BYTES, stream);
    Args a{};
    for (int i = 0; i < 16; ++i) a.in[i] = (const float*)d_in[i];
    a.out = (float*)d_out; a.ws = (unsigned char*)d_ws;
    a.ph_lo = 0; a.ph_hi = 9; a.li = 0;
    void* kargs[] = {(void*)&a};
    hipError_t le = hipLaunchCooperativeKernel((const void*)mk_fwd, dim3(grid), dim3(NWAVES * 64), kargs, LDS_BYTES, stream);
    if (le != hipSuccess) { fprintf(stderr, "kernel_launch: cooperative launch failed: %s (grid %d); falling back to a plain launch\n", hipGetErrorString(le), grid); (void)hipGetLastError();
        hipLaunchKernelGGL(mk_fwd, dim3(grid), dim3(NWAVES * 64), LDS_BYTES, stream, a); }
}
```
